# Optimizing an MI355X kernel written in HIP

```python
import jax
import jax.numpy as jnp
from jax import lax
import numpy as np


D_MODEL = 1024
BATCH = 8
SEQ = 8192
DEPTH = 1

GRID_W = 64
CTX_LEN = 256
RET_HEADS = 4
RET_W = D_MODEL // 2
RET_HEAD_DIM = RET_W // RET_HEADS
MLSTM_HEADS = 4
MLSTM_W = D_MODEL // 2
MLSTM_HEAD_DIM = MLSTM_W // MLSTM_HEADS
MIX_W = RET_W + MLSTM_W
GATE_COLS = 4 * MLSTM_HEADS
IN_COLS = 4 * RET_W + 4 * MLSTM_W + GATE_COLS
CONV_W = 3
CHUNK = 128
ROPE_BASE = 10000.0
N_EXPERTS = 64
TOP_K = 8
N_GROUPS = 8
TOPK_GROUPS = 4
EXPERT_FF = 256
SHARED_FF = 256
ROUTED_SCALE = 2.5
EXPERT_BLOCK = 128
N_MOD = 6
EPS = 1e-6

kernel_name = 'hybrid_retention_mlstm_moe_dit_block'


def rmsnorm(x, g):
    x32 = x.astype(jnp.float32)
    y = x32 * lax.rsqrt(jnp.mean(x32 * x32, axis=-1, keepdims=True) + EPS)
    return (y * g.astype(jnp.float32)).astype(x.dtype)


def modulate(h, shift, scale):
    return h * (1.0 + scale) + shift


def head_norm(t, gain):
    t32 = t.astype(jnp.float32)
    mu = jnp.mean(t32, axis=-1, keepdims=True)
    var = jnp.mean(jnp.square(t32 - mu), axis=-1, keepdims=True)
    y = (t32 - mu) * lax.rsqrt(var + EPS)
    B, H, N, Dh = t.shape
    return y.transpose(0, 2, 1, 3).reshape(B, N, H * Dh) * gain.astype(jnp.float32)


def split_heads(t, n_heads):
    B, N, W = t.shape
    return t.reshape(B, N, n_heads, W // n_heads).transpose(0, 2, 1, 3)


def flip_seq(t):
    return None if t is None else jnp.flip(t, axis=2)


def to_chunks(t):
    B, H, N = t.shape[:3]
    return jnp.moveaxis(t.reshape(B, H, N // CHUNK, CHUNK, *t.shape[3:]), 2, 0)


def from_chunks(t):
    t = jnp.moveaxis(t, 0, 2)
    B, H, nc, C = t.shape[:4]
    return t.reshape(B, H, nc * C, *t.shape[4:])


def rope_tables(rows, cols):
    quarter = RET_HEAD_DIM // 4
    freqs = ROPE_BASE ** (-jnp.arange(quarter, dtype=jnp.float32) / quarter)
    ang = jnp.concatenate([rows[:, None] * freqs, cols[:, None] * freqs], axis=-1)
    return jnp.cos(ang), jnp.sin(ang)


def rope_2d(t, cos, sin):
    half = t.shape[-1] // 2
    t1, t2 = t[..., :half], t[..., half:]
    cos = cos.astype(t.dtype)[None, None]
    sin = sin.astype(t.dtype)[None, None]
    return jnp.concatenate([t1 * cos - t2 * sin, t2 * cos + t1 * sin], axis=-1)


def conv3(t, w, b):
    tp = jnp.pad(t, ((0, 0), (1, 1), (0, 0)))
    return tp[:, :-2] * w[0] + tp[:, 1:-1] * w[1] + tp[:, 2:] * w[2] + b


def retention_scan(q, k, v, log_gamma, s0):
    idx = jnp.arange(CHUNK, dtype=jnp.float32)
    lg = log_gamma[:, None]
    k_decay = jnp.exp((CHUNK - 1 - idx) * lg)[None, :, :, None]
    q_decay = jnp.exp((idx + 1) * lg)[None, :, :, None]
    chunk_decay = jnp.exp(CHUNK * log_gamma)[None, :, None, None]
    rel = idx[:, None] - idx[None, :]
    intra = jnp.where(rel >= 0, jnp.exp(jnp.maximum(rel, 0.0) * lg[:, :, None]), 0.0)[None]
    xs = (to_chunks(k), to_chunks(v)) + (() if q is None else (to_chunks(q),))

    def step(S, blk):
        kb, vb = blk[0], blk[1]
        S_next = S * chunk_decay + jnp.einsum('bhcd,bhce->bhde', kb * k_decay, vb)
        if q is None:
            return S_next, None
        qb = blk[2]
        scores = jnp.einsum('bhid,bhjd->bhij', qb, kb) * intra
        out = (jnp.einsum('bhij,bhje->bhie', scores, vb)
               + jnp.einsum('bhid,bhde->bhie', qb * q_decay, S))
        return S_next, out

    s_fin, outs = lax.scan(step, s0, xs)
    return (None if q is None else from_chunks(outs)), s_fin


def mlstm_scan(q, k, v, i_pre, f_pre, state0):
    idx = jnp.arange(CHUNK)
    causal = (idx[:, None] >= idx[None, :])
    log_f = jax.nn.log_sigmoid(f_pre)
    xs = (to_chunks(k), to_chunks(v), to_chunks(i_pre), to_chunks(log_f)) + (
        () if q is None else (to_chunks(q),))

    def step(carry, blk):
        Cm, n, m = carry
        kb, vb, ib, lfb = blk[0], blk[1], blk[2], blk[3]
        b = jnp.cumsum(lfb, axis=-1)
        b_tot = b[..., -1]
        log_ws = b_tot[..., None] - b + ib
        m_next = jnp.maximum(b_tot + m, jnp.max(log_ws, axis=-1))
        decay_prev = jnp.exp(b_tot + m - m_next)
        ws = jnp.exp(log_ws - m_next[..., None])
        C_next = decay_prev[..., None, None] * Cm + jnp.einsum('bhcd,bhce->bhde', kb * ws[..., None], vb)
        n_next = decay_prev[..., None] * n + jnp.einsum('bhc,bhcd->bhd', ws, kb)
        if q is None:
            return (C_next, n_next, m_next), None
        qb = blk[4]
        log_w = jnp.where(causal, b[..., :, None] - b[..., None, :] + ib[..., None, :], -jnp.inf)
        log_inter = b + m[..., None]
        m_i = jnp.maximum(log_inter, jnp.max(log_w, axis=-1))
        w = jnp.exp(log_w - m_i[..., None])
        inter = jnp.exp(log_inter - m_i)
        scores = jnp.einsum('bhid,bhjd->bhij', qb, kb) * w
        num = (jnp.einsum('bhij,bhje->bhie', scores, vb)
               + inter[..., None] * jnp.einsum('bhid,bhde->bhie', qb, Cm))
        den = jnp.sum(scores, axis=-1) + inter * jnp.einsum('bhid,bhd->bhi', qb, n)
        h = num / jnp.maximum(jnp.abs(den), jnp.exp(-m_i))[..., None]
        return (C_next, n_next, m_next), h

    s_fin, outs = lax.scan(step, state0, xs)
    return (None if q is None else from_chunks(outs)), s_fin


def zero_states(B):
    r = jnp.zeros((B, RET_HEADS, RET_HEAD_DIM, RET_HEAD_DIM), jnp.float32)
    m = (jnp.zeros((B, MLSTM_HEADS, MLSTM_HEAD_DIM, MLSTM_HEAD_DIM), jnp.float32),
         jnp.zeros((B, MLSTM_HEADS, MLSTM_HEAD_DIM), jnp.float32),
         jnp.zeros((B, MLSTM_HEADS), jnp.float32))
    return (r, r, m, m)


def mixer_sublayer(h, rope, init, w_in, log_decay, ret_norm_g, conv_w, conv_b,
                   gate_b, mlstm_norm_g, w_out, with_output):
    B, N, _ = h.shape
    R, M = RET_W, MLSTM_W
    p = h @ w_in
    rq, rk, rv, rg = p[..., :R], p[..., R:2 * R], p[..., 2 * R:3 * R], p[..., 3 * R:4 * R]
    o0 = 4 * R
    mqk = jax.nn.silu(conv3(p[..., o0:o0 + 2 * M], conv_w, conv_b))
    mv = p[..., o0 + 2 * M:o0 + 3 * M]
    mo = p[..., o0 + 3 * M:o0 + 4 * M]
    gates = (p[..., o0 + 4 * M:].astype(jnp.float32) + gate_b.astype(jnp.float32).reshape(-1))
    gates = gates.reshape(B, N, 4, MLSTM_HEADS).transpose(2, 0, 3, 1)
    i_f, f_f, i_b, f_b = gates[0], gates[1], gates[2], gates[3]

    rq = split_heads(rq, RET_HEADS) * (RET_HEAD_DIM ** -0.5)
    rk = split_heads(rk, RET_HEADS)
    if rope is not None:
        rq = rope_2d(rq, *rope)
        rk = rope_2d(rk, *rope)
    rv = split_heads(rv, RET_HEADS)
    mq = split_heads(mqk[..., :M], MLSTM_HEADS)
    mk = split_heads(mqk[..., M:], MLSTM_HEADS) * (MLSTM_HEAD_DIM ** -0.5)
    mv = split_heads(mv, MLSTM_HEADS)
    log_gamma = -jnp.exp(log_decay.astype(jnp.float32))

    qr = rq if with_output else None
    qm = mq if with_output else None
    rs_f, rs_b, ms_f, ms_b = init
    ret_f, rs_f = retention_scan(qr, rk, rv, log_gamma[0], rs_f)
    ret_b, rs_b = retention_scan(flip_seq(qr), flip_seq(rk), flip_seq(rv), log_gamma[1], rs_b)
    ml_f, ms_f = mlstm_scan(qm, mk, mv, i_f, f_f, ms_f)
    ml_b, ms_b = mlstm_scan(flip_seq(qm), flip_seq(mk), flip_seq(mv), flip_seq(i_b), flip_seq(f_b), ms_b)
    states = (rs_f, rs_b, ms_f, ms_b)
    if not with_output:
        return None, states
    ret = head_norm(ret_f + flip_seq(ret_b), ret_norm_g) * jax.nn.silu(rg.astype(jnp.float32))
    mls = head_norm(ml_f + flip_seq(ml_b), mlstm_norm_g) * jax.nn.sigmoid(mo.astype(jnp.float32))
    y = jnp.concatenate([ret, mls], axis=-1).astype(h.dtype) @ w_out
    return y, states


def swiglu(t, wg, wu, wd):
    return (jax.nn.silu(t @ wg) * (t @ wu)) @ wd


def routed_experts(t, eidx, wts, w_gate, w_up, w_down):
    T, D = t.shape
    A = T * TOP_K
    e_flat = eidx.reshape(-1)
    tok_flat = jnp.repeat(jnp.arange(T, dtype=jnp.int32), TOP_K)
    w_flat = wts.reshape(-1)
    order = jnp.argsort(e_flat)
    e_s, tok_s, w_s = e_flat[order], tok_flat[order], w_flat[order]
    sizes = jnp.zeros((N_EXPERTS,), jnp.int32).at[e_flat].add(1)
    starts = jnp.cumsum(sizes) - sizes
    padded = (sizes + EXPERT_BLOCK - 1) // EXPERT_BLOCK * EXPERT_BLOCK
    pends = jnp.cumsum(padded)
    pstarts = pends - padded
    dest = pstarts[e_s] + (jnp.arange(A, dtype=jnp.int32) - starts[e_s])
    P = -(-(A + N_EXPERTS * (EXPERT_BLOCK - 1)) // EXPERT_BLOCK) * EXPERT_BLOCK
    NB = P // EXPERT_BLOCK
    buf_tok = jnp.zeros((P,), jnp.int32).at[dest].set(tok_s)
    buf_w = jnp.zeros((P,), t.dtype).at[dest].set(w_s)
    block_e = jnp.clip(jnp.searchsorted(pends, jnp.arange(NB, dtype=jnp.int32) * EXPERT_BLOCK,
                                        side='right'), 0, N_EXPERTS - 1)

    def body(y, blk):
        tok, wb, e = blk
        xb = t[tok]
        hb = jax.nn.silu(xb @ w_gate[e]) * (xb @ w_up[e])
        return y.at[tok].add((hb @ w_down[e]) * wb[:, None]), None

    y, _ = lax.scan(body, jnp.zeros_like(t),
                    (buf_tok.reshape(NB, EXPERT_BLOCK), buf_w.reshape(NB, EXPERT_BLOCK), block_e))
    return y


def moe_ffn(h, w_router, router_bias, w_gate, w_up, w_down, ws_gate, ws_up, ws_down):
    B, N, D = h.shape
    T = B * N
    t = h.reshape(T, D)
    scores = jax.nn.sigmoid((t @ w_router).astype(jnp.float32))
    sel = scores + router_bias.astype(jnp.float32)
    grp = lax.top_k(sel.reshape(T, N_GROUPS, N_EXPERTS // N_GROUPS), 2)[0].sum(-1)
    _, gidx = lax.top_k(grp, TOPK_GROUPS)
    gmask = jax.nn.one_hot(gidx, N_GROUPS, dtype=jnp.float32).sum(1) > 0
    emask = jnp.repeat(gmask, N_EXPERTS // N_GROUPS, axis=1)
    _, eidx = lax.top_k(jnp.where(emask, sel, -jnp.inf), TOP_K)
    wts = jnp.take_along_axis(scores, eidx, axis=1)
    wts = wts / jnp.sum(wts, axis=-1, keepdims=True) * ROUTED_SCALE
    routed = routed_experts(t, eidx, wts.astype(t.dtype), w_gate, w_up, w_down)
    shared = swiglu(t, ws_gate, ws_up, ws_down)
    return (routed + shared).reshape(B, N, D)


def setup_inputs(seed: int = 0) -> dict:
    key = jax.random.key(seed)
    ks = jax.random.split(key, 24)
    f32 = jnp.float32

    def nrm(k, shape, scale):
        return jax.random.normal(k, shape, f32) * scale

    D = D_MODEL
    decay_base = jnp.asarray(np.log(-np.log(1.0 - 2.0 ** (-5.0 - np.arange(RET_HEADS)))), dtype=f32)
    fb = jnp.linspace(3.0, 6.0, MLSTM_HEADS, dtype=f32)
    zb = jnp.zeros((MLSTM_HEADS,), f32)
    gate_base = jnp.stack([zb, fb, zb, fb])
    return {
        'x': nrm(ks[0], (BATCH, SEQ, D), 1.0),
        'c': nrm(ks[1], (BATCH, D), 1.0),
        'ctx': nrm(ks[2], (BATCH, CTX_LEN, D), 1.0),
        'c_ctx': nrm(ks[3], (D,), 1.0),
        'w_mod': nrm(ks[4], (DEPTH, D, N_MOD * D), D ** -0.5),
        'b_mod': nrm(ks[5], (DEPTH, N_MOD * D), 0.02),
        'norm_g': 1.0 + nrm(ks[6], (DEPTH, 4, D), 0.05),
        'w_in': nrm(ks[7], (DEPTH, D, IN_COLS), D ** -0.5),
        'ret_log_decay': decay_base[None, None, :] + nrm(ks[8], (DEPTH, 2, RET_HEADS), 0.1),
        'ret_norm_g': 1.0 + nrm(ks[9], (DEPTH, RET_W), 0.05),
        'mlstm_conv_w': nrm(ks[10], (DEPTH, CONV_W, 2 * MLSTM_W), CONV_W ** -0.5),
        'mlstm_conv_b': nrm(ks[11], (DEPTH, 2 * MLSTM_W), 0.02),
        'mlstm_gate_b': gate_base[None] + nrm(ks[12], (DEPTH, 4, MLSTM_HEADS), 0.1),
        'mlstm_norm_g': 1.0 + nrm(ks[13], (DEPTH, MLSTM_W), 0.05),
        'w_out': nrm(ks[14], (DEPTH, MIX_W, D), MIX_W ** -0.5),
        'w_router': nrm(ks[15], (DEPTH, D, N_EXPERTS), D ** -0.5),
        'router_bias': nrm(ks[16], (DEPTH, N_EXPERTS), 0.01),
        'w_gate': nrm(ks[17], (DEPTH, N_EXPERTS, D, EXPERT_FF), D ** -0.5),
        'w_up': nrm(ks[18], (DEPTH, N_EXPERTS, D, EXPERT_FF), D ** -0.5),
        'w_down': nrm(ks[19], (DEPTH, N_EXPERTS, EXPERT_FF, D), EXPERT_FF ** -0.5),
        'ws_gate': nrm(ks[20], (DEPTH, D, SHARED_FF), D ** -0.5),
        'ws_up': nrm(ks[21], (DEPTH, D, SHARED_FF), D ** -0.5),
        'ws_down': nrm(ks[22], (DEPTH, SHARED_FF, D), SHARED_FF ** -0.5),
    }


def reference(x, c, ctx, c_ctx, w_mod, b_mod, norm_g, w_in, ret_log_decay, ret_norm_g,
              mlstm_conv_w, mlstm_conv_b, mlstm_gate_b, mlstm_norm_g, w_out, w_router,
              router_bias, w_gate, w_up, w_down, ws_gate, ws_up, ws_down):
    B, N, D = x.shape
    ROWS = N // GRID_W
    rows = jnp.repeat(jnp.arange(ROWS, dtype=jnp.float32), GRID_W)
    cols = jnp.tile(jnp.arange(GRID_W, dtype=jnp.float32), ROWS)
    rope = rope_tables(rows, cols)
    for l in range(DEPTH):
        last = l == DEPTH - 1
        mod = (jax.nn.silu(c) @ w_mod[l] + b_mod[l]).reshape(B, N_MOD, D)
        sh1, sc1, g1, sh2, sc2, g2 = [mod[:, i][:, None, :] for i in range(N_MOD)]
        mod_c = (jax.nn.silu(c_ctx) @ w_mod[l] + b_mod[l]).reshape(N_MOD, D)
        csh1, csc1, cg1, csh2, csc2, cg2 = [mod_c[i] for i in range(N_MOD)]
        mix_params = (w_in[l], ret_log_decay[l], ret_norm_g[l], mlstm_conv_w[l], mlstm_conv_b[l],
                      mlstm_gate_b[l], mlstm_norm_g[l], w_out[l])
        h_ctx = modulate(rmsnorm(ctx, norm_g[l, 0]), csh1, csc1)
        y_ctx, ctx_states = mixer_sublayer(h_ctx, None, zero_states(ctx.shape[0]), *mix_params,
                                           with_output=not last)
        h_lat = modulate(rmsnorm(x, norm_g[l, 0]), sh1, sc1)
        y_lat, _ = mixer_sublayer(h_lat, rope, ctx_states, *mix_params, with_output=True)
        x = x + g1 * rmsnorm(y_lat, norm_g[l, 1])
        moe_params = (w_router[l], router_bias[l], w_gate[l], w_up[l], w_down[l],
                      ws_gate[l], ws_up[l], ws_down[l])
        if not last:
            ctx = ctx + cg1 * rmsnorm(y_ctx, norm_g[l, 1])
            hc = modulate(rmsnorm(ctx, norm_g[l, 2]), csh2, csc2)
            ctx = ctx + cg2 * rmsnorm(moe_ffn(hc, *moe_params), norm_g[l, 3])
        h = modulate(rmsnorm(x, norm_g[l, 2]), sh2, sc2)
        x = x + g2 * rmsnorm(moe_ffn(h, *moe_params), norm_g[l, 3])
    return x
```

```cpp
#include <hip/hip_runtime.h>
#include <cstdio>
#include <cstdint>

#ifndef MK_ONE_LAUNCH
#define MK_ONE_LAUNCH 1
#endif

#define LAS __attribute__((address_space(3)))
#define DEVI __device__ __forceinline__
typedef unsigned short bf16_t;
typedef short bf16x8 __attribute__((ext_vector_type(8)));
typedef float f32x4 __attribute__((ext_vector_type(4)));
typedef float f32x2 __attribute__((ext_vector_type(2)));
typedef unsigned u32x4 __attribute__((ext_vector_type(4)));
typedef unsigned u32x2 __attribute__((ext_vector_type(2)));

constexpr int DM = 1024, NBATCH = 8, SEQ = 8192, T = NBATCH * SEQ, CTXL = 256, TC = NBATCH * CTXL, TT = T + TC;
constexpr int CH = 128, NCH = SEQ / CH, NCC = CTXL / CH, NSLOT = NCH + NCC;
constexpr int PN = 4096;
constexpr int INC = 4112;
constexpr int NE = 64, TOPK = 8, EFF = 256;
constexpr int NTHREADS = 512, NWAVES = 8;
constexpr int LDS_BYTES = 155648;
constexpr int LDS_MISC = LDS_BYTES - 64;
constexpr float EPS = 1e-6f;
constexpr int HALF_T = T / 2;
constexpr int CAP_R = HALF_T * TOPK + NE * 256;
constexpr int CAP_TILES = CAP_R / 256;
constexpr int ROWS_H = CAP_R + HALF_T;
constexpr int SH_TILES = HALF_T / 256;
constexpr int HTILES = ROWS_H / 256;
constexpr float ROW_SCALE = 8.f;
constexpr float ACT_SCALE = 16.f, W_SCALE_DN = 512.f;
constexpr float H2_SCALE = 16.f, W_SCALE_GU = 1024.f;

constexpr size_t MB = 1ull << 20;
constexpr size_t WS_CTL = 0;
constexpr size_t CTL_BYTES = 65536;
constexpr size_t WS_MODP = 1 * MB;
constexpr size_t WS_WINT = 3 * MB;
constexpr size_t WS_WOUTT = 11 * MB;
constexpr size_t WS_WRT = 13 * MB;
constexpr size_t WS_GATES = 14 * MB;
constexpr size_t WS_UN = 19 * MB;
constexpr size_t WS_CHS = 22 * MB;
constexpr size_t WS_SM = 22 * MB + 256 * 1024;
constexpr size_t WS_EIDX = 23 * MB;
constexpr size_t WS_WTS = 25 * MB;
constexpr size_t WS_POS = 27 * MB;
constexpr size_t WS_TOKL = 29 * MB;
constexpr size_t WS_WL = 32 * MB;
constexpr size_t WS_BCNT = 35 * MB;
constexpr size_t WS_TEXP = 35 * MB + 128 * 1024;
constexpr size_t WS_NT = 35 * MB + 256 * 1024;
constexpr size_t WS_B = 36 * MB;
constexpr size_t WS_PROJ = 168 * MB;
constexpr size_t WS_US = 696 * MB;
constexpr size_t WS_WGU = 36 * MB;
constexpr size_t WS_WD = 101 * MB;
constexpr size_t WS_ACT = 696 * MB;
constexpr size_t WS_ROWS0 = 168 * MB;
constexpr size_t WS_ROWS1 = 472 * MB;
constexpr size_t WS_END = 1000 * MB;
static_assert(WS_WD + 65ull * 1024 * 256 * 2 <= WS_PROJ && WS_ACT + 2ull * ROWS_H * 256 * 2 <= WS_END && WS_ROWS0 + (size_t)ROWS_H * 1024 <= WS_ROWS1
              && WS_ROWS1 + (size_t)ROWS_H * 1024 <= WS_ACT + (size_t)ROWS_H * 256 * 2 && WS_ACT >= WS_PROJ + (size_t)TT * PN * 2, "workspace overlap");

struct Params {
    const float* in[23];
    float* out;
    unsigned char* ws;
    int ph_lo, ph_hi;
};
enum { I_X = 0, I_C, I_CTX, I_CCTX, I_WMOD, I_BMOD, I_NORMG, I_WIN, I_RDEC, I_RNG, I_CONVW, I_CONVB, I_GATEB, I_MNG, I_WOUT,
       I_WR, I_RB, I_WG, I_WU, I_WDN, I_SG, I_SU, I_SD };

DEVI float bf2f(bf16_t b) { return __uint_as_float(((unsigned)b) << 16); }
DEVI unsigned cvt_pk_bf16(float lo, float hi) { unsigned r; asm volatile("v_cvt_pk_bf16_f32 %0, %1, %2" : "=v"(r) : "v"(lo), "v"(hi)); return r; }
DEVI bf16_t f2bf(float f) { return (bf16_t)(cvt_pk_bf16(f, 0.f) & 0xffffu); }
DEVI float lo_bf(unsigned u) { return __uint_as_float(u << 16); }
DEVI float hi_bf(unsigned u) { return __uint_as_float(u & 0xffff0000u); }
DEVI float wave_sum(float v) {
#pragma unroll
    for (int o = 1; o < 64; o <<= 1) v += __shfl_xor(v, o);
    return v;
}
DEVI float row16_sum(float v) {
    v += __builtin_bit_cast(float, __builtin_amdgcn_update_dpp(0, __builtin_bit_cast(int, v), 0xB1, 0xF, 0xF, true));
    v += __builtin_bit_cast(float, __builtin_amdgcn_update_dpp(0, __builtin_bit_cast(int, v), 0x4E, 0xF, 0xF, true));
    v += __builtin_bit_cast(float, __builtin_amdgcn_update_dpp(0, __builtin_bit_cast(int, v), 0x141, 0xF, 0xF, true));
    v += __builtin_bit_cast(float, __builtin_amdgcn_update_dpp(0, __builtin_bit_cast(int, v), 0x140, 0xF, 0xF, true));
    return v;
}
DEVI float dpp_x1(float x) { return __builtin_bit_cast(float, __builtin_amdgcn_update_dpp(0, __builtin_bit_cast(int, x), 0xB1, 0xF, 0xF, true)); }
DEVI float dpp_x2(float x) { return __builtin_bit_cast(float, __builtin_amdgcn_update_dpp(0, __builtin_bit_cast(int, x), 0x4E, 0xF, 0xF, true)); }
DEVI float dpp_x4(float x) { const int t = __builtin_amdgcn_update_dpp(0, __builtin_bit_cast(int, x), 0x114, 0xF, 0xA, true);
    return __builtin_bit_cast(float, __builtin_amdgcn_update_dpp(t, __builtin_bit_cast(int, x), 0x104, 0xF, 0x5, true)); }
DEVI float dpp_x8(float x) { const int t = __builtin_amdgcn_update_dpp(0, __builtin_bit_cast(int, x), 0x118, 0xF, 0xC, true);
    return __builtin_bit_cast(float, __builtin_amdgcn_update_dpp(t, __builtin_bit_cast(int, x), 0x108, 0xF, 0x3, true)); }
DEVI float quad_sum(float v) {
    v += __builtin_bit_cast(float, __builtin_amdgcn_update_dpp(0, __builtin_bit_cast(int, v), 0xB1, 0xF, 0xF, true));
    v += __builtin_bit_cast(float, __builtin_amdgcn_update_dpp(0, __builtin_bit_cast(int, v), 0x4E, 0xF, 0xF, true));
    return v;
}
DEVI float wave_max(float v) {
#pragma unroll
    for (int o = 1; o < 64; o <<= 1) v = fmaxf(v, __shfl_xor(v, o));
    return v;
}
DEVI float sigmoidf_(float x) { return __builtin_amdgcn_rcpf(1.f + __expf(-x)); }
DEVI float siluf_(float x) { return x * __builtin_amdgcn_rcpf(1.f + __expf(-x)); }
DEVI float logsigmoidf_(float x) { const float e = __expf(-fabsf(x)); return fminf(x, 0.f) - __logf(1.f + e); }
#define LDS_WAIT() asm volatile("s_waitcnt lgkmcnt(0)" ::: "memory")

#define XB_TMO      128
#define XB_XCNT(j)  (256  + 64 * (j))
#define XB_XSUB(j)  (1280 + 64 * (j))
#define XB_XGEN(j)  (2304 + 64 * (j))
#define XB_TOP      3328
#define XB_TOPGEN   3392
#define XCD_BAR_WORDS 3456
#define XB_SPIN_CAP (1u << 18)
DEVI unsigned xb_ld(unsigned* p)              { return __hip_atomic_load(p, __ATOMIC_RELAXED, __HIP_MEMORY_SCOPE_AGENT); }
DEVI unsigned xb_add(unsigned* p, unsigned v) { return __hip_atomic_fetch_add(p, v, __ATOMIC_RELAXED, __HIP_MEMORY_SCOPE_AGENT); }
DEVI unsigned xb_xcc_id() { return (unsigned)__builtin_amdgcn_s_getreg((3 << 11) | 20) & 0xFu; }
#define XB_SPIN(cond, bar) do { unsigned _sp = 0; while (cond) { __builtin_amdgcn_s_sleep(1); \
    if ((++_sp & 255u) == 0u) { if (xb_ld(&(bar)[XB_TMO])) break; if (_sp > XB_SPIN_CAP) { atomicAdd(&(bar)[XB_TMO], 1u); break; } } } } while (0)
struct XcdBarrier { unsigned* bar; unsigned x; volatile LAS unsigned* st; };
DEVI XcdBarrier xcd_barrier_post(unsigned* bar, volatile LAS unsigned* st) {
    XcdBarrier b; b.bar = bar; b.x = xb_xcc_id(); b.st = st;
    if (threadIdx.x == 0) (void)xb_add(&bar[XB_XCNT(b.x)], 1u);
    return b;
}
DEVI void xcd_barrier_complete(unsigned* bar, unsigned x, unsigned& nloc, unsigned& nx) {
    const unsigned G = gridDim.x * gridDim.y * gridDim.z;
    unsigned sum, cnt, mine, sp = 0u;
    for (;;) {
        sum = 0u; cnt = 0u; mine = 0u;
#pragma unroll
        for (unsigned j = 0; j < 16; ++j) { const unsigned c = xb_ld(&bar[XB_XCNT(j)]); sum += c; cnt += (c > 0u) ? 1u : 0u; mine = (j == x) ? c : mine; }
        if (sum == G) break;
        __builtin_amdgcn_s_sleep(1);
        if ((++sp & 255u) == 0u) { if (xb_ld(&bar[XB_TMO])) break; if (sp > XB_SPIN_CAP) { atomicAdd(&bar[XB_TMO], 1u); break; } }
    }
    nloc = mine > 0u ? mine : 1u; nx = cnt > 0u ? cnt : 1u;
}
DEVI void xcd_barrier(const XcdBarrier& b) {
    asm volatile("s_waitcnt vmcnt(0)" ::: "memory");
    __syncthreads();
    if (threadIdx.x == 0) {
        unsigned* bar = b.bar;
        __builtin_amdgcn_s_waitcnt(0);
        unsigned nloc = b.st[0], nx = b.st[1];
        if (nloc == 0u) { xcd_barrier_complete(bar, b.x, nloc, nx); b.st[0] = nloc; b.st[1] = nx; }
        const unsigned old = xb_add(&bar[XB_XSUB(b.x)], 1u);
        const unsigned gen = old / nloc;
        if (old + 1u == (gen + 1u) * nloc) {
            __builtin_amdgcn_fence(__ATOMIC_RELEASE, "agent");
            asm volatile("s_waitcnt vmcnt(0)" ::: "memory");
            const unsigned og = xb_add(&bar[XB_TOP], 1u);
            const unsigned tg = og / nx;
            if (og + 1u == (tg + 1u) * nx) xb_add(&bar[XB_TOPGEN], 1u);
            else XB_SPIN(xb_ld(&bar[XB_TOPGEN]) == tg, bar);
            __builtin_amdgcn_fence(__ATOMIC_ACQUIRE, "agent");
            xb_add(&bar[XB_XGEN(b.x)], 1u);
            asm volatile("s_waitcnt vmcnt(0)" ::: "memory");
        } else {
            XB_SPIN(xb_ld(&bar[XB_XGEN(b.x)]) == gen, bar);
            __builtin_amdgcn_fence(__ATOMIC_ACQUIRE, "agent");
            asm volatile("s_waitcnt vmcnt(0)" ::: "memory");
        }
    }
    __syncthreads();
}

namespace pg8 {
constexpr int BM = 256, BK = 64, HALF = 128, HTB = HALF * BK * 2, STAGE_BYTES = 8 * HTB, NXCD = 8, WGM = 8;
DEVI int lds_byte(int r, int c) { const int st = (r >> 4) * 2 + (c >> 5), rr = r & 15, cc = c & 31, ob = rr * 64 + cc * 2; return st * 1024 + (ob ^ (((ob >> 9) & 1) << 5)); }
DEVI void stage_rc(int b, int& R, int& C) { const int st = b / 1024, sb = b % 1024, swz = sb ^ (((sb >> 9) & 1) << 5); R = (st >> 1) * 16 + swz / 64; C = (st & 1) * 32 + (swz % 64) / 2; }
DEVI int perm32(int rho) { const int n = rho >> 4, i = rho & 15; return 8 * (i >> 2) + 4 * n + (i & 3); }
struct Unit { int pm, pn, aux, seq; };
struct Gemm { const bf16_t* A; const bf16_t* Bt; int lda; int K; int sa = 0x7f7f7f7f; };
DEVI bool static_unit(int nM, int nN, long L, Unit& u) {
    const int nwg = nM * nN; if (L >= nwg) return false;
    int wgid = (int)L; { const int q = nwg / NXCD, r = nwg % NXCD, xcd = wgid % NXCD, off = wgid / NXCD; wgid = (xcd < r ? xcd * (q + 1) : r * (q + 1) + (xcd - r) * q) + off; }
    const int nig = WGM * nN, gid = wgid / nig, fm = gid * WGM, gsz = (nM - fm) < WGM ? (nM - fm) : WGM;
    u.pm = fm + ((wgid % nig) % gsz); u.pn = (wgid % nig) / gsz; u.aux = 0; return true;
}

typedef int v4i_t __attribute__((ext_vector_type(4)));
typedef int v8i_t __attribute__((ext_vector_type(8)));
template <class Epi, class Sched, bool AFTER_DRAIN = false, bool HB = false, bool F8 = false>
DEVI void gemm_phase(LAS unsigned char* lds, const Gemm g, const Sched& S, const Epi& E) {
    static_assert(!F8 || HB, "the fp8 body is the half-width one");
    const int tid = threadIdx.x, wid = __builtin_amdgcn_readfirstlane(tid >> 6), lane = tid & 63, wr = wid >> 2, wc = wid & 3, fr = lane & 15, fq = lane >> 4;
    const int K = g.K, nt = K / BK;
    int sR[2], sC[2]; unsigned voffB[2];
#pragma unroll
    for (int i = 0; i < 2; ++i) { int R, C; stage_rc(tid * 16 + i * 8192, R, C); sR[i] = R; sC[i] = C; const int Rb = (R & ~31) + perm32(R & 31); voffB[i] = (unsigned)(Rb * K + C) * 2u; }
    const size_t kstep = (size_t)(BK * 2);
    const size_t hstepB = (size_t)HALF * K * 2;
    const size_t tstepB = HB ? hstepB : 2 * hstepB;
    const unsigned ldsw = (unsigned)wid * 1024u;
    const int aoff = lds_byte(wr * 64 + fr, fq * 8), boff = lds_byte(wc * 32 + fr, fq * 8);
#define PG8_SA(b, h) (((b) * 2 + (h)) * HTB)
#define PG8_SB(b, h) ((4 + (b) * 2 + (h)) * HTB)
#define PG8_STAGE(bufoff, gbase, voff) do { _Pragma("unroll") for (int _i = 0; _i < 2; ++_i) \
        __builtin_amdgcn_global_load_lds((const unsigned*)((const char*)(gbase) + (voff)[_i]), (LAS unsigned*)(lds + (bufoff) + ldsw + _i * 8192), 16, 0, 0); } while (0)
#define PG8_LD8(P) __builtin_shufflevector(*(const LAS v4i_t*)(P), *(const LAS v4i_t*)((P) + 1024), 0, 1, 2, 3, 4, 5, 6, 7)
#define PG8_LDA(dst, b, h) do { _Pragma("unroll") for (int m = 0; m < 4; ++m) { if constexpr (F8) dst##8[m] = PG8_LD8(lds + PG8_SA(b, h) + aoff + m * 2048); \
        else { _Pragma("unroll") for (int k = 0; k < 2; ++k) dst[m][k] = *(const LAS bf16x8*)(lds + PG8_SA(b, h) + aoff + m * 2048 + k * 1024); } } } while (0)
#define PG8_LDB(dst, b, h) do { _Pragma("unroll") for (int n = 0; n < 2; ++n) { if constexpr (F8) dst##8[n] = PG8_LD8(lds + PG8_SB(b, h) + boff + n * 2048); \
        else { _Pragma("unroll") for (int k = 0; k < 2; ++k) dst[n][k] = *(const LAS bf16x8*)(lds + PG8_SB(b, h) + boff + n * 2048 + k * 1024); } } } while (0)
#define PG8_MMA(ai, bj, At, Bt) do { __builtin_amdgcn_s_setprio(1); _Pragma("unroll") for (int m = 0; m < 4; ++m) _Pragma("unroll") for (int n = 0; n < 2; ++n) { \
        if constexpr (F8) acc[ai][bj][m][n] = __builtin_amdgcn_mfma_scale_f32_16x16x128_f8f6f4(Bt##8[n], At##8[m], acc[ai][bj][m][n], 0, 0, 0, g.sa, 0, 0x7f7f7f7f); \
        else { _Pragma("unroll") for (int k = 0; k < 2; ++k) acc[ai][bj][m][n] = __builtin_amdgcn_mfma_f32_16x16x32_bf16(Bt[n][k], At[m][k], acc[ai][bj][m][n], 0, 0, 0); } } \
        __builtin_amdgcn_s_setprio(0); } while (0)
#define PG8_WAIT_LOOP do { if constexpr (HB) PG8_WAIT_V(6); else PG8_WAIT_V(8); } while (0)
#define PG8_WAIT_V(n) asm volatile("s_waitcnt vmcnt(" #n ")" ::: "memory")
#define PG8_WAIT_L(n) asm volatile("s_waitcnt lgkmcnt(" #n ")" ::: "memory")
#define PG8_BAR __builtin_amdgcn_s_barrier()
#define PG8_SCHED __builtin_amdgcn_sched_barrier(0)
#define PG8_AOFFS(dst, u) do { _Pragma("unroll") for (int _h = 0; _h < 2; ++_h) _Pragma("unroll") for (int _i = 0; _i < 2; ++_i) \
        { const int raw_ = S.arow(u, _h * HALF + sR[_i]); dst[_h][_i] = ((unsigned)(raw_ < 0 ? 0 : raw_) * (unsigned)g.lda + (unsigned)sC[_i]) * 2u; } } while (0)
    Unit cur, nxt; int ui = 0;
    if (!S.next(0, cur)) return;
    f32x4 acc[2][2][4][2];
#pragma unroll
    for (int a = 0; a < 2; ++a)
#pragma unroll
        for (int b = 0; b < 2; ++b)
#pragma unroll
            for (int m = 0; m < 4; ++m)
#pragma unroll
                for (int n = 0; n < 2; ++n) acc[a][b][m][n] = (f32x4){0.f, 0.f, 0.f, 0.f};
    bf16x8 At[4][2], B0[2][2], B1[2][2]; v8i_t At8[4], B08[2], B18[2];
    unsigned cOff[2][2], nOff[2][2];
    PG8_AOFFS(cOff, cur);
    bool has_next = S.next(1, nxt);
    if (has_next) { PG8_AOFFS(nOff, nxt); } else {
#pragma unroll
        for (int _h = 0; _h < 2; ++_h)
#pragma unroll
            for (int _i = 0; _i < 2; ++_i) nOff[_h][_i] = cOff[_h][_i]; }
    const char* gA = (const char*)g.A;
    const char* cB = (const char*)g.Bt + (size_t)cur.pn * tstepB;
    PG8_STAGE(PG8_SB(0, 0), cB, voffB); if constexpr (!HB) PG8_STAGE(PG8_SB(0, 1), cB + hstepB, voffB); PG8_STAGE(PG8_SA(0, 0), gA, cOff[0]); PG8_STAGE(PG8_SA(0, 1), gA, cOff[1]);
    if (wr == 1) PG8_BAR;
    PG8_WAIT_V(2); PG8_BAR;
    PG8_STAGE(PG8_SB(1, 0), cB + kstep, voffB); PG8_STAGE(PG8_SA(1, 0), gA + kstep, cOff[0]); if constexpr (!HB) PG8_STAGE(PG8_SB(1, 1), cB + hstepB + kstep, voffB);
    if constexpr (HB) PG8_WAIT_V(4); else PG8_WAIT_V(6);
    PG8_BAR;
    for (;;) {
        const char* nB = has_next ? (const char*)g.Bt + (size_t)nxt.pn * tstepB : cB;
        cur.seq = ui;
        if constexpr (Epi::PRE) E.prefetch(lds, cur, wid, lane);
        Unit nn; int nnRaw[2][2];
        const bool has_nn = has_next && S.next(ui + 2, nn);
        if constexpr (Sched::IDX_DMA) { if (has_nn) S.idx_dma(lds, nn, ui, wid, lane); }
        else {
#pragma unroll
            for (int _h = 0; _h < 2; ++_h)
#pragma unroll
                for (int _i = 0; _i < 2; ++_i) nnRaw[_h][_i] = has_nn ? S.arow(nn, _h * HALF + sR[_i]) : 0; }
#pragma unroll 1
        for (int t = 0; t < nt; t += 2) {
            const bool last = (t == nt - 2);
            const char* a1 = gA + (size_t)(t + 1) * kstep;
            const char* a2 = last ? gA : gA + (size_t)(t + 2) * kstep; const char* b2 = last ? nB : cB + (size_t)(t + 2) * kstep;
            const char* a3 = a2 + kstep; const char* b3 = b2 + kstep;
            unsigned o2[2][2];
#pragma unroll
            for (int _h = 0; _h < 2; ++_h)
#pragma unroll
                for (int _i = 0; _i < 2; ++_i) o2[_h][_i] = last ? nOff[_h][_i] : cOff[_h][_i];
            PG8_LDB(B0, 0, 0); if constexpr (!HB) PG8_LDB(B1, 0, 1); PG8_SCHED; PG8_LDA(At, 0, 0); PG8_STAGE(PG8_SA(1, 1), a1, cOff[1]);
            PG8_WAIT_LOOP; PG8_WAIT_L(0); PG8_BAR; PG8_MMA(0, 0, At, B0); if constexpr (!HB) PG8_MMA(0, 1, At, B1); PG8_BAR; PG8_SCHED;
            PG8_LDA(At, 0, 1); PG8_STAGE(PG8_SB(0, 0), b2, voffB); if constexpr (!HB) PG8_STAGE(PG8_SB(0, 1), b2 + hstepB, voffB); PG8_STAGE(PG8_SA(0, 0), a2, o2[0]);
            PG8_WAIT_LOOP; PG8_WAIT_L(0); PG8_BAR; PG8_MMA(1, 0, At, B0); if constexpr (!HB) PG8_MMA(1, 1, At, B1); PG8_BAR; PG8_SCHED;
            PG8_LDB(B0, 1, 0); if constexpr (!HB) PG8_LDB(B1, 1, 1); PG8_SCHED; PG8_LDA(At, 1, 0); PG8_STAGE(PG8_SA(0, 1), a2, o2[1]);
            PG8_WAIT_LOOP; PG8_WAIT_L(0); PG8_BAR; PG8_MMA(0, 0, At, B0); if constexpr (!HB) PG8_MMA(0, 1, At, B1); PG8_BAR; PG8_SCHED;
            PG8_LDA(At, 1, 1); PG8_STAGE(PG8_SB(1, 0), b3, voffB); if constexpr (!HB) PG8_STAGE(PG8_SB(1, 1), b3 + hstepB, voffB); PG8_STAGE(PG8_SA(1, 0), a3, o2[0]);
            PG8_WAIT_LOOP; PG8_WAIT_L(0); PG8_BAR; PG8_MMA(1, 0, At, B0); if constexpr (!HB) PG8_MMA(1, 1, At, B1); PG8_BAR; PG8_SCHED;
        }
        if (wr == 0) PG8_BAR;
        if constexpr (!AFTER_DRAIN) E(acc, cur, wr, wc, fr, fq);
        if (!has_next) break;
#pragma unroll
        for (int a = 0; a < 2; ++a)
#pragma unroll
            for (int b = 0; b < 2; ++b)
#pragma unroll
                for (int m = 0; m < 4; ++m)
#pragma unroll
                    for (int n = 0; n < 2; ++n) acc[a][b][m][n] = (f32x4){0.f, 0.f, 0.f, 0.f};
        cur = nxt; cB = nB; ++ui; nxt = nn; has_next = has_nn;
#pragma unroll
        for (int _h = 0; _h < 2; ++_h)
#pragma unroll
            for (int _i = 0; _i < 2; ++_i) { int raw;
                if constexpr (Sched::IDX_DMA) raw = has_nn ? S.idx_lds(lds, ui - 1, _h * HALF + sR[_i]) : 0; else { raw = nnRaw[_h][_i]; asm volatile("" : "+v"(raw)); }
                cOff[_h][_i] = nOff[_h][_i]; if (has_nn) nOff[_h][_i] = ((unsigned)(raw < 0 ? 0 : raw) * (unsigned)g.lda + (unsigned)sC[_i]) * 2u; }
        if (wr == 1) PG8_BAR;
    }
    PG8_WAIT_V(0);
    PG8_BAR;
    if constexpr (AFTER_DRAIN) E(acc, cur, wr, wc, fr, fq);
#undef PG8_SA
#undef PG8_SB
#undef PG8_STAGE
#undef PG8_LDA
#undef PG8_LD8
#undef PG8_WAIT_LOOP
#undef PG8_LDB
#undef PG8_MMA
#undef PG8_WAIT_V
#undef PG8_WAIT_L
#undef PG8_BAR
#undef PG8_SCHED
#undef PG8_AOFFS
}

template <class Epi, class Sched, int GRP>
DEVI void gemm_phase_astat8(LAS unsigned char* lds, const Gemm g, const Sched& S, const Epi& E) {
    const int tid = threadIdx.x, wid = __builtin_amdgcn_readfirstlane(tid >> 6), lane = tid & 63, wr = GRP, wc = wid & 3, fr = lane & 15, fq = lane >> 4;
    const int K = g.K;
    int sR[2], sC[2]; unsigned voffB[2], vA[2][2];
#pragma unroll
    for (int i = 0; i < 2; ++i) { int R, C; stage_rc(tid * 16 + i * 8192, R, C); sR[i] = R; sC[i] = C; const int Rb = (R & ~31) + perm32(R & 31); voffB[i] = (unsigned)(Rb * K + C) * 2u; }
#pragma unroll
    for (int h = 0; h < 2; ++h)
#pragma unroll
        for (int i = 0; i < 2; ++i) vA[h][i] = ((unsigned)(h * HALF + sR[i]) * (unsigned)g.lda + (unsigned)sC[i]) * 2u;
    const size_t kstep = (size_t)(BK * 2);
    const size_t tstepB = (size_t)HALF * K * 2;
    const unsigned ldsw = (unsigned)wid * 1024u;
    const int aoff = lds_byte(wr * 64 + fr, fq * 8), boff = lds_byte(wc * 32 + fr, fq * 8);
#define AS_STAGE(bufoff, gbase, voff) do { _Pragma("unroll") for (int _i = 0; _i < 2; ++_i) \
        __builtin_amdgcn_global_load_lds((const unsigned*)((const char*)(gbase) + (voff)[_i]), (LAS unsigned*)(lds + (bufoff) + ldsw + _i * 8192), 16, 0, 0); } while (0)
#define AS_STAGE_A(kt, pm_) do { const char* ab_ = gA + (size_t)(pm_) * 256u * (size_t)g.lda * 2u + (size_t)(kt) * kstep; \
        AS_STAGE(((kt) * 2) * HTB, ab_, vA[0]); AS_STAGE(((kt) * 2 + 1) * HTB, ab_, vA[1]); } while (0)
#define AS_STAGE_B(ht, Bp, kt) AS_STAGE((4 + (ht)) * HTB, (Bp) + (size_t)(kt) * kstep, voffB)
#define AS_LD8(P) __builtin_shufflevector(*(const LAS v4i_t*)(P), *(const LAS v4i_t*)((P) + 1024), 0, 1, 2, 3, 4, 5, 6, 7)
#define AS_LOADF(kt, slot) do { \
        _Pragma("unroll") for (int n = 0; n < 2; ++n) b8[n] = AS_LD8(lds + (4 + (slot) * 2 + (kt)) * HTB + boff + n * 2048); \
        _Pragma("unroll") for (int a = 0; a < 2; ++a) _Pragma("unroll") for (int m = 0; m < 4; ++m) a8[a][m] = AS_LD8(lds + ((kt) * 2 + a) * HTB + aoff + m * 2048); } while (0)
#define AS_MMA() do { __builtin_amdgcn_s_setprio(1); \
        _Pragma("unroll") for (int a = 0; a < 2; ++a) _Pragma("unroll") for (int m = 0; m < 4; ++m) _Pragma("unroll") for (int n = 0; n < 2; ++n) \
            acc[a][0][m][n] = __builtin_amdgcn_mfma_scale_f32_16x16x128_f8f6f4(b8[n], a8[a][m], acc[a][0][m][n], 0, 0, 0, g.sa, 0, 0x7f7f7f7f); \
        __builtin_amdgcn_s_setprio(0); } while (0)
#define AS_ZERO() do { _Pragma("unroll") for (int a = 0; a < 2; ++a) _Pragma("unroll") for (int m = 0; m < 4; ++m) _Pragma("unroll") for (int n = 0; n < 2; ++n) acc[a][0][m][n] = (f32x4){0.f, 0.f, 0.f, 0.f}; } while (0)
#define AS_WAIT(N) asm volatile("s_waitcnt vmcnt(" #N ") lgkmcnt(0)" ::: "memory")
#define AS_LWAIT() do { asm volatile("s_waitcnt lgkmcnt(0)" ::: "memory"); __builtin_amdgcn_sched_barrier(0); } while (0)
    static_assert(Epi::NST == 8, "the counted waits below assume 8 stores per epilogue");
    Unit cur, nxt, prv; int ui = 0;
    if (!S.next(0, cur)) return;
    prv = cur;
    f32x4 acc[2][2][4][2];
    AS_ZERO();
    v8i_t b8[2], a8[2][4];
    bool has_next = S.next(1, nxt);
    const char* gA = (const char*)g.A;
    const char* cB = (const char*)g.Bt + (size_t)cur.pn * tstepB;
    AS_STAGE_A(0, cur.pm); AS_STAGE_A(1, cur.pm); AS_STAGE_B(0, cB, 0); AS_STAGE_B(1, cB, 1);
    bool switched = false;
    for (;;) {
        const char* nB = has_next ? (const char*)g.Bt + (size_t)nxt.pn * tstepB : cB;
        const int slot = ui & 1;
        if (ui == 0 || (GRP == 1 && ui == 1)) AS_WAIT(0); else AS_WAIT(8);
        __builtin_amdgcn_s_barrier();
        __builtin_amdgcn_sched_barrier(0);
        if (switched) {
            AS_STAGE_A(0, cur.pm); AS_STAGE_A(1, cur.pm);
            asm volatile("s_waitcnt vmcnt(0)" ::: "memory");
            __builtin_amdgcn_s_barrier();
            __builtin_amdgcn_sched_barrier(0);
        }
        AS_STAGE_B((slot ^ 1) * 2, nB, 0); AS_STAGE_B((slot ^ 1) * 2 + 1, nB, 1);
        if constexpr (GRP == 0) {
            AS_LOADF(0, slot); AS_LWAIT(); AS_MMA(); __builtin_amdgcn_sched_barrier(0);
            AS_LOADF(1, slot); AS_LWAIT(); AS_MMA(); __builtin_amdgcn_sched_barrier(0);
            E(acc, cur, wr, wc, fr, fq); AS_ZERO();
        } else {
            if (ui > 0) { AS_MMA(); __builtin_amdgcn_sched_barrier(0); E(acc, prv, wr, wc, fr, fq); AS_ZERO(); }
            __builtin_amdgcn_sched_barrier(0);
            AS_LOADF(0, slot); AS_LWAIT(); AS_MMA(); __builtin_amdgcn_sched_barrier(0);
            AS_LOADF(1, slot);
        }
        __builtin_amdgcn_sched_barrier(0);
        prv = cur;
        if (!has_next) break;
        switched = nxt.pm != cur.pm; cur = nxt; cB = nB; ++ui; has_next = S.next(ui + 1, nxt);
    }
    if constexpr (GRP == 1) { AS_LWAIT(); AS_MMA(); E(acc, prv, wr, wc, fr, fq); }
    asm volatile("s_waitcnt vmcnt(0)" ::: "memory");
    __builtin_amdgcn_s_barrier();
#undef AS_LOADF
#undef AS_MMA
#undef AS_WAIT
#undef AS_LWAIT
#undef AS_STAGE
#undef AS_STAGE_A
#undef AS_STAGE_B
#undef AS_LD8
#undef AS_ZERO
}
}


struct Frame {
    LAS unsigned char* lds;
    int tid, lane, wave, G, blk;
    const Params* p;
    unsigned char* ws;
};

DEVI float clamp_fp8(float x) { return __builtin_amdgcn_fmed3f(x, -440.f, 440.f); }
DEVI unsigned pack_fp8x4(float a, float b, float c, float d) { int p = __builtin_amdgcn_cvt_pk_fp8_f32(clamp_fp8(a), clamp_fp8(b), 0, false); p = __builtin_amdgcn_cvt_pk_fp8_f32(clamp_fp8(c), clamp_fp8(d), p, true); return (unsigned)p; }
template <class SrcF>
DEVI void transpose_item8(const SrcF& src, unsigned char* WT8, int K, int k0, int n0, LAS float* scr, int lane, float scale) {
#pragma unroll 8
    for (int i = 0; i < 32; ++i) { const int kk = 2 * i + (lane >> 5); scr[kk * 33 + (lane & 31)] = *src(k0 + kk, n0 + (lane & 31)); }
    LDS_WAIT(); asm volatile("" ::: "memory");
    const int n = lane >> 1, hf = lane & 1; const LAS float* sp = scr + (32 * hf) * 33 + n;
    u32x4 o0, o1;
#pragma unroll
    for (int q = 0; q < 4; ++q) { o0[q] = pack_fp8x4(sp[(4 * q) * 33] * scale, sp[(4 * q + 1) * 33] * scale, sp[(4 * q + 2) * 33] * scale, sp[(4 * q + 3) * 33] * scale);
        o1[q] = pack_fp8x4(sp[(16 + 4 * q) * 33] * scale, sp[(17 + 4 * q) * 33] * scale, sp[(18 + 4 * q) * 33] * scale, sp[(19 + 4 * q) * 33] * scale); }
    unsigned char* dst = WT8 + (size_t)(n0 + n) * K + k0 + 32 * hf;
    *(u32x4*)dst = o0; *(u32x4*)(dst + 16) = o1;
    LDS_WAIT(); asm volatile("" ::: "memory");
}
template <class SrcF>
DEVI void transpose_item(const SrcF& src, bf16_t* WT, int K, int k0, int n0, LAS float* scr, int lane) {
#pragma unroll 8
    for (int i = 0; i < 32; ++i) { const int kk = 2 * i + (lane >> 5); scr[kk * 33 + (lane & 31)] = *src(k0 + kk, n0 + (lane & 31)); }
    LDS_WAIT(); asm volatile("" ::: "memory");
    const int c = lane & 7;
#pragma unroll
    for (int j = 0; j < 4; ++j) { const int n = (lane >> 3) + 8 * j; const LAS float* s = scr + (8 * c) * 33 + n;
        u32x4 o; o.x = cvt_pk_bf16(s[0 * 33], s[1 * 33]); o.y = cvt_pk_bf16(s[2 * 33], s[3 * 33]); o.z = cvt_pk_bf16(s[4 * 33], s[5 * 33]); o.w = cvt_pk_bf16(s[6 * 33], s[7 * 33]);
        *(u32x4*)(WT + (size_t)(n0 + n) * K + k0 + 8 * c) = o; }
    LDS_WAIT(); asm volatile("" ::: "memory");
}
DEVI int win_src_col(int c) {
    const int sec = c >> 9, h = (c >> 7) & 3, s = c & 127;
    int ssec = sec;
    if (sec == 3) ssec = 4; else if (sec == 4) ssec = 5; else if (sec == 5) ssec = 6; else if (sec == 6) ssec = 3;
    int d = s;
    if (sec < 2) { const int wc = s >> 5, fq = (s >> 3) & 3, n = (s >> 2) & 1, i = s & 3; d = 64 * n + 16 * wc + 4 * fq + i; }
    return ssec * 512 + h * 128 + d;
}
struct SrcWin { const float* w; DEVI const float* operator()(int k, int n) const { return w + (size_t)k * INC + win_src_col(n); } };
struct SrcPlain { const float* w; int N; DEVI const float* operator()(int k, int n) const { return w + (size_t)k * N + n; } };
struct SrcGU { const float* wg; long dwu; DEVI const float* operator()(int k, int r) const {
        const int ff = 64 * (r >> 7) + 16 * ((r >> 5) & 3) + 4 * ((r >> 3) & 3) + (r & 3); const long sel = ((r >> 2) & 1) ? dwu : 0l; return wg + ((long)k * EFF + ff + sel); } };

DEVI void phase_prep(Frame& F) {
    const Params& P = *F.p;
    if (F.blk < 96) {
        LAS float* sc = (LAS float*)F.lds;
        LAS float* red = sc + 9 * 1024;
        for (int i = F.tid; i < 9 * 1024; i += NTHREADS) { const int v = i >> 10, k = i & 1023; const float cv = v < 8 ? P.in[I_C][v * DM + k] : P.in[I_CCTX][k]; sc[i] = cv / (1.f + __expf(-cv)); }
        __syncthreads();
        const int c = F.tid & 63, ks = F.tid >> 6, n = F.blk * 64 + c;
        float a[9];
#pragma unroll
        for (int v = 0; v < 9; ++v) a[v] = 0.f;
        const float* w = P.in[I_WMOD] + (size_t)(ks * 128) * 6144 + n;
#pragma unroll 16
        for (int k = 0; k < 128; ++k) { const float wv = w[(size_t)k * 6144];
#pragma unroll
            for (int v = 0; v < 9; ++v) a[v] += sc[v * 1024 + ks * 128 + k] * wv; }
#pragma unroll
        for (int v = 0; v < 9; ++v) red[(ks * 9 + v) * 64 + c] = a[v];
        __syncthreads();
        for (int i = F.tid; i < 9 * 64; i += NTHREADS) { const int v = i >> 6, cc = i & 63; float sum = P.in[I_BMOD][F.blk * 64 + cc];
#pragma unroll
            for (int q = 0; q < 8; ++q) sum += red[(q * 9 + v) * 64 + cc];
            ((float*)(F.ws + WS_MODP))[(size_t)v * 6144 + F.blk * 64 + cc] = sum; }
        __syncthreads();
    }
    for (int i = F.blk * NTHREADS + F.tid; i < 256 * 1024; i += F.G * NTHREADS) { const int r = i >> 10, k = i & 1023; bf16_t v = 0;
        if (r < 64) v = f2bf(P.in[I_WR][k * NE + r]);
        else if (r >= 128 && r < 192) { const float w = P.in[I_WR][k * NE + r - 128]; v = f2bf(w - bf2f(f2bf(w))); }
        ((bf16_t*)(F.ws + WS_WRT))[i] = v; }
    LAS float* scr = (LAS float*)(F.lds + 57344 + F.wave * 8704);
    const int gw = F.blk * NWAVES + F.wave, NGW = F.G * NWAVES;
    constexpr int I_IN = (DM / 64) * (PN / 32), I_OUT = (DM / 64) * (DM / 32);
    for (int it = gw; it < I_IN + I_OUT; it += NGW) {
        if (it < I_IN) { const int kb = it / (PN / 32), nb = it % (PN / 32); transpose_item(SrcWin{P.in[I_WIN]}, (bf16_t*)(F.ws + WS_WINT), DM, kb * 64, nb * 32, scr, F.lane); }
        else { const int r = it - I_IN, kb = r / (DM / 32), nb = r % (DM / 32); transpose_item(SrcPlain{P.in[I_WOUT], DM}, (bf16_t*)(F.ws + WS_WOUTT), DM, kb * 64, nb * 32, scr, F.lane); }
    }
}
DEVI float mod_value(Frame& F, int v, int n) { return ((const float*)(F.ws + WS_MODP))[(size_t)v * 6144 + n]; }

DEVI void phase_norm1(Frame& F) {
    const Params& P = *F.p;
    LAS float* WG = (LAS float*)F.lds;
    LAS float* MODS = (LAS float*)(F.lds + 65536);
    for (int i0 = 0; i0 < 16 * 1024; i0 += 8 * NTHREADS) { float tv[8];
#pragma unroll
        for (int q = 0; q < 8; ++q) { const int i = i0 + F.tid + q * NTHREADS; tv[q] = P.in[I_WIN][(size_t)(i >> 4) * INC + 4096 + (i & 15)]; }
#pragma unroll
        for (int q = 0; q < 8; ++q) { const int i = i0 + F.tid + q * NTHREADS; WG[(i & 15) * 1024 + (i >> 4)] = tv[q]; } }
    for (int i0 = 0; i0 < 9 * 2048; i0 += 12 * NTHREADS) { float tv[12];
#pragma unroll
        for (int q = 0; q < 12; ++q) { const int i = i0 + F.tid + q * NTHREADS; tv[q] = mod_value(F, i / 2048, i % 2048); }
#pragma unroll
        for (int q = 0; q < 12; ++q) { const int i = i0 + F.tid + q * NTHREADS; MODS[i] = (i % 2048) < 1024 ? tv[q] : 1.f + tv[q]; } }
    __syncthreads();
    const float* g0 = P.in[I_NORMG];
    f32x4 gv[4];
#pragma unroll
    for (int j = 0; j < 4; ++j) gv[j] = *(const f32x4*)(g0 + 256 * j + 4 * F.lane);
    float gb = 0.f; if (F.lane < 16) gb = P.in[I_GATEB][F.lane];
    f32x4 wreg[8][4];
#pragma unroll
    for (int gj = 0; gj < 8; ++gj)
#pragma unroll
        for (int j = 0; j < 4; ++j) wreg[gj][j] = *(const LAS f32x4*)(WG + gj * 1024 + 256 * j + 4 * F.lane);
    bf16_t* HL = (bf16_t*)(F.ws + WS_B); float* GT = (float*)(F.ws + WS_GATES);
    const int gw = F.blk * NWAVES + F.wave, NGW = F.G * NWAVES;
    f32x4 xn[4];
    if (gw < TT) { const float* xr = gw < T ? P.in[I_X] + (size_t)gw * DM : P.in[I_CTX] + (size_t)(gw - T) * DM;
#pragma unroll
        for (int j = 0; j < 4; ++j) xn[j] = *(const f32x4*)(xr + 256 * j + 4 * F.lane); }
    for (int row = gw; row < TT; row += NGW) {
        const int v = row < T ? (row >> 13) : 8;
        f32x4 x[4]; float ss = 0.f;
#pragma unroll
        for (int j = 0; j < 4; ++j) { x[j] = xn[j]; ss += x[j].x * x[j].x + x[j].y * x[j].y + x[j].z * x[j].z + x[j].w * x[j].w; }
        { const int nr = row + NGW; if (nr < TT) { const float* xr = nr < T ? P.in[I_X] + (size_t)nr * DM : P.in[I_CTX] + (size_t)(nr - T) * DM;
#pragma unroll
            for (int j = 0; j < 4; ++j) xn[j] = *(const f32x4*)(xr + 256 * j + 4 * F.lane); } }
        const float rstd = rsqrtf(wave_sum(ss) * (1.f / DM) + EPS);
        const LAS float* ms = MODS + v * 2048;
#pragma unroll
        for (int j = 0; j < 4; ++j) { const f32x4 sh = *(const LAS f32x4*)(ms + 256 * j + 4 * F.lane), sc = *(const LAS f32x4*)(ms + 1024 + 256 * j + 4 * F.lane);
            x[j] = (x[j] * rstd * gv[j]) * sc + sh;
            u32x2 o; o.x = cvt_pk_bf16(x[j].x, x[j].y); o.y = cvt_pk_bf16(x[j].z, x[j].w);
            *(u32x2*)(HL + (size_t)row * DM + 256 * j + 4 * F.lane) = o; }
        float ga[16];
#pragma unroll
        for (int gj = 0; gj < 16; ++gj) { float a = 0.f;
#pragma unroll
            for (int j = 0; j < 4; ++j) { f32x4 w; if (gj < 8) w = wreg[gj][j]; else w = *(const LAS f32x4*)(WG + gj * 1024 + 256 * j + 4 * F.lane);
                a += x[j].x * w.x + x[j].y * w.y + x[j].z * w.z + x[j].w * w.w; }
            ga[gj] = a; }
        float myg;
        {   const bool b0 = F.lane & 1, b1 = F.lane & 2, b2 = F.lane & 4, b3 = F.lane & 8;
            float g8[8], g4[4], g2[2];
#pragma unroll
            for (int j = 0; j < 8; ++j) g8[j] = (b0 ? ga[2 * j + 1] : ga[2 * j]) + dpp_x1(b0 ? ga[2 * j] : ga[2 * j + 1]);
#pragma unroll
            for (int j = 0; j < 4; ++j) g4[j] = (b1 ? g8[2 * j + 1] : g8[2 * j]) + dpp_x2(b1 ? g8[2 * j] : g8[2 * j + 1]);
#pragma unroll
            for (int j = 0; j < 2; ++j) g2[j] = (b2 ? g4[2 * j + 1] : g4[2 * j]) + dpp_x4(b2 ? g4[2 * j] : g4[2 * j + 1]);
            myg = (b3 ? g2[1] : g2[0]) + dpp_x8(b3 ? g2[0] : g2[1]);
            myg += __shfl_xor(myg, 16); myg += __shfl_xor(myg, 32); }
        if (F.lane < 16) GT[(size_t)row * 16 + F.lane] = myg + gb;
    }
}

struct SchedProj {
    int G, c;
    DEVI bool next(int i, pg8::Unit& u) const {
        const long L = (long)i * G + c;
        if (L < 4096) return pg8::static_unit(256, 16, L, u);
        const int j = (int)(L - 4096); if (j >= 64) return false;
        const int ct = j & 7; u.pm = 256 + (j >> 3); u.pn = (ct < 4 ? 2 + ct : 4 + ct); u.aux = 0; return true;
    }
    DEVI int arow(const pg8::Unit& u, int r) const { return u.pm * 256 + r; }
    static constexpr bool IDX_DMA = false; };
struct EpiProj {
    bf16_t* O;
    static constexpr bool PRE = false;
    DEVI void operator()(const f32x4 (&acc)[2][2][4][2], const pg8::Unit& u, int wr, int wc, int fr, int fq) const {
        const int row0 = u.pm * 256 + wr * 64 + fr, col0 = u.pn * 256 + wc * 32 + 8 * fq;
        const bool rope = (u.pn < 4) && (u.pm < 256);
        const float qs = (u.pn < 2) ? 0.08838834764831845f : 1.f;
        float f2[4];
#pragma unroll
        for (int i = 0; i < 4; ++i) f2[i] = exp2f(-(float)(16 * (wc & 1) + 4 * fq + i) * (13.287712379549449f / 32.f)) * 0.15915494309189535f;
#pragma unroll
        for (int ai = 0; ai < 2; ++ai)
#pragma unroll
            for (int m = 0; m < 4; ++m) {
                const int row = row0 + ai * 128 + m * 16; const int pos = row & (SEQ - 1);
                const float pp = (float)((wc < 2) ? (pos >> 6) : (pos & 63));
                float cs[4], sn[4];
                if (rope) {
#pragma unroll
                    for (int i = 0; i < 4; ++i) { const float rev = __builtin_amdgcn_fractf(pp * f2[i]); cs[i] = __builtin_amdgcn_cosf(rev); sn[i] = __builtin_amdgcn_sinf(rev); }
                }
                bf16_t* rowp = O + (size_t)row * PN + col0;
#pragma unroll
                for (int bj = 0; bj < 2; ++bj) { f32x4 v0 = acc[ai][bj][m][0], v1 = acc[ai][bj][m][1];
                    if (rope) {
#pragma unroll
                        for (int i = 0; i < 4; ++i) { const float t1 = v0[i], t2 = v1[i]; v0[i] = t1 * cs[i] - t2 * sn[i]; v1[i] = t2 * cs[i] + t1 * sn[i]; } }
                    v0 = v0 * qs; v1 = v1 * qs;
                    u32x4 w; w.x = cvt_pk_bf16(v0[0], v0[1]); w.y = cvt_pk_bf16(v0[2], v0[3]); w.z = cvt_pk_bf16(v1[0], v1[1]); w.w = cvt_pk_bf16(v1[2], v1[3]);
                    *(u32x4*)(rowp + bj * 128) = w; }
            }
    }
};
DEVI void phase_gemm_proj(Frame& F) {
    pg8::Gemm g{(const bf16_t*)(F.ws + WS_B), (const bf16_t*)(F.ws + WS_WINT), DM, DM};
    SchedProj S{F.G, F.blk}; EpiProj E{(bf16_t*)(F.ws + WS_PROJ)};
    pg8::gemm_phase(F.lds, g, S, E);
}

DEVI void phase_conv(Frame& F) {
    const Params& P = *F.p;
    const bf16_t* PR = (const bf16_t*)(F.ws + WS_PROJ); bf16_t* MQ = (bf16_t*)(F.ws + WS_B);
    const int cg = F.tid & 127, run = F.tid >> 7, c0 = cg * 8;
    float w0[8], w1[8], w2[8], bb[8];
#pragma unroll
    for (int i = 0; i < 8; ++i) { w0[i] = P.in[I_CONVW][c0 + i]; w1[i] = P.in[I_CONVW][1024 + c0 + i]; w2[i] = P.in[I_CONVW][2048 + c0 + i]; bb[i] = P.in[I_CONVB][c0 + i]; }
    const float osc = cg >= 64 ? 0.08838834764831845f : 1.f;
    for (int it = F.blk; it < TT / 64; it += F.G) {
        const int r0 = it * 64 + run * 16;
        const bool isctx = r0 >= T;
        if (isctx && cg < 64) continue;
        const int slen = isctx ? CTXL : SEQ, pos0 = isctx ? ((r0 - T) & (CTXL - 1)) : (r0 & (SEQ - 1));
        u32x4 prev = (u32x4){0u, 0u, 0u, 0u}, cur, nxt;
        if (pos0 > 0) prev = *(const u32x4*)(PR + (size_t)(r0 - 1) * PN + 1536 + c0);
        cur = *(const u32x4*)(PR + (size_t)r0 * PN + 1536 + c0);
        for (int t = 0; t < 16; ++t) {
            const int r = r0 + t;
            nxt = (u32x4){0u, 0u, 0u, 0u};
            if (pos0 + t + 1 < slen) nxt = *(const u32x4*)(PR + (size_t)(r + 1) * PN + 1536 + c0);
            float o[8];
#pragma unroll
            for (int q = 0; q < 4; ++q) {
                const float a0 = lo_bf(prev[q]), a1 = hi_bf(prev[q]), b0 = lo_bf(cur[q]), b1 = hi_bf(cur[q]), d0 = lo_bf(nxt[q]), d1 = hi_bf(nxt[q]);
                o[2 * q] = siluf_(w0[2 * q] * a0 + w1[2 * q] * b0 + w2[2 * q] * d0 + bb[2 * q]) * osc;
                o[2 * q + 1] = siluf_(w0[2 * q + 1] * a1 + w1[2 * q + 1] * b1 + w2[2 * q + 1] * d1 + bb[2 * q + 1]) * osc;
            }
            u32x4 w; w.x = cvt_pk_bf16(o[0], o[1]); w.y = cvt_pk_bf16(o[2], o[3]); w.z = cvt_pk_bf16(o[4], o[5]); w.w = cvt_pk_bf16(o[6], o[7]);
            *(u32x4*)(MQ + (size_t)r * DM + c0) = w;
            prev = cur; cur = nxt;
        }
    }
}

constexpr int LDT = 136;
constexpr int TILE_B = 128 * LDT * 2;
DEVI bf16x8 frag_rows(const LAS bf16_t* base, int row, int k) { return *(const LAS bf16x8*)(base + row * LDT + k); }
DEVI bf16x8 frag_cols(const LAS bf16_t* base, int k, int col) { bf16x8 v;
#pragma unroll
    for (int j = 0; j < 8; ++j) v[j] = (short)base[(k + j) * LDT + col];
    return v; }
DEVI void stage_tile(LAS bf16_t* dst, const bf16_t* src, size_t ld, int tid) {
#pragma unroll
    for (int i = 0; i < 4; ++i) { const int p = tid + NTHREADS * i, r = p >> 4, c = (p & 15) * 8; *(LAS u32x4*)(dst + r * LDT + c) = *(const u32x4*)(src + (size_t)r * ld + c); }
}
DEVI void stage_tile_scaled2(LAS bf16_t* d0, LAS bf16_t* d1, const LAS float* s0, const LAS float* s1, const bf16_t* src, size_t ld, int tid) {
#pragma unroll
    for (int i = 0; i < 4; ++i) { const int p = tid + NTHREADS * i, r = p >> 4, c = (p & 15) * 8; const u32x4 v = *(const u32x4*)(src + (size_t)r * ld + c);
        const float a = s0[r], b = s1[r]; u32x4 o0, o1;
#pragma unroll
        for (int q = 0; q < 4; ++q) { const float lo = lo_bf(v[q]), hi = hi_bf(v[q]); o0[q] = cvt_pk_bf16(lo * a, hi * a); o1[q] = cvt_pk_bf16(lo * b, hi * b); }
        *(LAS u32x4*)(d0 + r * LDT + c) = o0; *(LAS u32x4*)(d1 + r * LDT + c) = o1; }
}
typedef short v4i16_t __attribute__((ext_vector_type(4)));
DEVI bf16x8 frag_tr(const LAS bf16_t* base, int k, int c16, int fr) {
    const LAS bf16_t* p = base + (k + (fr >> 2)) * LDT + c16 + 4 * (fr & 3);
    const v4i16_t lo = __builtin_amdgcn_ds_read_tr16_b64_v4i16((LAS v4i16_t*)p), hi = __builtin_amdgcn_ds_read_tr16_b64_v4i16((LAS v4i16_t*)(p + 4 * LDT));
    return (bf16x8){lo[0], lo[1], lo[2], lo[3], hi[0], hi[1], hi[2], hi[3]};
}
template <bool MAXOP> DEVI float wave_incl_scan(float v, int lane) {
#pragma unroll
    for (int o = 1; o < 64; o <<= 1) { const float u = __shfl_up(v, o); if (lane >= o) v = MAXOP ? fmaxf(v, u) : v + u; }
    return v;
}
DEVI void mlstm_gates2(LAS float* vec, const float* GT, int row0, int h, int tid, int lane, int wave, float m_f, float m_b, bool need_mu) {
    const bool act = tid < 256, bw = tid >= 128; const int tau = bw ? 255 - tid : tid;
    float gi = 0.f, bsum = 0.f, a = 0.f, pm = 0.f;
    if (act) { const float* g = GT + (size_t)(row0 + tau) * 16; const float lf = logsigmoidf_(g[(bw ? 12 : 4) + h]); gi = g[(bw ? 8 : 0) + h];
        bsum = wave_incl_scan<false>(lf, lane); if (lane == 63) vec[3400 + wave] = bsum; }
    __syncthreads();
    if (act) { if (wave & 1) bsum += vec[3400 + wave - 1]; a = gi - bsum; vec[(bw ? 896 : 768) + tau] = bsum; vec[(bw ? 640 : 512) + tau] = a;
        pm = wave_incl_scan<true>(a, lane); if (lane == 63) vec[3404 + wave] = pm; }
    __syncthreads();
    if (act) { if (wave & 1) pm = fmaxf(pm, vec[3404 + wave - 1]);
        if (need_mu) vec[(bw ? 1408 : 1280) + tau] = fmaxf(bw ? m_b : m_f, pm);
        if (tid == 127) { vec[3410] = bsum; vec[3411] = pm; } if (tid == 255) { vec[3412] = bsum; vec[3413] = pm; } }
    __syncthreads();
}
DEVI void mlstm_gates3(LAS float* vec, float fg, float ig, int tid, int lane, int wave, float m_f, float m_b) {
    const bool act = tid < 256, bw = tid >= 128; const int tau = bw ? 255 - tid : tid;
    float bsum = 0.f, a = 0.f, pm = 0.f;
    if (act) { bsum = wave_incl_scan<false>(logsigmoidf_(fg), lane); if (lane == 63) vec[3400 + wave] = bsum; }
    __syncthreads();
    if (act) { if (wave & 1) bsum += vec[3400 + wave - 1]; a = ig - bsum; vec[(bw ? 896 : 768) + tau] = bsum; vec[(bw ? 640 : 512) + tau] = a;
        pm = wave_incl_scan<true>(a, lane); if (lane == 63) vec[3404 + wave] = pm; }
    __syncthreads();
    if (act) { if (wave & 1) pm = fmaxf(pm, vec[3404 + wave - 1]); vec[(bw ? 1408 : 1280) + tau] = fmaxf(bw ? m_b : m_f, pm);
        if (tid == 127) { vec[3410] = bsum; vec[3411] = pm; } if (tid == 255) { vec[3412] = bsum; vec[3413] = pm; } }
    __syncthreads();
}
DEVI void mlstm_chunk_gates(LAS float* vec, const float* GT, int row0, int h, int tid) {
    if (tid < 128) { const float* g = GT + (size_t)(row0 + tid) * 16;
        vec[tid] = logsigmoidf_(g[4 + h]); vec[128 + tid] = logsigmoidf_(g[12 + h]); vec[256 + tid] = g[h]; vec[384 + tid] = g[8 + h]; }
    __syncthreads();
    if (tid < 128) { float s = 0.f; for (int j = 0; j <= tid; ++j) s += vec[j]; vec[768 + tid] = s; vec[512 + tid] = vec[256 + tid] - s; }
    else if (tid < 256) { const int t = tid - 128; float s = 0.f; for (int j = 127; j >= t; --j) s += vec[128 + j]; vec[896 + t] = s; vec[640 + t] = vec[384 + t] - s; }
    __syncthreads();
}
DEVI size_t us_index(int ty, int b, int h, int dir, int slot) { return ((((size_t)(ty * 8 + b) * 4 + h) * 2 + dir) * NSLOT + slot) * 16384; }
DEVI size_t sm_index(int b, int h, int dir, int slot) { return (((size_t)b * 4 + h) * 2 + dir) * NSLOT + slot; }

DEVI void conv_tile_regs(u32x4 (&out)[4], const LAS bf16_t* Tl, const LAS bf16_t* halo, const float* cw, const float* cb, float oscale, int tid) {
    const int cc = (tid & 15) * 8;
    float w0[8], w1[8], w2[8], bb[8];
#pragma unroll
    for (int q = 0; q < 2; ++q) { const f32x4 a = *(const f32x4*)(cw + cc + 4 * q), b = *(const f32x4*)(cw + 1024 + cc + 4 * q), c = *(const f32x4*)(cw + 2048 + cc + 4 * q), d = *(const f32x4*)(cb + cc + 4 * q);
#pragma unroll
        for (int j = 0; j < 4; ++j) { w0[4 * q + j] = a[j]; w1[4 * q + j] = b[j]; w2[4 * q + j] = c[j]; bb[4 * q + j] = d[j]; } }
#pragma unroll
    for (int i = 0; i < 4; ++i) { const int r = (tid + NTHREADS * i) >> 4;
        const u32x4 cur = *(const LAS u32x4*)(Tl + r * LDT + cc);
        const LAS bf16_t* pp = r > 0 ? Tl + (r - 1) * LDT + cc : halo + cc; const LAS bf16_t* pn = r < 127 ? Tl + (r + 1) * LDT + cc : halo + 128 + cc;
        const u32x4 prev = *(const LAS u32x4*)pp, nxt = *(const LAS u32x4*)pn;
        float o[8];
#pragma unroll
        for (int q = 0; q < 4; ++q) {
            o[2 * q] = siluf_(w0[2 * q] * lo_bf(prev[q]) + w1[2 * q] * lo_bf(cur[q]) + w2[2 * q] * lo_bf(nxt[q]) + bb[2 * q]) * oscale;
            o[2 * q + 1] = siluf_(w0[2 * q + 1] * hi_bf(prev[q]) + w1[2 * q + 1] * hi_bf(cur[q]) + w2[2 * q + 1] * hi_bf(nxt[q]) + bb[2 * q + 1]) * oscale; }
        out[i].x = cvt_pk_bf16(o[0], o[1]); out[i].y = cvt_pk_bf16(o[2], o[3]); out[i].z = cvt_pk_bf16(o[4], o[5]); out[i].w = cvt_pk_bf16(o[6], o[7]); }
}

DEVI void phase_chunk_u(Frame& F) {
    const Params& P = *F.p;
    LAS bf16_t* Vs = (LAS bf16_t*)F.lds; LAS bf16_t* Kf = (LAS bf16_t*)(F.lds + TILE_B); LAS bf16_t* Kb = (LAS bf16_t*)(F.lds + 2 * TILE_B);
    LAS float* vec = (LAS float*)(F.lds + 3 * TILE_B);
    const bf16_t* PR = (const bf16_t*)(F.ws + WS_PROJ); const float* GT = (const float*)(F.ws + WS_GATES);
    bf16_t* US = (bf16_t*)(F.ws + WS_US);
    const int wr0 = F.wave >> 1, wc0 = F.wave & 1, fr0 = F.lane & 15, fq0 = F.lane >> 4;
    constexpr int NIT4 = 2 * 8 * 4 * NSLOT;
    u32x4 kreg[4], vreg[4], kcur[4], vcur[4], phalo = (u32x4){0u, 0u, 0u, 0u}; float pfg = 0.f, pig = 0.f;
    LAS bf16_t* HL = (LAS bf16_t*)(vec + 2432);
#define P4_ISSUE(IT) do { const int slot_ = (IT) % NSLOT, h_ = ((IT) / NSLOT) & 3, b_ = ((IT) / (NSLOT * 4)) & 7, ty_ = (IT) / (NSLOT * 32); \
        const int row0_ = slot_ < NCC ? T + b_ * CTXL + slot_ * CH : b_ * SEQ + (slot_ - NCC) * CH; \
        const bf16_t* ks_ = PR + (size_t)row0_ * PN + (ty_ == 0 ? 512 : 2048) + h_ * 128; const size_t kl_ = PN; \
        if (ty_ == 1 && F.tid < 32) { const int wh_ = F.tid >> 4; const int sl_ = slot_ < NCC ? slot_ : slot_ - NCC, ns_ = slot_ < NCC ? NCC : NCH; \
            const bool ok_ = wh_ ? (sl_ + 1 < ns_) : (sl_ > 0); phalo = (u32x4){0u, 0u, 0u, 0u}; \
            if (ok_) phalo = *(const u32x4*)(ks_ + (long)(wh_ ? 128 : -1) * (long)PN + (F.tid & 15) * 8); } \
        const bf16_t* vs_ = PR + (size_t)row0_ * PN + (ty_ == 0 ? 1024 : 2560) + h_ * 128; \
        _Pragma("unroll") for (int i = 0; i < 4; ++i) { const int p = F.tid + NTHREADS * i, r = p >> 4, c = (p & 15) * 8; kreg[i] = *(const u32x4*)(ks_ + (size_t)r * kl_ + c); vreg[i] = *(const u32x4*)(vs_ + (size_t)r * PN + c); } \
        if (ty_ == 1 && F.tid < 256) { const int bw_ = F.tid >> 7, tau_ = bw_ ? 255 - F.tid : F.tid; const float* g_ = GT + (size_t)(row0_ + tau_) * 16; pfg = g_[(bw_ ? 12 : 4) + h_]; pig = g_[(bw_ ? 8 : 0) + h_]; } } while (0)
    if (F.blk < NIT4) P4_ISSUE(F.blk);
    for (int it = F.blk; it < NIT4; it += F.G) {
        const int slot = it % NSLOT, h = (it / NSLOT) & 3, b = (it / (NSLOT * 4)) & 7, ty = it / (NSLOT * 32);
        int fr = fr0, fq = fq0, wr = wr0, wc = wc0;
        asm volatile("" : "+v"(fr), "+v"(fq), "+s"(wr), "+s"(wc));
        __syncthreads();
#pragma unroll
        for (int i = 0; i < 4; ++i) { kcur[i] = kreg[i]; vcur[i] = vreg[i]; }
        const float cfg = pfg, cig = pig; const u32x4 chalo = phalo;
        if (it + F.G < NIT4) P4_ISSUE(it + F.G);
        if (ty == 1) {
#pragma unroll
            for (int i = 0; i < 4; ++i) { const int p = F.tid + NTHREADS * i, r = p >> 4, c = (p & 15) * 8; *(LAS u32x4*)(Kf + r * LDT + c) = kcur[i]; }
            if (F.tid < 32) *(LAS u32x4*)(HL + (F.tid >> 4) * 128 + (F.tid & 15) * 8) = chalo;
            __syncthreads();
            conv_tile_regs(kcur, Kf, HL, P.in[I_CONVW] + 512 + h * 128, P.in[I_CONVB] + 512 + h * 128, 0.08838834764831845f, F.tid);
        }
        if (ty == 0) {
            const float lf = -expf(P.in[I_RDEC][h]) * 1.4426950408889634f, lb = -expf(P.in[I_RDEC][4 + h]) * 1.4426950408889634f;
            if (F.tid < 128) { vec[1024 + F.tid] = exp2f((float)(127 - F.tid) * lf); vec[1152 + F.tid] = exp2f((float)F.tid * lb); }
        } else {
            mlstm_gates3(vec, cfg, cig, F.tid, F.lane, F.wave, 0.f, 0.f);
            const float mf = vec[3411], mb = vec[3413];
            if (F.tid < 128) { vec[1024 + F.tid] = __expf(vec[512 + F.tid] - mf); vec[1152 + F.tid] = __expf(vec[640 + F.tid] - mb); }
            if (F.tid == 0) { float* chs = (float*)(F.ws + WS_CHS);
                chs[sm_index(b, h, 0, slot) * 2 + 0] = vec[3410]; chs[sm_index(b, h, 0, slot) * 2 + 1] = mf;
                chs[sm_index(b, h, 1, slot) * 2 + 0] = vec[3412]; chs[sm_index(b, h, 1, slot) * 2 + 1] = mb; }
        }
        __syncthreads();
#pragma unroll
        for (int i = 0; i < 4; ++i) { const int p = F.tid + NTHREADS * i, r = p >> 4, c = (p & 15) * 8;
            *(LAS u32x4*)(Vs + r * LDT + c) = vcur[i];
            const float wa = vec[1024 + r], wb = vec[1152 + r]; u32x4 o0, o1;
#pragma unroll
            for (int q = 0; q < 4; ++q) { const float lo = lo_bf(kcur[i][q]), hi = hi_bf(kcur[i][q]); o0[q] = cvt_pk_bf16(lo * wa, hi * wa); o1[q] = cvt_pk_bf16(lo * wb, hi * wb); }
            *(LAS u32x4*)(Kf + r * LDT + c) = o0; *(LAS u32x4*)(Kb + r * LDT + c) = o1; }
        __syncthreads();
        f32x4 af[2][4], ab[2][4];
#pragma unroll
        for (int m = 0; m < 2; ++m)
#pragma unroll
            for (int n = 0; n < 4; ++n) { af[m][n] = (f32x4){0.f, 0.f, 0.f, 0.f}; ab[m][n] = (f32x4){0.f, 0.f, 0.f, 0.f}; }
#pragma unroll 1
        for (int ks = 0; ks < 4; ++ks) {
            bf16x8 kf2[2], kb2[2];
#pragma unroll
            for (int m = 0; m < 2; ++m) { kf2[m] = frag_tr(Kf, ks * 32 + 8 * fq, 32 * wr + 16 * m, fr); kb2[m] = frag_tr(Kb, ks * 32 + 8 * fq, 32 * wr + 16 * m, fr); }
#pragma unroll
            for (int n = 0; n < 4; ++n) { const bf16x8 bv = frag_tr(Vs, ks * 32 + 8 * fq, 64 * wc + 16 * n, fr);
#pragma unroll
                for (int m = 0; m < 2; ++m) { af[m][n] = __builtin_amdgcn_mfma_f32_16x16x32_bf16(kf2[m], bv, af[m][n], 0, 0, 0); ab[m][n] = __builtin_amdgcn_mfma_f32_16x16x32_bf16(kb2[m], bv, ab[m][n], 0, 0, 0); } }
        }
        if (ty == 1 && F.tid < 256) {
            const int dir = F.tid >> 7, d = F.tid & 127; const LAS bf16_t* kk = dir ? Kb : Kf; float s = 0.f;
#pragma unroll 8
            for (int t = 0; t < 128; ++t) s += bf2f(kk[t * LDT + d]);
            ((float*)(F.ws + WS_UN))[sm_index(b, h, dir, slot) * 128 + d] = s;
        }
        __syncthreads();
#pragma unroll
        for (int m = 0; m < 2; ++m)
#pragma unroll
            for (int n = 0; n < 4; ++n) { const int e = 64 * wc + 16 * n + fr, d0 = 32 * wr + 16 * m + 4 * fq;
                u32x2 o; o.x = cvt_pk_bf16(af[m][n][0], af[m][n][1]); o.y = cvt_pk_bf16(af[m][n][2], af[m][n][3]); *(LAS u32x2*)(Kf + e * LDT + d0) = o;
                o.x = cvt_pk_bf16(ab[m][n][0], ab[m][n][1]); o.y = cvt_pk_bf16(ab[m][n][2], ab[m][n][3]); *(LAS u32x2*)(Kb + e * LDT + d0) = o; }
        __syncthreads();
        bf16_t* uf = US + us_index(ty, b, h, 0, slot); bf16_t* ub = US + us_index(ty, b, h, 1, slot);
#pragma unroll
        for (int i = 0; i < 4; ++i) { const int p = F.tid + NTHREADS * i, r = p >> 4, c = (p & 15) * 8;
            *(u32x4*)(uf + r * 128 + c) = *(const LAS u32x4*)(Kf + r * LDT + c); *(u32x4*)(ub + r * 128 + c) = *(const LAS u32x4*)(Kb + r * LDT + c); }
    }
#undef P4_ISSUE
}

DEVI int scan_slot(int dir, int s) { return dir == 0 ? s : (s < NCC ? (NCC - 1 - s) : (NSLOT - 1 - (s - NCC))); }
DEVI void phase_scan_states(Frame& F) {
    const Params& P = *F.p;
    bf16_t* US = (bf16_t*)(F.ws + WS_US);
    for (int it = F.blk; it < 256; it += F.G) {
        const int half = it & 1, chain = it >> 1, dir = chain & 1, h = (chain >> 1) & 3, b = (chain >> 3) & 7, ty = chain >> 6;
        bf16_t* base = US + us_index(ty, b, h, dir, 0) + half * 8192 + F.tid * 16;
        float st[16];
#pragma unroll
        for (int i = 0; i < 16; ++i) st[i] = 0.f;
        float m = 0.f, nst = 0.f;
        const float gdec = ty == 0 ? expf(-expf(P.in[I_RDEC][dir * 4 + h]) * 128.f) : 0.f;
        const float* chs = (const float*)(F.ws + WS_CHS) + sm_index(b, h, dir, 0) * 2;
        float* smv = (float*)(F.ws + WS_SM) + sm_index(b, h, dir, 0);
        float* un = (float*)(F.ws + WS_UN) + sm_index(b, h, dir, 0) * 128;
        const bool do_n = (ty == 1) && half == 0 && F.tid < 128;
        u32x4 q0[6], q1[6];
#pragma unroll
        for (int j = 0; j < 6; ++j) { const bf16_t* p = base + (size_t)scan_slot(dir, j) * 16384; q0[j] = *(const u32x4*)p; q1[j] = *(const u32x4*)(p + 8); }
        for (int s3 = 0; s3 < NSLOT; s3 += 6) {
#pragma unroll
            for (int j = 0; j < 6; ++j) {
                const int s = s3 + j; const int slot = scan_slot(dir, s);
                bf16_t* p = base + (size_t)slot * 16384;
                const u32x4 u0 = q0[j], u1 = q1[j];
                if (s + 6 < NSLOT) { const bf16_t* pn = base + (size_t)scan_slot(dir, s + 6) * 16384; q0[j] = *(const u32x4*)pn; q1[j] = *(const u32x4*)(pn + 8); }
                float dec = gdec, du = 1.f;
                if (ty == 1) { const float btot = chs[slot * 2], amax = chs[slot * 2 + 1]; const float mloc = btot + amax, mn = fmaxf(btot + m, mloc);
                    dec = __expf(btot + m - mn); du = __expf(mloc - mn);
                    if (half == 0 && F.tid == 0 && slot >= NCC) smv[slot] = m;
                    m = mn; }
                if (slot >= NCC) { u32x4 o0, o1;
#pragma unroll
                    for (int q = 0; q < 4; ++q) { o0[q] = cvt_pk_bf16(st[2 * q], st[2 * q + 1]); o1[q] = cvt_pk_bf16(st[8 + 2 * q], st[8 + 2 * q + 1]); }
                    *(u32x4*)p = o0; *(u32x4*)(p + 8) = o1; }
#pragma unroll
                for (int q = 0; q < 4; ++q) { st[2 * q] = dec * st[2 * q] + du * lo_bf(u0[q]); st[2 * q + 1] = dec * st[2 * q + 1] + du * hi_bf(u0[q]);
                    st[8 + 2 * q] = dec * st[8 + 2 * q] + du * lo_bf(u1[q]); st[8 + 2 * q + 1] = dec * st[8 + 2 * q + 1] + du * hi_bf(u1[q]); }
                if (do_n) { const float uv = un[slot * 128 + F.tid]; if (slot >= NCC) un[slot * 128 + F.tid] = nst; nst = dec * nst + du * uv; }
            }
        }
    }
}

DEVI void phase_chunk_out(Frame& F) {
    const Params& P = *F.p;
    LAS bf16_t* Qs = (LAS bf16_t*)F.lds; LAS bf16_t* R1 = (LAS bf16_t*)(F.lds + TILE_B); LAS bf16_t* Vs = (LAS bf16_t*)(F.lds + 2 * TILE_B); LAS bf16_t* R3 = (LAS bf16_t*)(F.lds + 3 * TILE_B);
    LAS float* Ot = (LAS float*)F.lds; constexpr int LDO = 132;
    LAS float* vec = (LAS float*)(F.lds + 4 * TILE_B);
    bf16_t* PR = (bf16_t*)(F.ws + WS_PROJ); const float* GT = (const float*)(F.ws + WS_GATES);
    const bf16_t* US = (const bf16_t*)(F.ws + WS_US);
    const int wr0 = F.wave >> 1, wc0 = F.wave & 1, fr0 = F.lane & 15, fq0 = F.lane >> 4, w0 = F.wave;
    u32x4 qreg[4], kreg[4], vreg[4], phalo = (u32x4){0u, 0u, 0u, 0u}; float pfg = 0.f, pig = 0.f, pnv = 0.f, pmf = 0.f, pmb = 0.f;
    LAS bf16_t* HL = (LAS bf16_t*)(vec + 2432);
#define P6_ISSUE(JJ) do { const int rt_ = F.blk + ((JJ) >> 4) * F.G, kk_ = (JJ) & 15; const int c_ = 2 * (rt_ & 31) + (kk_ & 1), h_ = (kk_ >> 1) & 3, b_ = rt_ >> 5, ty_ = kk_ >> 3; const int row0_ = b_ * SEQ + c_ * CH, slot_ = NCC + c_; \
        const bf16_t* qs_ = PR + (size_t)row0_ * PN + (ty_ == 0 ? 0 : 1536) + h_ * 128; const size_t ql_ = PN; \
        if (ty_ == 1 && tidv < 64) { const int tl_ = tidv >> 5, wh_ = (tidv >> 4) & 1; const bool ok_ = wh_ ? (c_ + 1 < NCH) : (c_ > 0); phalo = (u32x4){0u, 0u, 0u, 0u}; \
            if (ok_) phalo = *(const u32x4*)(qs_ + tl_ * 512 + (long)(wh_ ? 128 : -1) * (long)PN + (tidv & 15) * 8); } \
        const bf16_t* vs_ = PR + (size_t)row0_ * PN + (ty_ == 0 ? 1024 : 2560) + h_ * 128; \
        _Pragma("unroll") for (int i = 0; i < 4; ++i) { const int p = tidv + NTHREADS * i, r = p >> 4, cc = (p & 15) * 8; \
            qreg[i] = *(const u32x4*)(qs_ + (size_t)r * ql_ + cc); kreg[i] = *(const u32x4*)(qs_ + 512 + (size_t)r * ql_ + cc); vreg[i] = *(const u32x4*)(vs_ + (size_t)r * PN + cc); } \
        if (ty_ == 1) { pmf = ((const float*)(F.ws + WS_SM))[sm_index(b_, h_, 0, slot_)]; pmb = ((const float*)(F.ws + WS_SM))[sm_index(b_, h_, 1, slot_)]; \
            if (tidv < 256) { const int bw_ = tidv >> 7, tau_ = bw_ ? 255 - tidv : tidv; const float* g_ = GT + (size_t)(row0_ + tau_) * 16; \
                pfg = g_[(bw_ ? 12 : 4) + h_]; pig = g_[(bw_ ? 8 : 0) + h_]; pnv = ((const float*)(F.ws + WS_UN))[sm_index(b_, h_, bw_, slot_) * 128 + (tidv & 127)]; } } } while (0)
    int tidv = F.tid;
    const int njj = F.blk < T / 256 ? 16 * ((T / 256 - 1 - F.blk) / F.G + 1) : 0;
    if (njj > 0) P6_ISSUE(0);
    for (int jj = 0; jj < njj; ++jj) {
        const int rt = F.blk + (jj >> 4) * F.G, kk = jj & 15;
        const int c = 2 * (rt & 31) + (kk & 1), h = (kk >> 1) & 3, b = rt >> 5, ty = kk >> 3;
        const int row0 = b * SEQ + c * CH, slot = NCC + c;
        int fr = fr0, fq = fq0, wr = wr0, wc = wc0, wv = w0;
        tidv = F.tid;
        asm volatile("" : "+v"(fr), "+v"(fq), "+v"(tidv), "+s"(wr), "+s"(wc), "+s"(wv));
        __syncthreads();
#pragma unroll
        for (int i = 0; i < 4; ++i) { const int p = tidv + NTHREADS * i, r = p >> 4, cc = (p & 15) * 8;
            *(LAS u32x4*)(Qs + r * LDT + cc) = qreg[i]; *(LAS u32x4*)(R1 + r * LDT + cc) = kreg[i]; *(LAS u32x4*)(Vs + r * LDT + cc) = vreg[i]; }
        const float m_f = pmf, m_b = pmb;
        if (ty == 1) {
            if (tidv < 64) *(LAS u32x4*)(HL + (tidv >> 4) * 128 + (tidv & 15) * 8) = phalo;
            __syncthreads();
            u32x4 cq[4], ck[4];
            conv_tile_regs(cq, Qs, HL, P.in[I_CONVW] + h * 128, P.in[I_CONVB] + h * 128, 1.f, tidv);
            conv_tile_regs(ck, R1, HL + 256, P.in[I_CONVW] + 512 + h * 128, P.in[I_CONVB] + 512 + h * 128, 0.08838834764831845f, tidv);
            __syncthreads();
#pragma unroll
            for (int i = 0; i < 4; ++i) { const int p = tidv + NTHREADS * i, r = p >> 4, cc = (p & 15) * 8; *(LAS u32x4*)(Qs + r * LDT + cc) = cq[i]; *(LAS u32x4*)(R1 + r * LDT + cc) = ck[i]; }
        }
        const bf16_t* sfp = US + us_index(ty, b, h, 0, slot); const bf16_t* sbp = US + us_index(ty, b, h, 1, slot);
        u32x4 s0[4], s1[4];
#pragma unroll
        for (int i = 0; i < 4; ++i) { const int p = tidv + NTHREADS * i, r = p >> 4, cc = (p & 15) * 8; s0[i] = *(const u32x4*)(sfp + r * 128 + cc); s1[i] = *(const u32x4*)(sbp + r * 128 + cc); }
        float lgf = 0.f, lgb = 0.f;
        if (ty == 0) {
            lgf = -expf(P.in[I_RDEC][h]) * 1.4426950408889634f; lgb = -expf(P.in[I_RDEC][4 + h]) * 1.4426950408889634f;
            if (tidv < 128) { vec[1024 + tidv] = __builtin_amdgcn_exp2f((float)(tidv + 1) * lgf); vec[1152 + tidv] = __builtin_amdgcn_exp2f((float)(128 - tidv) * lgb); }
            __syncthreads();
        } else {
            if (tidv < 256) vec[1792 + tidv] = pnv;
            mlstm_gates3(vec, pfg, pig, tidv, F.lane, F.wave, m_f, m_b);
            {
                const int t = tidv >> 2, qq = tidv & 3; float sf = 0.f, sb = 0.f;
#pragma unroll 4
                for (int d = qq * 32; d < qq * 32 + 32; d += 2) { const unsigned qv = *(const LAS unsigned*)(Qs + t * LDT + d); const float q0 = lo_bf(qv), q1 = hi_bf(qv);
                    sf += q0 * vec[1792 + d] + q1 * vec[1792 + d + 1]; sb += q0 * vec[1920 + d] + q1 * vec[1920 + d + 1]; }
                sf = quad_sum(sf); sb = quad_sum(sb);
                if (qq == 0) { vec[2048 + t] = sf; vec[2176 + t] = sb; }
            }
        }
        f32x4 g[8];
#pragma unroll
        for (int m = 0; m < 8; ++m) g[m] = (f32x4){0.f, 0.f, 0.f, 0.f};
#pragma unroll 1
        for (int ks = 0; ks < 4; ++ks) {
            const bf16x8 bq = frag_rows(Qs, 16 * wv + fr, ks * 32 + 8 * fq);
#pragma unroll
            for (int m = 0; m < 8; ++m) { const bf16x8 ak = frag_rows(R1, 16 * m + fr, ks * 32 + 8 * fq); g[m] = __builtin_amdgcn_mfma_f32_16x16x32_bf16(ak, bq, g[m], 0, 0, 0); }
        }
        __syncthreads();
        {
            const int t = 16 * wv + fr;
            if (ty == 0) {
#pragma unroll
                for (int m = 0; m < 8; ++m) { float pv[4];
                    if (m < wv) {
#pragma unroll
                        for (int r = 0; r < 4; ++r) pv[r] = g[m][r] * __builtin_amdgcn_exp2f((float)(t - (16 * m + 4 * fq + r)) * lgf);
                    } else if (m > wv) {
#pragma unroll
                        for (int r = 0; r < 4; ++r) pv[r] = g[m][r] * __builtin_amdgcn_exp2f((float)((16 * m + 4 * fq + r) - t) * lgb);
                    } else {
#pragma unroll
                        for (int r = 0; r < 4; ++r) { const int dl = t - (16 * m + 4 * fq + r);
                            const float w = dl > 0 ? __builtin_amdgcn_exp2f((float)dl * lgf) : (dl < 0 ? __builtin_amdgcn_exp2f((float)(-dl) * lgb) : 2.f); pv[r] = g[m][r] * w; }
                    }
                    u32x2 o; o.x = cvt_pk_bf16(pv[0], pv[1]); o.y = cvt_pk_bf16(pv[2], pv[3]); *(LAS u32x2*)(R1 + t * LDT + 16 * m + 4 * fq) = o; }
            } else {
                const float muf = vec[1280 + t], mub = vec[1408 + t]; float rsf = 0.f, rsb = 0.f;
                f32x4 sb4[8];
#pragma unroll
                for (int m = 0; m < 8; ++m) {
                    if (m < wv) {
                        const f32x4 av = *(const LAS f32x4*)(vec + 512 + 16 * m + 4 * fq);
#pragma unroll
                        for (int r = 0; r < 4; ++r) { const float sf = g[m][r] * __expf(av[r] - muf); g[m][r] = sf; rsf += sf; }
                        sb4[m] = (f32x4){0.f, 0.f, 0.f, 0.f};
                    } else if (m > wv) {
                        const f32x4 bv = *(const LAS f32x4*)(vec + 640 + 16 * m + 4 * fq);
#pragma unroll
                        for (int r = 0; r < 4; ++r) { const float sb = g[m][r] * __expf(bv[r] - mub); sb4[m][r] = sb; rsb += sb; }
                        g[m] = (f32x4){0.f, 0.f, 0.f, 0.f};
                    } else {
                        const f32x4 av = *(const LAS f32x4*)(vec + 512 + 16 * m + 4 * fq), bv = *(const LAS f32x4*)(vec + 640 + 16 * m + 4 * fq);
#pragma unroll
                        for (int r = 0; r < 4; ++r) { const int tp = 16 * m + 4 * fq + r; const float gv = g[m][r];
                            const float sf = tp <= t ? gv * __expf(av[r] - muf) : 0.f, sb = tp >= t ? gv * __expf(bv[r] - mub) : 0.f;
                            g[m][r] = sf; sb4[m][r] = sb; rsf += sf; rsb += sb; }
                    } }
                rsf += __shfl_xor(rsf, 16); rsf += __shfl_xor(rsf, 32); rsb += __shfl_xor(rsb, 16); rsb += __shfl_xor(rsb, 32);
                const float interf = __expf(m_f - muf), interb = __expf(m_b - mub);
                const float denf = rsf + interf * vec[2048 + t], denb = rsb + interb * vec[2176 + t];
                const float rDf = __builtin_amdgcn_rcpf(fmaxf(fabsf(denf), __expf(-(vec[768 + t] + muf)))), rDb = __builtin_amdgcn_rcpf(fmaxf(fabsf(denb), __expf(-(vec[896 + t] + mub))));
                if (fq == 0) { vec[1024 + t] = interf * rDf; vec[1152 + t] = interb * rDb; }
#pragma unroll
                for (int m = 0; m < 8; ++m) { const f32x4 pv = g[m] * rDf + sb4[m] * rDb;
                    u32x2 o; o.x = cvt_pk_bf16(pv[0], pv[1]); o.y = cvt_pk_bf16(pv[2], pv[3]); *(LAS u32x2*)(R1 + t * LDT + 16 * m + 4 * fq) = o; }
            }
        }
        f32x4 o1[2][4];
        {
            f32x4 o2[2][4], o3[2][4];
#pragma unroll
            for (int m = 0; m < 2; ++m)
#pragma unroll
                for (int n = 0; n < 4; ++n) { o2[m][n] = (f32x4){0.f, 0.f, 0.f, 0.f}; o3[m][n] = (f32x4){0.f, 0.f, 0.f, 0.f}; }
#define P6_QS(ACC) do { _Pragma("unroll 1") for (int ks = 0; ks < 4; ++ks) { bf16x8 aq[2]; \
                _Pragma("unroll") for (int m = 0; m < 2; ++m) aq[m] = frag_rows(Qs, 32 * wr + 16 * m + fr, ks * 32 + 8 * fq); \
                _Pragma("unroll") for (int n = 0; n < 4; ++n) { const bf16x8 bs = frag_rows(R3, 64 * wc + 16 * n + fr, ks * 32 + 8 * fq); \
                    _Pragma("unroll") for (int m = 0; m < 2; ++m) ACC[m][n] = __builtin_amdgcn_mfma_f32_16x16x32_bf16(aq[m], bs, ACC[m][n], 0, 0, 0); } } } while (0)
#pragma unroll
            for (int i = 0; i < 4; ++i) { const int p = tidv + NTHREADS * i, r = p >> 4, cc = (p & 15) * 8; *(LAS u32x4*)(R3 + r * LDT + cc) = s0[i]; }
            __syncthreads();
            P6_QS(o2);
            __syncthreads();
#pragma unroll
            for (int i = 0; i < 4; ++i) { const int p = tidv + NTHREADS * i, r = p >> 4, cc = (p & 15) * 8; *(LAS u32x4*)(R3 + r * LDT + cc) = s1[i]; }
            __syncthreads();
            P6_QS(o3);
#pragma unroll
            for (int m = 0; m < 2; ++m)
#pragma unroll
                for (int r = 0; r < 4; ++r) { const int t = 32 * wr + 16 * m + 4 * fq + r; const float cf = vec[1024 + t], cb = vec[1152 + t];
#pragma unroll
                    for (int n = 0; n < 4; ++n) o1[m][n][r] = cf * o2[m][n][r] + cb * o3[m][n][r]; }
        }
        const float* gain = (ty == 0 ? P.in[I_RNG] : P.in[I_MNG]) + h * 128;
        bf16_t* obase = PR + (size_t)row0 * PN + 3072 + ty * 512 + h * 128;
        u32x4 gt[4];
#pragma unroll
        for (int i = 0; i < 4; ++i) { const int p = tidv + NTHREADS * i, r = p >> 4, cc = (p & 15) * 8; gt[i] = *(const u32x4*)(obase + (size_t)r * PN + cc); }
        if (jj + 1 < njj) P6_ISSUE(jj + 1);
#pragma unroll 1
        for (int ks = 0; ks < 4; ++ks) {
            bf16x8 ap[2];
#pragma unroll
            for (int m = 0; m < 2; ++m) ap[m] = frag_rows(R1, 32 * wr + 16 * m + fr, ks * 32 + 8 * fq);
#pragma unroll
            for (int n = 0; n < 4; ++n) { const bf16x8 bv = frag_tr(Vs, ks * 32 + 8 * fq, 64 * wc + 16 * n, fr);
#pragma unroll
                for (int m = 0; m < 2; ++m) o1[m][n] = __builtin_amdgcn_mfma_f32_16x16x32_bf16(ap[m], bv, o1[m][n], 0, 0, 0); }
        }
        __syncthreads();
#pragma unroll
        for (int m = 0; m < 2; ++m)
#pragma unroll
            for (int n = 0; n < 4; ++n)
#pragma unroll
                for (int r = 0; r < 4; ++r) Ot[(32 * wr + 16 * m + 4 * fq + r) * LDO + 64 * wc + 16 * n + fr] = o1[m][n][r];
        __syncthreads();
#pragma unroll
        for (int i = 0; i < 4; ++i) { const int p = tidv + NTHREADS * i, r = p >> 4, cc = (p & 15) * 8;
            const f32x4 a0 = *(const LAS f32x4*)(Ot + r * LDO + cc), a1 = *(const LAS f32x4*)(Ot + r * LDO + cc + 4);
            float sm = (a0.x + a0.y) + (a0.z + a0.w) + (a1.x + a1.y) + (a1.z + a1.w);
            float sq = (a0.x * a0.x + a0.y * a0.y) + (a0.z * a0.z + a0.w * a0.w) + (a1.x * a1.x + a1.y * a1.y) + (a1.z * a1.z + a1.w * a1.w);
            sm = row16_sum(sm); sq = row16_sum(sq);
            const float mean = sm * (1.f / 128.f), rstd = __builtin_amdgcn_rsqf(fmaxf(sq * (1.f / 128.f) - mean * mean, 0.f) + EPS);
            const f32x4 g0 = *(const f32x4*)(gain + cc), g1 = *(const f32x4*)(gain + cc + 4);
            float y[8]; const float av[8] = {a0.x, a0.y, a0.z, a0.w, a1.x, a1.y, a1.z, a1.w}; const float gn[8] = {g0.x, g0.y, g0.z, g0.w, g1.x, g1.y, g1.z, g1.w};
#pragma unroll
            for (int q = 0; q < 4; ++q) { const float t0 = lo_bf(gt[i][q]), t1 = hi_bf(gt[i][q]);
                const float c0 = ty == 0 ? siluf_(t0) : sigmoidf_(t0), c1 = ty == 0 ? siluf_(t1) : sigmoidf_(t1);
                y[2 * q] = (av[2 * q] - mean) * rstd * gn[2 * q] * c0; y[2 * q + 1] = (av[2 * q + 1] - mean) * rstd * gn[2 * q + 1] * c1; }
            u32x4 o; o.x = cvt_pk_bf16(y[0], y[1]); o.y = cvt_pk_bf16(y[2], y[3]); o.z = cvt_pk_bf16(y[4], y[5]); o.w = cvt_pk_bf16(y[6], y[7]);
            *(u32x4*)(obase + (size_t)r * PN + cc) = o; }
    }
#undef P6_ISSUE
#undef P6_QS
}

struct SchedY { int G, c;
    DEVI bool next(int i, pg8::Unit& u) const { return pg8::static_unit(256, 4, (long)i * G + c, u); }
    DEVI int arow(const pg8::Unit& u, int r) const { return u.pm * 256 + r; }
    static constexpr bool IDX_DMA = false; };
struct EpiBf16 { bf16_t* O; int ldc;
    static constexpr bool PRE = false;
    DEVI void operator()(const f32x4 (&acc)[2][2][4][2], const pg8::Unit& u, int wr, int wc, int fr, int fq) const {
        const int row0 = u.pm * 256 + wr * 64 + fr, col0 = u.pn * 256 + wc * 32 + 8 * fq;
#pragma unroll
        for (int ai = 0; ai < 2; ++ai)
#pragma unroll
            for (int m = 0; m < 4; ++m) { bf16_t* rowp = O + (size_t)(row0 + ai * 128 + m * 16) * ldc + col0;
#pragma unroll
                for (int bj = 0; bj < 2; ++bj) { const f32x4 v0 = acc[ai][bj][m][0], v1 = acc[ai][bj][m][1];
                    u32x4 w; w.x = cvt_pk_bf16(v0[0], v0[1]); w.y = cvt_pk_bf16(v0[2], v0[3]); w.z = cvt_pk_bf16(v1[0], v1[1]); w.w = cvt_pk_bf16(v1[2], v1[3]);
                    *(u32x4*)(rowp + bj * 128) = w; } }
    } };
DEVI void expert_weight_copies(Frame& F) {
    const Params& P = *F.p;
    __syncthreads();
    LAS float* scr = (LAS float*)(F.lds + F.wave * 8704);
    const int gw = F.blk * NWAVES + F.wave, NGW = F.G * NWAVES;
    constexpr int IGU = 16 * 16, IDN = 4 * 32;
    for (int it = gw; it < 65 * (IGU + IDN); it += NGW) {
        const int e = it / (IGU + IDN), r = it % (IGU + IDN);
        if (r < IGU) { const int kb = r >> 4, nb = r & 15;
            const float* wg = e < 64 ? P.in[I_WG] + (size_t)e * DM * EFF : P.in[I_SG]; const float* wu = e < 64 ? P.in[I_WU] + (size_t)e * DM * EFF : P.in[I_SU];
            transpose_item8(SrcGU{wg, (long)(wu - wg)}, (unsigned char*)(F.ws + WS_WGU) + (size_t)e * 512 * DM, DM, kb * 64, nb * 32, scr, F.lane, W_SCALE_GU); }
        else { const int q = r - IGU, kb = q >> 5, nb = q & 31;
            const float* wd = e < 64 ? P.in[I_WDN] + (size_t)e * EFF * DM : P.in[I_SD];
            transpose_item8(SrcPlain{wd, DM}, (unsigned char*)(F.ws + WS_WD) + (size_t)e * DM * EFF, EFF, kb * 64, nb * 32, scr, F.lane, W_SCALE_DN); }
    }
}
struct SchedRowTiles { int G, c;
    DEVI bool next(int i, pg8::Unit& u) const { const int rt = c + (i >> 2) * G; if (rt >= T / 256) return false; u.pm = rt; u.pn = i & 3; u.aux = 0; return true; }
    DEVI int arow(const pg8::Unit& u, int r) const { return u.pm * 256 + r; }
    static constexpr bool IDX_DMA = false; };
DEVI void wg_global_handoff(Frame& F) {
    asm volatile("s_waitcnt vmcnt(0)" ::: "memory");
    __syncthreads();
    if (F.tid == 0) { __builtin_amdgcn_fence(__ATOMIC_ACQUIRE, "agent"); asm volatile("s_waitcnt vmcnt(0)" ::: "memory"); }
    __syncthreads();
}
DEVI void phase_gemm_y(Frame& F) {
    pg8::Gemm g{(const bf16_t*)(F.ws + WS_PROJ) + 3072, (const bf16_t*)(F.ws + WS_WOUTT), PN, DM};
    SchedRowTiles S{F.G, F.blk}; EpiBf16 E{(bf16_t*)(F.ws + WS_PROJ), PN};
    pg8::gemm_phase(F.lds, g, S, E);
}

struct SchedOne { int pm; DEVI bool next(int i, pg8::Unit& u) const { if (i) return false; u.pm = pm; u.pn = 0; u.aux = 0; return true; }
    DEVI int arow(const pg8::Unit& u, int r) const { return u.pm * 256 + r; }
    static constexpr bool IDX_DMA = false; };
constexpr int LGP = 258;
struct EpiRouter { LAS float* L;
    static constexpr bool PRE = false;
    DEVI void operator()(const f32x4 (&acc)[2][2][4][2], const pg8::Unit&, int wr, int wc, int fr, int fq) const {
        if (wc < 2) {
#pragma unroll
            for (int ai = 0; ai < 2; ++ai)
#pragma unroll
                for (int m = 0; m < 4; ++m) { const int row = ai * 128 + wr * 64 + m * 16 + fr, ex = wc * 32 + 8 * fq;
                    const f32x4 v0 = acc[ai][0][m][0] + acc[ai][1][m][0], v1 = acc[ai][0][m][1] + acc[ai][1][m][1];
#pragma unroll
                    for (int i = 0; i < 4; ++i) { L[(ex + i) * LGP + row] = v0[i]; L[(ex + 4 + i) * LGP + row] = v1[i]; } }
        }
    } };
DEVI void phase_norm2(Frame& F) {
    const Params& P = *F.p;
    LAS float* LG = (LAS float*)F.lds;
    LAS float* MODS = (LAS float*)(F.lds + 131072);
    LAS int* hist = (LAS int*)(F.lds + 131072 + 12288);
    const float* ng = P.in[I_NORMG];
    const bf16_t* Y = (const bf16_t*)(F.ws + WS_PROJ); bf16_t* H2 = (bf16_t*)(F.ws + WS_PROJ) + 3072;
    int* EIDX = (int*)(F.ws + WS_EIDX); float* WTS = (float*)(F.ws + WS_WTS);
#pragma unroll 1
    for (int rb = F.blk; rb < T / 256; rb += F.G) {
        const int b = rb >> 5;
        __syncthreads();
        for (int i = F.tid; i < 3 * 1024; i += NTHREADS) { const int v = i >> 10, n = i & 1023; const float m = mod_value(F, b, (2 + v) * 1024 + n); MODS[i] = v == 2 ? 1.f + m : m; }
        __syncthreads();
        {
            int lane = F.lane; asm volatile("" : "+v"(lane));
            f32x4 g1v[4], g2v[4];
#pragma unroll
            for (int j = 0; j < 4; ++j) { g1v[j] = *(const f32x4*)(ng + 1024 + 256 * j + 4 * lane); g2v[j] = *(const f32x4*)(ng + 2048 + 256 * j + 4 * lane); }
            u32x2 yn[4]; f32x4 xn[4];
            { const int row = rb * 256 + F.wave;
#pragma unroll
              for (int j = 0; j < 4; ++j) { yn[j] = *(const u32x2*)(Y + (size_t)row * PN + 256 * j + 4 * lane); xn[j] = *(const f32x4*)(P.in[I_X] + (size_t)row * DM + 256 * j + 4 * lane); } }
            for (int i = 0; i < 32; ++i) {
                const int row = rb * 256 + F.wave + 8 * i;
                f32x4 y[4], x[4]; float ss = 0.f;
#pragma unroll
                for (int j = 0; j < 4; ++j) { const u32x2 yy = yn[j]; y[j] = (f32x4){lo_bf(yy.x), hi_bf(yy.x), lo_bf(yy.y), hi_bf(yy.y)};
                    x[j] = xn[j]; ss += y[j].x * y[j].x + y[j].y * y[j].y + y[j].z * y[j].z + y[j].w * y[j].w; }
                if (i + 1 < 32) { const int nr = row + 8;
#pragma unroll
                    for (int j = 0; j < 4; ++j) { yn[j] = *(const u32x2*)(Y + (size_t)nr * PN + 256 * j + 4 * lane); xn[j] = *(const f32x4*)(P.in[I_X] + (size_t)nr * DM + 256 * j + 4 * lane); } }
                const float rsy = rsqrtf(wave_sum(ss) * (1.f / DM) + EPS); float s2 = 0.f;
#pragma unroll
                for (int j = 0; j < 4; ++j) { const f32x4 gg = *(const LAS f32x4*)(MODS + 256 * j + 4 * lane); x[j] = x[j] + gg * (y[j] * rsy * g1v[j]);
                    { u32x2 xo; xo.x = cvt_pk_bf16(x[j].x, x[j].y); xo.y = cvt_pk_bf16(x[j].z, x[j].w); *(u32x2*)((bf16_t*)(P.out + (size_t)row * DM) + 256 * j + 4 * lane) = xo; } s2 += x[j].x * x[j].x + x[j].y * x[j].y + x[j].z * x[j].z + x[j].w * x[j].w; }
                const float rsx = rsqrtf(wave_sum(s2) * (1.f / DM) + EPS);
#pragma unroll
                for (int j = 0; j < 4; ++j) { const f32x4 sh = *(const LAS f32x4*)(MODS + 1024 + 256 * j + 4 * lane), sc = *(const LAS f32x4*)(MODS + 2048 + 256 * j + 4 * lane);
                    const f32x4 hv = (x[j] * rsx * g2v[j]) * sc + sh;
                    u32x2 o; o.x = cvt_pk_bf16(hv.x, hv.y); o.y = cvt_pk_bf16(hv.z, hv.w);
                    *(u32x2*)(H2 + (size_t)row * PN + 256 * j + 4 * lane) = o;
                    *(unsigned*)((unsigned char*)(F.ws + WS_PROJ) + (size_t)row * PN * 2 + 256 * j + 4 * lane) = pack_fp8x4(hv.x * H2_SCALE, hv.y * H2_SCALE, hv.z * H2_SCALE, hv.w * H2_SCALE); }
            }
        }
    }
    asm volatile("s_waitcnt vmcnt(0)" ::: "memory");
    __syncthreads();
    if (F.tid == 0) { __builtin_amdgcn_fence(__ATOMIC_ACQUIRE, "agent"); asm volatile("s_waitcnt vmcnt(0)" ::: "memory"); }
    __syncthreads();
#pragma unroll 1
    for (int rb = F.blk; rb < T / 256; rb += F.G) {
        __syncthreads();
        if (F.tid < 64) hist[F.tid] = 0;
        {
            pg8::Gemm g{(const bf16_t*)(F.ws + WS_PROJ) + 3072, (const bf16_t*)(F.ws + WS_WRT), PN, DM};
            SchedOne S{rb}; EpiRouter E{LG};
            pg8::gemm_phase<EpiRouter, SchedOne, true>(F.lds, g, S, E);
        }
        __syncthreads();
        if (F.tid < 256) {
            const int lr = F.tid, row = rb * 256 + lr;
            float sc[64], sel[64];
#pragma unroll
            for (int e = 0; e < 64; ++e) { const float s = sigmoidf_(LG[e * LGP + lr]); sc[e] = s; sel[e] = s + P.in[I_RB][e]; }
            float gs[8];
#pragma unroll
            for (int g2 = 0; g2 < 8; ++g2) { float m1 = -3.0e38f, m2 = -3.0e38f;
#pragma unroll
                for (int j = 0; j < 8; ++j) { const float v = sel[8 * g2 + j]; m2 = fmaxf(m2, fminf(m1, v)); m1 = fmaxf(m1, v); }
                gs[g2] = m1 + m2; }
#pragma unroll
            for (int g2 = 0; g2 < 8; ++g2) { int rank = 0;
#pragma unroll
                for (int g3 = 0; g3 < 8; ++g3) if (g3 != g2) rank += (gs[g3] > gs[g2] || (gs[g3] == gs[g2] && g3 < g2)) ? 1 : 0;
                if (rank >= 4) {
#pragma unroll
                    for (int j = 0; j < 8; ++j) sel[8 * g2 + j] = -3.0e38f; } }
            int idx[8]; float wv[8]; float wsum = 0.f;
#pragma unroll
            for (int k = 0; k < 8; ++k) { float best = -3.4e38f, bs = 0.f; int bi = 0;
#pragma unroll
                for (int e = 0; e < 64; ++e) { const bool c = sel[e] > best; best = c ? sel[e] : best; bi = c ? e : bi; bs = c ? sc[e] : bs; }
                idx[k] = bi; wv[k] = bs; wsum += bs;
#pragma unroll
                for (int e = 0; e < 64; ++e) sel[e] = (bi == e) ? -3.4e38f : sel[e]; }
            const float wn = 2.5f * __builtin_amdgcn_rcpf(wsum);
            *(u32x4*)(EIDX + (size_t)row * 8) = (u32x4){(unsigned)idx[0], (unsigned)idx[1], (unsigned)idx[2], (unsigned)idx[3]};
            *(u32x4*)(EIDX + (size_t)row * 8 + 4) = (u32x4){(unsigned)idx[4], (unsigned)idx[5], (unsigned)idx[6], (unsigned)idx[7]};
            *(f32x4*)(WTS + (size_t)row * 8) = (f32x4){wv[0] * wn, wv[1] * wn, wv[2] * wn, wv[3] * wn};
            *(f32x4*)(WTS + (size_t)row * 8 + 4) = (f32x4){wv[4] * wn, wv[5] * wn, wv[6] * wn, wv[7] * wn};
#pragma unroll
            for (int k = 0; k < 8; ++k) atomicAdd((int*)hist + idx[k], 1);
        }
        __syncthreads();
        if (F.tid < 64) ((int*)(F.ws + WS_BCNT))[rb * 64 + F.tid] = hist[F.tid];
    }
}

DEVI void phase_lists(Frame& F) {
    LAS int* base = (LAS int*)F.lds;
    LAS int* pst = base + 64;
    LAS int* tot = pst + 65;
    LAS int* lcnt = tot + 64;
    const int* BC = (const int*)(F.ws + WS_BCNT);
    const int* EIDX = (const int*)(F.ws + WS_EIDX); const float* WTS = (const float*)(F.ws + WS_WTS); int* POS = (int*)(F.ws + WS_POS);
    for (int rb = F.blk; rb < 256; rb += F.G) {
        const int hh = rb >> 7;
        __syncthreads();
        {   LAS int* psum = lcnt + 64;
            const int e = F.tid & 63, part = F.tid >> 6; int bs = 0, ts = 0;
#pragma unroll
            for (int i = 0; i < 16; ++i) { const int q = hh * 128 + part * 16 + i; const int v = BC[q * 64 + e]; ts += v; bs += q < rb ? v : 0; }
            psum[(part * 64 + e) * 2] = bs; psum[(part * 64 + e) * 2 + 1] = ts;
            __syncthreads();
            if (F.tid < 64) { int bsum = 0, tsum = 0;
#pragma unroll
                for (int p = 0; p < 8; ++p) { bsum += psum[(p * 64 + F.tid) * 2]; tsum += psum[(p * 64 + F.tid) * 2 + 1]; }
                base[F.tid] = bsum; tot[F.tid] = tsum; lcnt[F.tid] = 0; }
        }
        __syncthreads();
        if (F.tid == 0) { int s = 0; for (int e = 0; e < 64; ++e) { pst[e] = s; s += (tot[e] + 255) & ~255; } pst[64] = s; }
        __syncthreads();
        int* TOK = (int*)(F.ws + WS_TOKL) + (size_t)hh * ROWS_H; float* WL = (float*)(F.ws + WS_WL) + (size_t)hh * ROWS_H;
        for (int i = F.tid; i < 256 * 8; i += NTHREADS) { const int t = rb * 256 + (i >> 3), k = i & 7; const int e = EIDX[(size_t)t * 8 + k];
            const int loc = atomicAdd((int*)lcnt + e, 1); const int dest = pst[e] + base[e] + loc;
            TOK[dest] = t; WL[dest] = WTS[(size_t)t * 8 + k]; POS[(size_t)t * 8 + k] = dest + hh * ROWS_H; }
        if (F.tid < 256) { const int t = rb * 256 + F.tid; TOK[CAP_R + t - hh * HALF_T] = t; WL[CAP_R + t - hh * HALF_T] = 1.f; }
        const int e = rb & 127;
        if (e < 64) {
            for (int r = pst[e] + tot[e] + F.tid; r < pst[e + 1]; r += NTHREADS) { TOK[r] = -1; WL[r] = 0.f; }
            int* TE = (int*)(F.ws + WS_TEXP) + hh * CAP_TILES;
            for (int q = (pst[e] >> 8) + F.tid; q < (pst[e + 1] >> 8); q += NTHREADS) TE[q] = e;
            if (e == 0 && F.tid == 0) ((int*)(F.ws + WS_NT))[hh] = pst[64] >> 8;
        }
    }
}

struct SchedMoE {
    int G, c, nt0, nt1, npn, hsel; const int* texp; const int* tok; bool gather;
    DEVI bool next(int i, pg8::Unit& u) const {
        const int cc = (G == 256) ? ((c & 7) * 32 + (c >> 3)) : c;
        const int sh = npn == 8 ? 3 : (npn == 4 ? 2 : 1);
        const int L = i * G + cc; const int rtl = L >> sh; int pnl = L & (npn - 1);
        const int r0 = nt0 + SH_TILES, r1 = nt1 + SH_TILES;
        int hh, rl;
        if (hsel < 0) { if (rtl >= r0 + r1) return false; hh = rtl >= r0 ? 1 : 0; rl = rtl - hh * r0; }
        else {
            hh = hsel; const int nrt = hh ? r1 : r0, fr = nrt / G;
            if (i < npn * fr) { rl = (i >> sh) * G + cc; pnl = i & (npn - 1); }
            else { const int L2 = (i - npn * fr) * G + cc; rl = fr * G + (L2 >> sh); pnl = L2 & (npn - 1); if (rl >= nrt) return false; }
        }
        const int nth = hh ? nt1 : nt0;
        int e, lt; if (rl < nth) { lt = rl; e = texp[hh * CAP_TILES + rl]; } else { lt = CAP_TILES + (rl - nth); e = 64; }
        u.pm = hh * HTILES + lt; u.pn = e * npn + pnl; u.aux = pnl; return true;
    }
    DEVI int arow(const pg8::Unit& u, int r) const {
        if (!gather) return u.pm * 256 + r;
        const int t = tok[u.pm * 256 + r]; return t < 0 ? 0 : t;
    }
};
constexpr int UT_OFF = pg8::STAGE_BYTES, UT_MAX = 64;
constexpr int WLB_OFF = UT_OFF + 1024;
constexpr int IDX_OFF = UT_OFF + 3072;
template <bool GATHER>
struct SchedTab { const LAS int* tab; const int* tok;
    static constexpr bool IDX_DMA = GATHER;
    DEVI bool next(int i, pg8::Unit& u) const {
        if (i >= UT_MAX) return false;
        const int pm = tab[4 * i]; if (pm < 0) return false;
        u.pm = pm; u.pn = tab[4 * i + 1]; u.aux = tab[4 * i + 2]; return true;
    }
    DEVI int arow(const pg8::Unit& u, int r) const {
        if (!GATHER) return u.pm * 256 + r;
        return tok[u.pm * 256 + r];
    }
    DEVI void idx_dma(LAS unsigned char* l, const pg8::Unit& u, int ui, int wid, int lane) const {
        if (wid >= 4) __builtin_amdgcn_global_load_lds((const unsigned*)(tok + u.pm * 256 + (wid - 4) * 64 + lane), (LAS unsigned*)(l + IDX_OFF + (ui & 1) * 1024 + (wid - 4) * 256), 4, 0, 0);
    }
    DEVI int idx_lds(LAS unsigned char* l, int ui, int r) const { return ((const LAS int*)(l + IDX_OFF + (ui & 1) * 1024))[r]; }
};
template <bool GATHER>
DEVI SchedTab<GATHER> build_unit_table(Frame& F, const SchedMoE& S) {
    LAS int* tab = (LAS int*)(F.lds + UT_OFF);
    __syncthreads();
    int ti = F.tid; asm volatile("" : "+v"(ti));
    if (ti < UT_MAX) { pg8::Unit u; u.pm = 0; u.pn = 0; u.aux = 0; const bool ok = S.next(ti, u);
        tab[4 * ti] = ok ? u.pm : -1; tab[4 * ti + 1] = ok ? u.pn : 0; tab[4 * ti + 2] = ok ? u.aux : 0; }
    __syncthreads();
    return SchedTab<GATHER>{tab, S.tok};
}
struct EpiGU { unsigned char* O; const float* wl; float inv; LAS unsigned char* lds;
    static constexpr bool PRE = true;
    DEVI void prefetch(LAS unsigned char* l, const pg8::Unit& u, int wid, int lane) const {
        if (wid < 4) __builtin_amdgcn_global_load_lds((const unsigned*)(wl + u.pm * 256 + wid * 64 + lane), (LAS unsigned*)(l + WLB_OFF + (u.seq & 1) * 1024 + wid * 256), 4, 0, 0);
    }
    DEVI void operator()(const f32x4 (&acc)[2][2][4][2], const pg8::Unit& u, int wr, int wc, int fr, int fq) const {
        asm volatile("" : "+v"(fr), "+v"(fq));
        const int row0 = u.pm * 256 + wr * 64 + fr, col0 = u.aux * 64 + wc * 16 + 4 * fq;
        const LAS float* wb = (const LAS float*)(lds + WLB_OFF + (u.seq & 1) * 1024) + wr * 64 + fr;
        float wv[2][4];
#pragma unroll
        for (int ai = 0; ai < 2; ++ai)
#pragma unroll
            for (int m = 0; m < 4; ++m) wv[ai][m] = wb[ai * 128 + m * 16];
#pragma unroll
        for (int ai = 0; ai < 2; ++ai)
#pragma unroll
            for (int m = 0; m < 4; ++m) { const f32x4 g0 = acc[ai][0][m][0], u0 = acc[ai][0][m][1]; const float w = wv[ai][m];
                float o[4];
#pragma unroll
                for (int i = 0; i < 4; ++i) o[i] = siluf_(g0[i]) * u0[i] * (w * ACT_SCALE);
                *(unsigned*)(O + (size_t)(row0 + ai * 128 + m * 16) * EFF + col0) = pack_fp8x4(o[0], o[1], o[2], o[3]); }
    } };
DEVI void phase_moe_gu(Frame& F) {
    const int nt0 = ((const int*)(F.ws + WS_NT))[0], nt1 = ((const int*)(F.ws + WS_NT))[1];
    static_assert(H2_SCALE * W_SCALE_GU == 16384.f, "the gate|up GEMM's operand scaling is undone by the MFMA block scale: 2^-14");
    pg8::Gemm g{(const bf16_t*)(F.ws + WS_PROJ), (const bf16_t*)(F.ws + WS_WGU), PN, DM / 2, 0x71717171};
    SchedMoE S0{F.G, F.blk, nt0, nt1, 4, -1, (const int*)(F.ws + WS_TEXP), (const int*)(F.ws + WS_TOKL), true};
    const SchedTab<true> S = build_unit_table<true>(F, S0);
    EpiGU E{(unsigned char*)(F.ws + WS_ACT), (const float*)(F.ws + WS_WL), 1.f, F.lds};
    pg8::gemm_phase<EpiGU, SchedTab<true>, false, true, true>(F.lds, g, S, E);
}
struct EpiDown { unsigned char* O; int hh; float sc;
    static constexpr bool PRE = false;
    static constexpr int NST = 8;
    DEVI void operator()(const f32x4 (&acc)[2][2][4][2], const pg8::Unit& u, int wr, int wc, int fr, int fq) const {
        asm volatile("" : "+v"(fr), "+v"(fq));
        const int row0 = (u.pm - hh * HTILES) * 256 + wr * 64 + fr, col0 = u.aux * 128 + wc * 32 + 8 * fq;
#pragma unroll
        for (int ai = 0; ai < 2; ++ai)
#pragma unroll
            for (int m = 0; m < 4; ++m) { const int row = row0 + ai * 128 + m * 16;
                const f32x4 a0 = acc[ai][0][m][0], a1 = acc[ai][0][m][1];
                u32x2 o; o.x = pack_fp8x4(a0[0], a0[1], a0[2], a0[3]); o.y = pack_fp8x4(a1[0], a1[1], a1[2], a1[3]);
                *(u32x2*)(O + (size_t)row * DM + col0) = o; }
    } };
DEVI void phase_moe_down(Frame& F, int hh) {
    const int nt0 = ((const int*)(F.ws + WS_NT))[0], nt1 = ((const int*)(F.ws + WS_NT))[1];
    static_assert(ROW_SCALE / (ACT_SCALE * W_SCALE_DN) == 1.f / 1024.f, "the down GEMM's output scaling rides on the MFMA block scale: 2^-10");
    pg8::Gemm g{(const bf16_t*)(F.ws + WS_ACT), (const bf16_t*)(F.ws + WS_WD), EFF / 2, EFF / 2, 0x75757575};
    SchedMoE S0{F.G, F.blk, nt0, nt1, 8, hh, (const int*)(F.ws + WS_TEXP), nullptr, false};
    const SchedTab<false> S = build_unit_table<false>(F, S0);
    EpiDown E{(unsigned char*)(F.ws + (hh ? WS_ROWS1 : WS_ROWS0)), hh, 1.f};
    if ((F.wave >> 2) == 0) pg8::gemm_phase_astat8<EpiDown, SchedTab<false>, 0>(F.lds, g, S, E); else pg8::gemm_phase_astat8<EpiDown, SchedTab<false>, 1>(F.lds, g, S, E);
}
DEVI void phase_combine(Frame& F, int hh) {
    const Params& P = *F.p;
    LAS float* G2 = (LAS float*)F.lds;
    const unsigned char* ROWS = (const unsigned char*)(F.ws + (hh ? WS_ROWS1 : WS_ROWS0)); const int* POS = (const int*)(F.ws + WS_POS);
    const int cA = 16 * F.lane;
    f32x4 g3v[4];
#pragma unroll
    for (int j = 0; j < 4; ++j) g3v[j] = *(const f32x4*)(P.in[I_NORMG] + 3072 + cA + 4 * j);
    for (int rb = F.blk; rb < HALF_T / 128; rb += F.G) {
        const int t0 = hh * HALF_T + rb * 128, b = t0 >> 13;
        __syncthreads();
        for (int i = F.tid; i < 1024; i += NTHREADS) G2[i] = mod_value(F, b, 5 * 1024 + i);
        __syncthreads();
        int prv[16];
#pragma unroll
        for (int i = 0; i < 16; ++i) { prv[i] = 0; if (F.lane < 8) prv[i] = POS[(size_t)(t0 + F.wave + 8 * i) * 8 + F.lane] - hh * ROWS_H; }
#pragma unroll
        for (int i = 0; i < 16; ++i) {
            const int t = t0 + F.wave + 8 * i;
            const int pr = prv[i];
            const bf16_t* x1p = (const bf16_t*)(P.out + (size_t)t * DM);
            const u32x4 xa = *(const u32x4*)(x1p + cA), xb = *(const u32x4*)(x1p + cA + 8);
            u32x4 rv[9];
#pragma unroll
            for (int k = 0; k < 9; ++k) { const int r = k < 8 ? __shfl(pr, k) : CAP_R + (t - hh * HALF_T); rv[k] = *(const u32x4*)(ROWS + (size_t)r * DM + 16 * F.lane); }
            float a[16];
#pragma unroll
            for (int q = 0; q < 16; ++q) a[q] = 0.f;
#pragma unroll
            for (int k = 0; k < 9; ++k)
#pragma unroll
                for (int q = 0; q < 4; ++q) { const f32x2 lo = __builtin_amdgcn_cvt_pk_f32_fp8((int)rv[k][q], false), hi = __builtin_amdgcn_cvt_pk_f32_fp8((int)rv[k][q], true);
                    a[4 * q] += lo[0]; a[4 * q + 1] += lo[1]; a[4 * q + 2] += hi[0]; a[4 * q + 3] += hi[1]; }
            float ss = 0.f;
#pragma unroll
            for (int q = 0; q < 16; ++q) { a[q] *= (1.f / ROW_SCALE); ss += a[q] * a[q]; }
            const float rs = rsqrtf(wave_sum(ss) * (1.f / DM) + EPS);
            asm volatile("s_waitcnt vmcnt(0)" ::: "memory");
#pragma unroll
            for (int j = 0; j < 4; ++j) { const int col = cA + 4 * j; const f32x4 gg = *(const LAS f32x4*)(G2 + col);
                const u32x4 xs = (j >> 1) ? xb : xa; const unsigned w0 = (j & 1) ? xs.z : xs.x, w1 = (j & 1) ? xs.w : xs.y;
                const f32x4 x1 = (f32x4){lo_bf(w0), hi_bf(w0), lo_bf(w1), hi_bf(w1)};
                const f32x4 av = (f32x4){a[4 * j], a[4 * j + 1], a[4 * j + 2], a[4 * j + 3]};
                *(f32x4*)(P.out + (size_t)t * DM + col) = x1 + gg * (av * rs * g3v[j]); }
        }
    }
}

DEVI void phase_mixer_tail(Frame& F) {
    const bool first = (F.blk >> 3) & 1;
    if (first) { expert_weight_copies(F); __syncthreads(); }
    phase_chunk_out(F);
    wg_global_handoff(F);
    phase_gemm_y(F);
    wg_global_handoff(F);
    phase_norm2(F);
    if (!first) { __syncthreads(); expert_weight_copies(F); }
}

DEVI void phase_down1_combine0(Frame& F) {
    if ((F.blk >> 3) & 1) { phase_combine(F, 0); __syncthreads(); phase_moe_down(F, 1); }
    else { phase_moe_down(F, 1); __syncthreads(); phase_combine(F, 0); }
}

constexpr int N_PHASES = 11;
__global__ void __launch_bounds__(NTHREADS, 2) mk_fwd(Params prm) {
    extern __shared__ __attribute__((aligned(16))) unsigned char lds_raw[];
    Frame F; F.lds = (LAS unsigned char*)lds_raw; F.tid = threadIdx.x; F.lane = F.tid & 63; F.wave = __builtin_amdgcn_readfirstlane(F.tid >> 6);
    F.G = gridDim.x; F.blk = blockIdx.x; F.p = &prm; F.ws = prm.ws;
    volatile LAS unsigned* misc = (volatile LAS unsigned*)(F.lds + LDS_MISC);
    if (F.tid < 16) misc[F.tid] = 0u;
    __syncthreads();
    const int lo = prm.ph_lo, hi = prm.ph_hi;
    XcdBarrier bar; bar.bar = (unsigned*)(F.ws + WS_CTL); bar.x = 0; bar.st = misc;
    if (hi - lo > 1) bar = xcd_barrier_post((unsigned*)(F.ws + WS_CTL), misc);
#ifndef PH_MASK
#define PH_MASK 0xFFFF
#endif
#define RUN(k, call) do { if (((PH_MASK >> (k)) & 1) && lo <= (k) && (k) < hi) { call; if ((k) + 1 < hi) xcd_barrier(bar); } } while (0)
    RUN(0, phase_prep(F));
    RUN(1, phase_norm1(F));
    RUN(2, phase_gemm_proj(F));
    RUN(3, phase_chunk_u(F));
    RUN(4, phase_scan_states(F));
    RUN(5, phase_mixer_tail(F));
    RUN(6, phase_lists(F));
    RUN(7, phase_moe_gu(F));
    RUN(8, phase_moe_down(F, 0));
    RUN(9, phase_down1_combine0(F));
    RUN(10, phase_combine(F, 1));
#undef RUN
}

extern "C" void kernel_launch(void* const* d_in, const int* in_sizes, int n_in, void* d_out, int out_size, void* d_ws, size_t ws_size, hipStream_t stream) {
    static int grid = 0;
    if (grid == 0) {
        if (n_in != 23 || in_sizes[0] != T * DM || out_size != T * DM || ws_size < WS_END) {
            fprintf(stderr, "kernel_launch: unexpected shapes (n_in %d, in0 %d, out %d, ws %zu < %zu)\n", n_in, n_in > 0 ? in_sizes[0] : -1, out_size, ws_size, (size_t)WS_END); grid = -1; return; }
        int dev = 0, cus = 0, per_cu = 0;
        if (hipGetDevice(&dev) != hipSuccess || hipDeviceGetAttribute(&cus, hipDeviceAttributeMultiprocessorCount, dev) != hipSuccess) { grid = -1; return; }
        if (hipFuncSetAttribute((const void*)mk_fwd, hipFuncAttributeMaxDynamicSharedMemorySize, LDS_BYTES) != hipSuccess) { fprintf(stderr, "kernel_launch: hipFuncSetAttribute failed\n"); grid = -1; return; }
        if (hipOccupancyMaxActiveBlocksPerMultiprocessor(&per_cu, (const void*)mk_fwd, NTHREADS, LDS_BYTES) != hipSuccess || per_cu < 1) { fprintf(stderr, "kernel_launch: occupancy query says %d\n", per_cu); }
        (void)hipGetLastError();
        grid = cus;
    }
    if (grid < 0) return;
    (void)hipMemsetAsync((char*)d_ws + WS_CTL, 0, CTL_BYTES, stream);
    Params p{};
    for (int i = 0; i < 23; ++i) p.in[i] = (const float*)d_in[i];
    p.out = (float*)d_out; p.ws = (unsigned char*)d_ws;
#if MK_ONE_LAUNCH
    p.ph_lo = 0; p.ph_hi = N_PHASES;
    hipLaunchKernelGGL(mk_fwd, dim3(grid), dim3(NTHREADS), LDS_BYTES, stream, p);
#else
    for (int k = 0; k < N_PHASES; ++k) { p.ph_lo = k; p.ph_hi = k + 1; hipLaunchKernelGGL(mk_fwd, dim3(grid), dim3(NTHREADS), LDS_BYTES, stream, p); }
#endif
}
```

```cpp
#include <hip/hip_runtime.h>
#include <cstdio>
#include <cstdint>

#ifndef MK_ONE_LAUNCH
#define MK_ONE_LAUNCH 1
#endif

#define LAS __attribute__((address_space(3)))
#define DEVI __device__ __forceinline__
typedef unsigned short bf16_t;
typedef short bf16x8 __attribute__((ext_vector_type(8)));
typedef float f32x4 __attribute__((ext_vector_type(4)));
typedef float f32x2 __attribute__((ext_vector_type(2)));
typedef unsigned u32x4 __attribute__((ext_vector_type(4)));
typedef unsigned u32x2 __attribute__((ext_vector_type(2)));

constexpr int DM = 1024, NBATCH = 8, SEQ = 8192, T = NBATCH * SEQ, CTXL = 256, TC = NBATCH * CTXL, TT = T + TC;
constexpr int CH = 128, NCH = SEQ / CH, NCC = CTXL / CH, NSLOT = NCH + NCC;
constexpr int PN = 4096;
constexpr int INC = 4112;
constexpr int NE = 64, TOPK = 8, EFF = 256;
constexpr int NTHREADS = 512, NWAVES = 8;
constexpr int LDS_BYTES = 155648;
constexpr int LDS_MISC = LDS_BYTES - 64;
constexpr float EPS = 1e-6f;
constexpr int HALF_T = T / 2;
constexpr int CAP_R = HALF_T * TOPK + NE * 256;
constexpr int CAP_TILES = CAP_R / 256;
constexpr int ROWS_H = CAP_R + HALF_T;
constexpr int SH_TILES = HALF_T / 256;
constexpr int HTILES = ROWS_H / 256;
constexpr float ROW_SCALE = 8.f;
constexpr float ACT_SCALE = 16.f, W_SCALE_DN = 512.f;
constexpr float H2_SCALE = 16.f, W_SCALE_GU = 1024.f;

constexpr size_t MB = 1ull << 20;
constexpr size_t WS_CTL = 0;
constexpr size_t CTL_BYTES = 65536;
constexpr size_t WS_MODP = 1 * MB;
constexpr size_t WS_WINT = 3 * MB;
constexpr size_t WS_WOUTT = 11 * MB;
constexpr size_t WS_WRT = 13 * MB;
constexpr size_t WS_GATES = 14 * MB;
constexpr size_t WS_UN = 19 * MB;
constexpr size_t WS_CHS = 22 * MB;
constexpr size_t WS_SM = 22 * MB + 256 * 1024;
constexpr size_t WS_EIDX = 23 * MB;
constexpr size_t WS_WTS = 25 * MB;
constexpr size_t WS_POS = 27 * MB;
constexpr size_t WS_TOKL = 29 * MB;
constexpr size_t WS_WL = 32 * MB;
constexpr size_t WS_BCNT = 35 * MB;
constexpr size_t WS_TEXP = 35 * MB + 128 * 1024;
constexpr size_t WS_NT = 35 * MB + 256 * 1024;
constexpr size_t WS_B = 36 * MB;
constexpr size_t WS_PROJ = 168 * MB;
constexpr size_t WS_US = 696 * MB;
constexpr size_t WS_WGU = 36 * MB;
constexpr size_t WS_WD = 101 * MB;
constexpr size_t WS_ACT = 776 * MB;
constexpr size_t WS_ROWS0 = 168 * MB;
constexpr size_t WS_ROWS1 = 472 * MB;
constexpr size_t WS_END = 1000 * MB;
static_assert(WS_WD + 65ull * 1024 * 256 * 2 <= WS_PROJ && WS_ACT + 2ull * ROWS_H * 256 <= WS_END && WS_ROWS0 + (size_t)ROWS_H * 1024 <= WS_ROWS1
              && WS_ROWS1 + (size_t)ROWS_H * 1024 <= WS_ACT && WS_ACT >= WS_PROJ + (size_t)TT * PN * 2, "workspace overlap");

struct Params {
    const float* in[23];
    float* out;
    unsigned char* ws;
    int ph_lo, ph_hi;
};
enum { I_X = 0, I_C, I_CTX, I_CCTX, I_WMOD, I_BMOD, I_NORMG, I_WIN, I_RDEC, I_RNG, I_CONVW, I_CONVB, I_GATEB, I_MNG, I_WOUT,
       I_WR, I_RB, I_WG, I_WU, I_WDN, I_SG, I_SU, I_SD };

DEVI float bf2f(bf16_t b) { return __uint_as_float(((unsigned)b) << 16); }
DEVI unsigned cvt_pk_bf16(float lo, float hi) { unsigned r; asm volatile("v_cvt_pk_bf16_f32 %0, %1, %2" : "=v"(r) : "v"(lo), "v"(hi)); return r; }
DEVI bf16_t f2bf(float f) { return (bf16_t)(cvt_pk_bf16(f, 0.f) & 0xffffu); }
DEVI float lo_bf(unsigned u) { return __uint_as_float(u << 16); }
DEVI float hi_bf(unsigned u) { return __uint_as_float(u & 0xffff0000u); }
DEVI float wave_sum(float v) {
#pragma unroll
    for (int o = 1; o < 64; o <<= 1) v += __shfl_xor(v, o);
    return v;
}
DEVI float row16_sum(float v) {
    v += __builtin_bit_cast(float, __builtin_amdgcn_update_dpp(0, __builtin_bit_cast(int, v), 0xB1, 0xF, 0xF, true));
    v += __builtin_bit_cast(float, __builtin_amdgcn_update_dpp(0, __builtin_bit_cast(int, v), 0x4E, 0xF, 0xF, true));
    v += __builtin_bit_cast(float, __builtin_amdgcn_update_dpp(0, __builtin_bit_cast(int, v), 0x141, 0xF, 0xF, true));
    v += __builtin_bit_cast(float, __builtin_amdgcn_update_dpp(0, __builtin_bit_cast(int, v), 0x140, 0xF, 0xF, true));
    return v;
}
DEVI float dpp_x1(float x) { return __builtin_bit_cast(float, __builtin_amdgcn_update_dpp(0, __builtin_bit_cast(int, x), 0xB1, 0xF, 0xF, true)); }
DEVI float dpp_x2(float x) { return __builtin_bit_cast(float, __builtin_amdgcn_update_dpp(0, __builtin_bit_cast(int, x), 0x4E, 0xF, 0xF, true)); }
DEVI float dpp_x4(float x) { const int t = __builtin_amdgcn_update_dpp(0, __builtin_bit_cast(int, x), 0x114, 0xF, 0xA, true);
    return __builtin_bit_cast(float, __builtin_amdgcn_update_dpp(t, __builtin_bit_cast(int, x), 0x104, 0xF, 0x5, true)); }
DEVI float dpp_x8(float x) { const int t = __builtin_amdgcn_update_dpp(0, __builtin_bit_cast(int, x), 0x118, 0xF, 0xC, true);
    return __builtin_bit_cast(float, __builtin_amdgcn_update_dpp(t, __builtin_bit_cast(int, x), 0x108, 0xF, 0x3, true)); }
DEVI float quad_sum(float v) {
    v += __builtin_bit_cast(float, __builtin_amdgcn_update_dpp(0, __builtin_bit_cast(int, v), 0xB1, 0xF, 0xF, true));
    v += __builtin_bit_cast(float, __builtin_amdgcn_update_dpp(0, __builtin_bit_cast(int, v), 0x4E, 0xF, 0xF, true));
    return v;
}
DEVI float wave_max(float v) {
#pragma unroll
    for (int o = 1; o < 64; o <<= 1) v = fmaxf(v, __shfl_xor(v, o));
    return v;
}
DEVI float sigmoidf_(float x) { return __builtin_amdgcn_rcpf(1.f + __expf(-x)); }
DEVI float siluf_(float x) { return x * __builtin_amdgcn_rcpf(1.f + __expf(-x)); }
DEVI float logsigmoidf_(float x) { const float e = __expf(-fabsf(x)); return fminf(x, 0.f) - __logf(1.f + e); }
#define LDS_WAIT() asm volatile("s_waitcnt lgkmcnt(0)" ::: "memory")

#define XB_TMO      128
#define XB_XCNT(j)  (256  + 64 * (j))
#define XB_XSUB(j)  (1280 + 64 * (j))
#define XB_XGEN(j)  (2304 + 64 * (j))
#define XB_TOP      3328
#define XB_TOPGEN   3392
#define XCD_BAR_WORDS 3456
#define XB_SPIN_CAP (1u << 18)
DEVI unsigned xb_ld(unsigned* p)              { return __hip_atomic_load(p, __ATOMIC_RELAXED, __HIP_MEMORY_SCOPE_AGENT); }
DEVI unsigned xb_add(unsigned* p, unsigned v) { return __hip_atomic_fetch_add(p, v, __ATOMIC_RELAXED, __HIP_MEMORY_SCOPE_AGENT); }
DEVI unsigned xb_xcc_id() { return (unsigned)__builtin_amdgcn_s_getreg((3 << 11) | 20) & 0xFu; }
#define XB_SPIN(cond, bar) do { unsigned _sp = 0; while (cond) { __builtin_amdgcn_s_sleep(1); \
    if ((++_sp & 255u) == 0u) { if (xb_ld(&(bar)[XB_TMO])) break; if (_sp > XB_SPIN_CAP) { atomicAdd(&(bar)[XB_TMO], 1u); break; } } } } while (0)
struct XcdBarrier { unsigned* bar; unsigned x; volatile LAS unsigned* st; };
DEVI XcdBarrier xcd_barrier_post(unsigned* bar, volatile LAS unsigned* st) {
    XcdBarrier b; b.bar = bar; b.x = xb_xcc_id(); b.st = st;
    if (threadIdx.x == 0) (void)xb_add(&bar[XB_XCNT(b.x)], 1u);
    return b;
}
DEVI void xcd_barrier_complete(unsigned* bar, unsigned x, unsigned& nloc, unsigned& nx) {
    const unsigned G = gridDim.x * gridDim.y * gridDim.z;
    unsigned sum, cnt, mine, sp = 0u;
    for (;;) {
        sum = 0u; cnt = 0u; mine = 0u;
#pragma unroll
        for (unsigned j = 0; j < 16; ++j) { const unsigned c = xb_ld(&bar[XB_XCNT(j)]); sum += c; cnt += (c > 0u) ? 1u : 0u; mine = (j == x) ? c : mine; }
        if (sum == G) break;
        __builtin_amdgcn_s_sleep(1);
        if ((++sp & 255u) == 0u) { if (xb_ld(&bar[XB_TMO])) break; if (sp > XB_SPIN_CAP) { atomicAdd(&bar[XB_TMO], 1u); break; } }
    }
    nloc = mine > 0u ? mine : 1u; nx = cnt > 0u ? cnt : 1u;
}
DEVI void xcd_barrier(const XcdBarrier& b) {
    asm volatile("s_waitcnt vmcnt(0)" ::: "memory");
    __syncthreads();
    if (threadIdx.x == 0) {
        unsigned* bar = b.bar;
        __builtin_amdgcn_s_waitcnt(0);
        unsigned nloc = b.st[0], nx = b.st[1];
        if (nloc == 0u) { xcd_barrier_complete(bar, b.x, nloc, nx); b.st[0] = nloc; b.st[1] = nx; }
        const unsigned old = xb_add(&bar[XB_XSUB(b.x)], 1u);
        const unsigned gen = old / nloc;
        if (old + 1u == (gen + 1u) * nloc) {
            __builtin_amdgcn_fence(__ATOMIC_RELEASE, "agent");
            asm volatile("s_waitcnt vmcnt(0)" ::: "memory");
            const unsigned og = xb_add(&bar[XB_TOP], 1u);
            const unsigned tg = og / nx;
            if (og + 1u == (tg + 1u) * nx) xb_add(&bar[XB_TOPGEN], 1u);
            else XB_SPIN(xb_ld(&bar[XB_TOPGEN]) == tg, bar);
            __builtin_amdgcn_fence(__ATOMIC_ACQUIRE, "agent");
            xb_add(&bar[XB_XGEN(b.x)], 1u);
            asm volatile("s_waitcnt vmcnt(0)" ::: "memory");
        } else {
            XB_SPIN(xb_ld(&bar[XB_XGEN(b.x)]) == gen, bar);
            __builtin_amdgcn_fence(__ATOMIC_ACQUIRE, "agent");
            asm volatile("s_waitcnt vmcnt(0)" ::: "memory");
        }
    }
    __syncthreads();
}

DEVI unsigned pack_fp8x4(float a, float b, float c, float d);
namespace pg8 {
constexpr int BM = 256, BK = 64, HALF = 128, HTB = HALF * BK * 2, STAGE_BYTES = 8 * HTB, NXCD = 8, WGM = 8;
DEVI int lds_byte(int r, int c) { const int st = (r >> 4) * 2 + (c >> 5), rr = r & 15, cc = c & 31, ob = rr * 64 + cc * 2; return st * 1024 + (ob ^ (((ob >> 9) & 1) << 5)); }
DEVI void stage_rc(int b, int& R, int& C) { const int st = b / 1024, sb = b % 1024, swz = sb ^ (((sb >> 9) & 1) << 5); R = (st >> 1) * 16 + swz / 64; C = (st & 1) * 32 + (swz % 64) / 2; }
DEVI int perm32(int rho) { const int n = rho >> 4, i = rho & 15; return 8 * (i >> 2) + 4 * n + (i & 3); }
struct Unit { int pm, pn, aux, seq; };
struct Gemm { const bf16_t* A; const bf16_t* Bt; int lda; int K; int sa = 0x7f7f7f7f; };
DEVI bool static_unit(int nM, int nN, long L, Unit& u) {
    const int nwg = nM * nN; if (L >= nwg) return false;
    int wgid = (int)L; { const int q = nwg / NXCD, r = nwg % NXCD, xcd = wgid % NXCD, off = wgid / NXCD; wgid = (xcd < r ? xcd * (q + 1) : r * (q + 1) + (xcd - r) * q) + off; }
    const int nig = WGM * nN, gid = wgid / nig, fm = gid * WGM, gsz = (nM - fm) < WGM ? (nM - fm) : WGM;
    u.pm = fm + ((wgid % nig) % gsz); u.pn = (wgid % nig) / gsz; u.aux = 0; return true;
}

typedef int v4i_t __attribute__((ext_vector_type(4)));
typedef int v8i_t __attribute__((ext_vector_type(8)));
template <class Epi, class Sched, bool AFTER_DRAIN = false, bool HB = false, bool F8 = false>
DEVI void gemm_phase(LAS unsigned char* lds, const Gemm g, const Sched& S, const Epi& E) {
    static_assert(!F8 || HB, "the fp8 body is the half-width one");
    const int tid = threadIdx.x, wid = __builtin_amdgcn_readfirstlane(tid >> 6), lane = tid & 63, wr = wid >> 2, wc = wid & 3, fr = lane & 15, fq = lane >> 4;
    const int K = g.K, nt = K / BK;
    int sR[2], sC[2]; unsigned voffB[2];
#pragma unroll
    for (int i = 0; i < 2; ++i) { int R, C; stage_rc(tid * 16 + i * 8192, R, C); sR[i] = R; sC[i] = C; const int Rb = (R & ~31) + perm32(R & 31); voffB[i] = (unsigned)(Rb * K + C) * 2u; }
    const size_t kstep = (size_t)(BK * 2);
    const size_t hstepB = (size_t)HALF * K * 2;
    const size_t tstepB = HB ? hstepB : 2 * hstepB;
    const unsigned ldsw = (unsigned)wid * 1024u;
    const int aoff = lds_byte(wr * 64 + fr, fq * 8), boff = lds_byte(wc * 32 + fr, fq * 8);
#define PG8_SA(b, h) (((b) * 2 + (h)) * HTB)
#define PG8_SB(b, h) ((4 + (b) * 2 + (h)) * HTB)
#define PG8_STAGE(bufoff, gbase, voff) do { _Pragma("unroll") for (int _i = 0; _i < 2; ++_i) \
        __builtin_amdgcn_global_load_lds((const unsigned*)((const char*)(gbase) + (voff)[_i]), (LAS unsigned*)(lds + (bufoff) + ldsw + _i * 8192), 16, 0, 0); } while (0)
#define PG8_LD8(P) __builtin_shufflevector(*(const LAS v4i_t*)(P), *(const LAS v4i_t*)((P) + 1024), 0, 1, 2, 3, 4, 5, 6, 7)
#define PG8_LDA(dst, b, h) do { _Pragma("unroll") for (int m = 0; m < 4; ++m) { if constexpr (F8) dst##8[m] = PG8_LD8(lds + PG8_SA(b, h) + aoff + m * 2048); \
        else { _Pragma("unroll") for (int k = 0; k < 2; ++k) dst[m][k] = *(const LAS bf16x8*)(lds + PG8_SA(b, h) + aoff + m * 2048 + k * 1024); } } } while (0)
#define PG8_LDB(dst, b, h) do { _Pragma("unroll") for (int n = 0; n < 2; ++n) { if constexpr (F8) dst##8[n] = PG8_LD8(lds + PG8_SB(b, h) + boff + n * 2048); \
        else { _Pragma("unroll") for (int k = 0; k < 2; ++k) dst[n][k] = *(const LAS bf16x8*)(lds + PG8_SB(b, h) + boff + n * 2048 + k * 1024); } } } while (0)
#define PG8_MMA(ai, bj, At, Bt) do { __builtin_amdgcn_s_setprio(1); _Pragma("unroll") for (int m = 0; m < 4; ++m) _Pragma("unroll") for (int n = 0; n < 2; ++n) { \
        if constexpr (F8) acc[ai][bj][m][n] = __builtin_amdgcn_mfma_scale_f32_16x16x128_f8f6f4(Bt##8[n], At##8[m], acc[ai][bj][m][n], 0, 0, 0, g.sa, 0, 0x7f7f7f7f); \
        else { _Pragma("unroll") for (int k = 0; k < 2; ++k) acc[ai][bj][m][n] = __builtin_amdgcn_mfma_f32_16x16x32_bf16(Bt[n][k], At[m][k], acc[ai][bj][m][n], 0, 0, 0); } } \
        __builtin_amdgcn_s_setprio(0); } while (0)
#define PG8_WAIT_LOOP do { if constexpr (HB) PG8_WAIT_V(6); else PG8_WAIT_V(8); } while (0)
#define PG8_WAIT_V(n) asm volatile("s_waitcnt vmcnt(" #n ")" ::: "memory")
#define PG8_WAIT_L(n) asm volatile("s_waitcnt lgkmcnt(" #n ")" ::: "memory")
#define PG8_BAR __builtin_amdgcn_s_barrier()
#define PG8_SCHED __builtin_amdgcn_sched_barrier(0)
#define PG8_AOFFS(dst, u) do { _Pragma("unroll") for (int _h = 0; _h < 2; ++_h) _Pragma("unroll") for (int _i = 0; _i < 2; ++_i) \
        { const int raw_ = S.arow(u, _h * HALF + sR[_i]); dst[_h][_i] = ((unsigned)(raw_ < 0 ? 0 : raw_) * (unsigned)g.lda + (unsigned)sC[_i]) * 2u; } } while (0)
    Unit cur, nxt; int ui = 0;
    if (!S.next(0, cur)) return;
    f32x4 acc[2][2][4][2];
#pragma unroll
    for (int a = 0; a < 2; ++a)
#pragma unroll
        for (int b = 0; b < 2; ++b)
#pragma unroll
            for (int m = 0; m < 4; ++m)
#pragma unroll
                for (int n = 0; n < 2; ++n) acc[a][b][m][n] = (f32x4){0.f, 0.f, 0.f, 0.f};
    bf16x8 At[4][2], B0[2][2], B1[2][2]; v8i_t At8[4], B08[2], B18[2];
    unsigned cOff[2][2], nOff[2][2];
    PG8_AOFFS(cOff, cur);
    bool has_next = S.next(1, nxt);
    if (has_next) { PG8_AOFFS(nOff, nxt); } else {
#pragma unroll
        for (int _h = 0; _h < 2; ++_h)
#pragma unroll
            for (int _i = 0; _i < 2; ++_i) nOff[_h][_i] = cOff[_h][_i]; }
    const char* gA = (const char*)g.A;
    const char* cB = (const char*)g.Bt + (size_t)cur.pn * tstepB;
    PG8_STAGE(PG8_SB(0, 0), cB, voffB); if constexpr (!HB) PG8_STAGE(PG8_SB(0, 1), cB + hstepB, voffB); PG8_STAGE(PG8_SA(0, 0), gA, cOff[0]); PG8_STAGE(PG8_SA(0, 1), gA, cOff[1]);
    if (wr == 1) PG8_BAR;
    PG8_WAIT_V(2); PG8_BAR;
    PG8_STAGE(PG8_SB(1, 0), cB + kstep, voffB); PG8_STAGE(PG8_SA(1, 0), gA + kstep, cOff[0]); if constexpr (!HB) PG8_STAGE(PG8_SB(1, 1), cB + hstepB + kstep, voffB);
    if constexpr (HB) PG8_WAIT_V(4); else PG8_WAIT_V(6);
    PG8_BAR;
    for (;;) {
        const char* nB = has_next ? (const char*)g.Bt + (size_t)nxt.pn * tstepB : cB;
        cur.seq = ui;
        if constexpr (Epi::PRE) E.prefetch(lds, cur, wid, lane);
        Unit nn; int nnRaw[2][2];
        const bool has_nn = has_next && S.next(ui + 2, nn);
        if constexpr (Sched::IDX_DMA) { if (has_nn) S.idx_dma(lds, nn, ui, wid, lane); }
        else {
#pragma unroll
            for (int _h = 0; _h < 2; ++_h)
#pragma unroll
                for (int _i = 0; _i < 2; ++_i) nnRaw[_h][_i] = has_nn ? S.arow(nn, _h * HALF + sR[_i]) : 0; }
#pragma unroll 1
        for (int t = 0; t < nt; t += 2) {
            const bool last = (t == nt - 2);
            const char* a1 = gA + (size_t)(t + 1) * kstep;
            const char* a2 = last ? gA : gA + (size_t)(t + 2) * kstep; const char* b2 = last ? nB : cB + (size_t)(t + 2) * kstep;
            const char* a3 = a2 + kstep; const char* b3 = b2 + kstep;
            unsigned o2[2][2];
#pragma unroll
            for (int _h = 0; _h < 2; ++_h)
#pragma unroll
                for (int _i = 0; _i < 2; ++_i) o2[_h][_i] = last ? nOff[_h][_i] : cOff[_h][_i];
            PG8_LDB(B0, 0, 0); if constexpr (!HB) PG8_LDB(B1, 0, 1); PG8_SCHED; PG8_LDA(At, 0, 0); PG8_STAGE(PG8_SA(1, 1), a1, cOff[1]);
            PG8_WAIT_LOOP; PG8_WAIT_L(0); PG8_BAR; PG8_MMA(0, 0, At, B0); if constexpr (!HB) PG8_MMA(0, 1, At, B1); PG8_BAR; PG8_SCHED;
            PG8_LDA(At, 0, 1); PG8_STAGE(PG8_SB(0, 0), b2, voffB); if constexpr (!HB) PG8_STAGE(PG8_SB(0, 1), b2 + hstepB, voffB); PG8_STAGE(PG8_SA(0, 0), a2, o2[0]);
            PG8_WAIT_LOOP; PG8_WAIT_L(0); PG8_BAR; PG8_MMA(1, 0, At, B0); if constexpr (!HB) PG8_MMA(1, 1, At, B1); PG8_BAR; PG8_SCHED;
            PG8_LDB(B0, 1, 0); if constexpr (!HB) PG8_LDB(B1, 1, 1); PG8_SCHED; PG8_LDA(At, 1, 0); PG8_STAGE(PG8_SA(0, 1), a2, o2[1]);
            PG8_WAIT_LOOP; PG8_WAIT_L(0); PG8_BAR; PG8_MMA(0, 0, At, B0); if constexpr (!HB) PG8_MMA(0, 1, At, B1); PG8_BAR; PG8_SCHED;
            PG8_LDA(At, 1, 1); PG8_STAGE(PG8_SB(1, 0), b3, voffB); if constexpr (!HB) PG8_STAGE(PG8_SB(1, 1), b3 + hstepB, voffB); PG8_STAGE(PG8_SA(1, 0), a3, o2[0]);
            PG8_WAIT_LOOP; PG8_WAIT_L(0); PG8_BAR; PG8_MMA(1, 0, At, B0); if constexpr (!HB) PG8_MMA(1, 1, At, B1); PG8_BAR; PG8_SCHED;
        }
        if (wr == 0) PG8_BAR;
        if constexpr (!AFTER_DRAIN) E(acc, cur, wr, wc, fr, fq);
        if (!has_next) break;
#pragma unroll
        for (int a = 0; a < 2; ++a)
#pragma unroll
            for (int b = 0; b < 2; ++b)
#pragma unroll
                for (int m = 0; m < 4; ++m)
#pragma unroll
                    for (int n = 0; n < 2; ++n) acc[a][b][m][n] = (f32x4){0.f, 0.f, 0.f, 0.f};
        cur = nxt; cB = nB; ++ui; nxt = nn; has_next = has_nn;
#pragma unroll
        for (int _h = 0; _h < 2; ++_h)
#pragma unroll
            for (int _i = 0; _i < 2; ++_i) { int raw;
                if constexpr (Sched::IDX_DMA) raw = has_nn ? S.idx_lds(lds, ui - 1, _h * HALF + sR[_i]) : 0; else { raw = nnRaw[_h][_i]; asm volatile("" : "+v"(raw)); }
                cOff[_h][_i] = nOff[_h][_i]; if (has_nn) nOff[_h][_i] = ((unsigned)(raw < 0 ? 0 : raw) * (unsigned)g.lda + (unsigned)sC[_i]) * 2u; }
        if (wr == 1) PG8_BAR;
    }
    PG8_WAIT_V(0);
    PG8_BAR;
    if constexpr (AFTER_DRAIN) E(acc, cur, wr, wc, fr, fq);
#undef PG8_SA
#undef PG8_SB
#undef PG8_STAGE
#undef PG8_LDA
#undef PG8_LD8
#undef PG8_WAIT_LOOP
#undef PG8_LDB
#undef PG8_MMA
#undef PG8_WAIT_V
#undef PG8_WAIT_L
#undef PG8_BAR
#undef PG8_SCHED
#undef PG8_AOFFS
}

template <class Epi, class Sched, int GRP>
DEVI void gemm_phase_astat8(LAS unsigned char* lds, const Gemm g, const Sched& S, const Epi& E) {
    const int tid = threadIdx.x, wid = __builtin_amdgcn_readfirstlane(tid >> 6), lane = tid & 63, wr = GRP, wc = wid & 3, fr = lane & 15, fq = lane >> 4;
    const int K = g.K;
    int sR[2], sC[2]; unsigned voffB[2], vA[2][2];
#pragma unroll
    for (int i = 0; i < 2; ++i) { int R, C; stage_rc(tid * 16 + i * 8192, R, C); sR[i] = R; sC[i] = C; const int Rb = (R & ~31) + perm32(R & 31); voffB[i] = (unsigned)(Rb * K + C) * 2u; }
#pragma unroll
    for (int h = 0; h < 2; ++h)
#pragma unroll
        for (int i = 0; i < 2; ++i) vA[h][i] = ((unsigned)(h * HALF + sR[i]) * (unsigned)g.lda + (unsigned)sC[i]) * 2u;
    const size_t kstep = (size_t)(BK * 2);
    const size_t tstepB = (size_t)HALF * K * 2;
    const unsigned ldsw = (unsigned)wid * 1024u;
    const int aoff = lds_byte(wr * 64 + fr, fq * 8), boff = lds_byte(wc * 32 + fr, fq * 8);
#define AS_STAGE(bufoff, gbase, voff) do { _Pragma("unroll") for (int _i = 0; _i < 2; ++_i) \
        __builtin_amdgcn_global_load_lds((const unsigned*)((const char*)(gbase) + (voff)[_i]), (LAS unsigned*)(lds + (bufoff) + ldsw + _i * 8192), 16, 0, 0); } while (0)
#define AS_STAGE_A(kt, pm_) do { const char* ab_ = gA + (size_t)(pm_) * 256u * (size_t)g.lda * 2u + (size_t)(kt) * kstep; \
        AS_STAGE(((kt) * 2) * HTB, ab_, vA[0]); AS_STAGE(((kt) * 2 + 1) * HTB, ab_, vA[1]); } while (0)
#define AS_STAGE_B(ht, Bp, kt) AS_STAGE((4 + (ht)) * HTB, (Bp) + (size_t)(kt) * kstep, voffB)
#define AS_LD8(P) __builtin_shufflevector(*(const LAS v4i_t*)(P), *(const LAS v4i_t*)((P) + 1024), 0, 1, 2, 3, 4, 5, 6, 7)
#define AS_LOADF(kt, slot) do { \
        _Pragma("unroll") for (int n = 0; n < 2; ++n) b8[n] = AS_LD8(lds + (4 + (slot) * 2 + (kt)) * HTB + boff + n * 2048); \
        _Pragma("unroll") for (int a = 0; a < 2; ++a) _Pragma("unroll") for (int m = 0; m < 4; ++m) a8[a][m] = AS_LD8(lds + ((kt) * 2 + a) * HTB + aoff + m * 2048); } while (0)
#define AS_MMA() do { __builtin_amdgcn_s_setprio(1); \
        _Pragma("unroll") for (int a = 0; a < 2; ++a) _Pragma("unroll") for (int m = 0; m < 4; ++m) _Pragma("unroll") for (int n = 0; n < 2; ++n) \
            acc[a][0][m][n] = __builtin_amdgcn_mfma_scale_f32_16x16x128_f8f6f4(b8[n], a8[a][m], acc[a][0][m][n], 0, 0, 0, g.sa, 0, 0x7f7f7f7f); \
        __builtin_amdgcn_s_setprio(0); } while (0)
#define AS_ZERO() do { _Pragma("unroll") for (int a = 0; a < 2; ++a) _Pragma("unroll") for (int m = 0; m < 4; ++m) _Pragma("unroll") for (int n = 0; n < 2; ++n) acc[a][0][m][n] = (f32x4){0.f, 0.f, 0.f, 0.f}; } while (0)
#define AS_WAIT(N) asm volatile("s_waitcnt vmcnt(" #N ") lgkmcnt(0)" ::: "memory")
#define AS_LWAIT() do { asm volatile("s_waitcnt lgkmcnt(0)" ::: "memory"); __builtin_amdgcn_sched_barrier(0); } while (0)
    static_assert(Epi::NST == 8, "the counted waits below assume 8 stores per epilogue");
    Unit cur, nxt, prv; int ui = 0;
    if (!S.next(0, cur)) return;
    prv = cur;
    f32x4 acc[2][2][4][2];
    AS_ZERO();
    v8i_t b8[2], a8[2][4];
    bool has_next = S.next(1, nxt);
    const char* gA = (const char*)g.A;
    const char* cB = (const char*)g.Bt + (size_t)cur.pn * tstepB;
    AS_STAGE_A(0, cur.pm); AS_STAGE_A(1, cur.pm); AS_STAGE_B(0, cB, 0); AS_STAGE_B(1, cB, 1);
    bool switched = false;
    for (;;) {
        const char* nB = has_next ? (const char*)g.Bt + (size_t)nxt.pn * tstepB : cB;
        const int slot = ui & 1;
        if (ui == 0 || (GRP == 1 && ui == 1)) AS_WAIT(0); else AS_WAIT(8);
        __builtin_amdgcn_s_barrier();
        __builtin_amdgcn_sched_barrier(0);
        if (switched) {
            AS_STAGE_A(0, cur.pm); AS_STAGE_A(1, cur.pm);
            asm volatile("s_waitcnt vmcnt(0)" ::: "memory");
            __builtin_amdgcn_s_barrier();
            __builtin_amdgcn_sched_barrier(0);
        }
        AS_STAGE_B((slot ^ 1) * 2, nB, 0); AS_STAGE_B((slot ^ 1) * 2 + 1, nB, 1);
        if constexpr (GRP == 0) {
            AS_LOADF(0, slot); AS_LWAIT(); AS_MMA(); __builtin_amdgcn_sched_barrier(0);
            AS_LOADF(1, slot); AS_LWAIT(); AS_MMA(); __builtin_amdgcn_sched_barrier(0);
            E(acc, cur, wr, wc, fr, fq); AS_ZERO();
        } else {
            if (ui > 0) { AS_MMA(); __builtin_amdgcn_sched_barrier(0); E(acc, prv, wr, wc, fr, fq); AS_ZERO(); }
            __builtin_amdgcn_sched_barrier(0);
            AS_LOADF(0, slot); AS_LWAIT(); AS_MMA(); __builtin_amdgcn_sched_barrier(0);
            AS_LOADF(1, slot);
        }
        __builtin_amdgcn_sched_barrier(0);
        prv = cur;
        if (!has_next) break;
        switched = nxt.pm != cur.pm; cur = nxt; cB = nB; ++ui; has_next = S.next(ui + 1, nxt);
    }
    if constexpr (GRP == 1) { AS_LWAIT(); AS_MMA(); E(acc, prv, wr, wc, fr, fq); }
    asm volatile("s_waitcnt vmcnt(0)" ::: "memory");
    __builtin_amdgcn_s_barrier();
#undef AS_LOADF
#undef AS_MMA
#undef AS_WAIT
#undef AS_LWAIT
#undef AS_STAGE
#undef AS_STAGE_A
#undef AS_STAGE_B
#undef AS_LD8
#undef AS_ZERO
}

struct DnArgs { const unsigned char* A; const unsigned char* Bt; unsigned char* O; int hh; int sa; };
template <class Sched>
DEVI void gemm_phase_dnreg(LAS unsigned char* lds, const DnArgs g, const Sched& S) {
    const int tid = threadIdx.x, wid = __builtin_amdgcn_readfirstlane(tid >> 6), lane = tid & 63, fr = lane & 15, fq = lane >> 4;
    constexpr int KB = 256;
    unsigned voffB[2];
#pragma unroll
    for (int i = 0; i < 2; ++i) { int R, C; stage_rc(tid * 16 + i * 8192, R, C); const int j = R >> 4, q4 = (R >> 2) & 3, r = R & 3;
        const int col = 64 * (j >> 2) + 16 * q4 + 4 * (j & 3) + r; voffB[i] = (unsigned)(col * KB + C * 2); }
    const unsigned ldsw = (unsigned)wid * 1024u;
    const int boff = lds_byte(fr, fq * 8);
#define DN_STAGE_B(slot, Bp, kt) do { _Pragma("unroll") for (int _i = 0; _i < 2; ++_i) \
        __builtin_amdgcn_global_load_lds((const unsigned*)((Bp) + (kt) * 128 + voffB[_i]), (LAS unsigned*)(lds + (slot) * HTB + ldsw + _i * 8192), 16, 0, 0); } while (0)
#define DN_LOADA(dst, pm_) do { const unsigned char* ap_ = g.A + ((size_t)(pm_) * 256u + 32u * wid + fr) * KB + 16 * fq; \
        _Pragma("unroll") for (int kt = 0; kt < 2; ++kt) _Pragma("unroll") for (int m = 0; m < 2; ++m) { \
            const v4i_t lo_ = *(const v4i_t*)(ap_ + m * 16 * KB + kt * 128), hi_ = *(const v4i_t*)(ap_ + m * 16 * KB + kt * 128 + 64); \
            dst[kt][m] = __builtin_shufflevector(lo_, hi_, 0, 1, 2, 3, 4, 5, 6, 7); } } while (0)
#define DN_LD8(P) __builtin_shufflevector(*(const LAS v4i_t*)(P), *(const LAS v4i_t*)((P) + 1024), 0, 1, 2, 3, 4, 5, 6, 7)
#define DN_TILE(kt, slot) do { v8i_t b8[8]; \
        _Pragma("unroll") for (int j = 0; j < 8; ++j) b8[j] = DN_LD8(lds + (slot) * HTB + boff + j * 2048); \
        __builtin_amdgcn_s_setprio(1); \
        _Pragma("unroll") for (int j = 0; j < 8; ++j) _Pragma("unroll") for (int m = 0; m < 2; ++m) \
            acc[m][j] = __builtin_amdgcn_mfma_scale_f32_16x16x128_f8f6f4(b8[j], a8[kt][m], acc[m][j], 0, 0, 0, g.sa, 0, 0x7f7f7f7f); \
        __builtin_amdgcn_s_setprio(0); } while (0)
    Unit cur, nxt, fut;
    if (!S.next(0, cur)) return;
    f32x4 acc[2][8];
#pragma unroll
    for (int m = 0; m < 2; ++m)
#pragma unroll
        for (int j = 0; j < 8; ++j) acc[m][j] = (f32x4){0.f, 0.f, 0.f, 0.f};
    v8i_t a8[2][2], a8n[2][2];
    constexpr size_t TB = (size_t)128 * KB;
#pragma unroll
    for (int v = 0; v < 3; ++v) { Unit uv; const bool ok = S.next(v, uv); const unsigned char* bp = g.Bt + (size_t)(ok ? uv.pn : cur.pn) * TB;
        DN_STAGE_B(2 * v, bp, 0); DN_STAGE_B(2 * v + 1, bp, 1); }
    DN_LOADA(a8, cur.pm);
#pragma unroll
    for (int kt = 0; kt < 2; ++kt)
#pragma unroll
        for (int m = 0; m < 2; ++m) a8n[kt][m] = a8[kt][m];
    bool has_next = S.next(1, nxt);
    for (int ui = 0;; ++ui) {
        asm volatile("s_waitcnt vmcnt(8) lgkmcnt(0)" ::: "memory");
        __builtin_amdgcn_s_barrier();
        __builtin_amdgcn_sched_barrier(0);
        { const bool okf = S.next(ui + 3, fut); const unsigned char* bp = g.Bt + (size_t)(okf ? fut.pn : cur.pn) * TB;
          const int s3 = (2 * ui + 6) & 7; DN_STAGE_B(s3, bp, 0); DN_STAGE_B(s3 + 1, bp, 1); }
        const bool sw = has_next && nxt.pm != cur.pm;
        if (sw) DN_LOADA(a8n, nxt.pm);
        __builtin_amdgcn_sched_barrier(0);
        const int s0 = (2 * ui) & 7;
        DN_TILE(0, s0);
        DN_TILE(1, s0 + 1);
        {
            int frr = fr, fqq = fq; asm volatile("" : "+v"(frr), "+v"(fqq));
            unsigned char* op = g.O + (size_t)((cur.pm - g.hh * HTILES) * 256 + 32 * wid + frr) * DM + cur.aux * 128 + 16 * fqq;
#pragma unroll
            for (int m = 0; m < 2; ++m)
#pragma unroll
                for (int hf = 0; hf < 2; ++hf) { u32x4 o;
#pragma unroll
                    for (int jj = 0; jj < 4; ++jj) { const f32x4 v = acc[m][4 * hf + jj]; o[jj] = pack_fp8x4(v[0], v[1], v[2], v[3]); }
                    *(u32x4*)(op + (size_t)m * 16 * DM + 64 * hf) = o; }
        }
        if (!has_next) break;
#pragma unroll
        for (int m = 0; m < 2; ++m)
#pragma unroll
            for (int j = 0; j < 8; ++j) acc[m][j] = (f32x4){0.f, 0.f, 0.f, 0.f};
        if (sw) {
#pragma unroll
            for (int kt = 0; kt < 2; ++kt)
#pragma unroll
                for (int m = 0; m < 2; ++m) a8[kt][m] = a8n[kt][m]; }
        cur = nxt; has_next = S.next(ui + 2, nxt);
    }
    asm volatile("s_waitcnt vmcnt(0)" ::: "memory");
    __builtin_amdgcn_s_barrier();
#undef DN_STAGE_B
#undef DN_LOADA
#undef DN_LD8
#undef DN_TILE
}
}


struct Frame {
    LAS unsigned char* lds;
    int tid, lane, wave, G, blk;
    const Params* p;
    unsigned char* ws;
};

DEVI float clamp_fp8(float x) { return __builtin_amdgcn_fmed3f(x, -440.f, 440.f); }
DEVI unsigned pack_fp8x4(float a, float b, float c, float d) { int p = __builtin_amdgcn_cvt_pk_fp8_f32(clamp_fp8(a), clamp_fp8(b), 0, false); p = __builtin_amdgcn_cvt_pk_fp8_f32(clamp_fp8(c), clamp_fp8(d), p, true); return (unsigned)p; }
template <class SrcF>
DEVI void transpose_item8(const SrcF& src, unsigned char* WT8, int K, int k0, int n0, LAS float* scr, int lane, float scale) {
#pragma unroll 8
    for (int i = 0; i < 32; ++i) { const int kk = 2 * i + (lane >> 5); scr[kk * 33 + (lane & 31)] = *src(k0 + kk, n0 + (lane & 31)); }
    LDS_WAIT(); asm volatile("" ::: "memory");
    const int n = lane >> 1, hf = lane & 1; const LAS float* sp = scr + (32 * hf) * 33 + n;
    u32x4 o0, o1;
#pragma unroll
    for (int q = 0; q < 4; ++q) { o0[q] = pack_fp8x4(sp[(4 * q) * 33] * scale, sp[(4 * q + 1) * 33] * scale, sp[(4 * q + 2) * 33] * scale, sp[(4 * q + 3) * 33] * scale);
        o1[q] = pack_fp8x4(sp[(16 + 4 * q) * 33] * scale, sp[(17 + 4 * q) * 33] * scale, sp[(18 + 4 * q) * 33] * scale, sp[(19 + 4 * q) * 33] * scale); }
    unsigned char* dst = WT8 + (size_t)(n0 + n) * K + k0 + 32 * hf;
    *(u32x4*)dst = o0; *(u32x4*)(dst + 16) = o1;
    LDS_WAIT(); asm volatile("" ::: "memory");
}
template <class SrcF>
DEVI void transpose_item(const SrcF& src, bf16_t* WT, int K, int k0, int n0, LAS float* scr, int lane) {
#pragma unroll 8
    for (int i = 0; i < 32; ++i) { const int kk = 2 * i + (lane >> 5); scr[kk * 33 + (lane & 31)] = *src(k0 + kk, n0 + (lane & 31)); }
    LDS_WAIT(); asm volatile("" ::: "memory");
    const int c = lane & 7;
#pragma unroll
    for (int j = 0; j < 4; ++j) { const int n = (lane >> 3) + 8 * j; const LAS float* s = scr + (8 * c) * 33 + n;
        u32x4 o; o.x = cvt_pk_bf16(s[0 * 33], s[1 * 33]); o.y = cvt_pk_bf16(s[2 * 33], s[3 * 33]); o.z = cvt_pk_bf16(s[4 * 33], s[5 * 33]); o.w = cvt_pk_bf16(s[6 * 33], s[7 * 33]);
        *(u32x4*)(WT + (size_t)(n0 + n) * K + k0 + 8 * c) = o; }
    LDS_WAIT(); asm volatile("" ::: "memory");
}
DEVI int win_src_col(int c) {
    const int sec = c >> 9, h = (c >> 7) & 3, s = c & 127;
    int ssec = sec;
    if (sec == 3) ssec = 4; else if (sec == 4) ssec = 5; else if (sec == 5) ssec = 6; else if (sec == 6) ssec = 3;
    int d = s;
    if (sec < 2) { const int wc = s >> 5, fq = (s >> 3) & 3, n = (s >> 2) & 1, i = s & 3; d = 64 * n + 16 * wc + 4 * fq + i; }
    return ssec * 512 + h * 128 + d;
}
struct SrcWin { const float* w; DEVI const float* operator()(int k, int n) const { return w + (size_t)k * INC + win_src_col(n); } };
struct SrcPlain { const float* w; int N; DEVI const float* operator()(int k, int n) const { return w + (size_t)k * N + n; } };
struct SrcGU { const float* wg; long dwu; DEVI const float* operator()(int k, int r) const {
        const int ff = 64 * (r >> 7) + 16 * ((r >> 5) & 3) + 4 * ((r >> 3) & 3) + (r & 3); const long sel = ((r >> 2) & 1) ? dwu : 0l; return wg + ((long)k * EFF + ff + sel); } };

DEVI void phase_prep(Frame& F) {
    const Params& P = *F.p;
    if (F.blk < 96) {
        LAS float* sc = (LAS float*)F.lds;
        LAS float* red = sc + 9 * 1024;
        for (int i = F.tid; i < 9 * 1024; i += NTHREADS) { const int v = i >> 10, k = i & 1023; const float cv = v < 8 ? P.in[I_C][v * DM + k] : P.in[I_CCTX][k]; sc[i] = cv / (1.f + __expf(-cv)); }
        __syncthreads();
        const int c = F.tid & 63, ks = F.tid >> 6, n = F.blk * 64 + c;
        float a[9];
#pragma unroll
        for (int v = 0; v < 9; ++v) a[v] = 0.f;
        const float* w = P.in[I_WMOD] + (size_t)(ks * 128) * 6144 + n;
#pragma unroll 16
        for (int k = 0; k < 128; ++k) { const float wv = w[(size_t)k * 6144];
#pragma unroll
            for (int v = 0; v < 9; ++v) a[v] += sc[v * 1024 + ks * 128 + k] * wv; }
#pragma unroll
        for (int v = 0; v < 9; ++v) red[(ks * 9 + v) * 64 + c] = a[v];
        __syncthreads();
        for (int i = F.tid; i < 9 * 64; i += NTHREADS) { const int v = i >> 6, cc = i & 63; float sum = P.in[I_BMOD][F.blk * 64 + cc];
#pragma unroll
            for (int q = 0; q < 8; ++q) sum += red[(q * 9 + v) * 64 + cc];
            ((float*)(F.ws + WS_MODP))[(size_t)v * 6144 + F.blk * 64 + cc] = sum; }
        __syncthreads();
    }
    for (int i = F.blk * NTHREADS + F.tid; i < 256 * 1024; i += F.G * NTHREADS) { const int r = i >> 10, k = i & 1023; bf16_t v = 0;
        if (r < 64) v = f2bf(P.in[I_WR][k * NE + r]);
        else if (r >= 128 && r < 192) { const float w = P.in[I_WR][k * NE + r - 128]; v = f2bf(w - bf2f(f2bf(w))); }
        ((bf16_t*)(F.ws + WS_WRT))[i] = v; }
    LAS float* scr = (LAS float*)(F.lds + 57344 + F.wave * 8704);
    const int gw = F.blk * NWAVES + F.wave, NGW = F.G * NWAVES;
    constexpr int I_IN = (DM / 64) * (PN / 32), I_OUT = (DM / 64) * (DM / 32);
    for (int it = gw; it < I_IN + I_OUT; it += NGW) {
        if (it < I_IN) { const int kb = it / (PN / 32), nb = it % (PN / 32); transpose_item(SrcWin{P.in[I_WIN]}, (bf16_t*)(F.ws + WS_WINT), DM, kb * 64, nb * 32, scr, F.lane); }
        else { const int r = it - I_IN, kb = r / (DM / 32), nb = r % (DM / 32); transpose_item(SrcPlain{P.in[I_WOUT], DM}, (bf16_t*)(F.ws + WS_WOUTT), DM, kb * 64, nb * 32, scr, F.lane); }
    }
}
DEVI float mod_value(Frame& F, int v, int n) { return ((const float*)(F.ws + WS_MODP))[(size_t)v * 6144 + n]; }

DEVI void phase_norm1(Frame& F) {
    const Params& P = *F.p;
    LAS float* WG = (LAS float*)F.lds;
    LAS float* MODS = (LAS float*)(F.lds + 65536);
    for (int i0 = 0; i0 < 16 * 1024; i0 += 8 * NTHREADS) { float tv[8];
#pragma unroll
        for (int q = 0; q < 8; ++q) { const int i = i0 + F.tid + q * NTHREADS; tv[q] = P.in[I_WIN][(size_t)(i >> 4) * INC + 4096 + (i & 15)]; }
#pragma unroll
        for (int q = 0; q < 8; ++q) { const int i = i0 + F.tid + q * NTHREADS; WG[(i & 15) * 1024 + (i >> 4)] = tv[q]; } }
    for (int i0 = 0; i0 < 9 * 2048; i0 += 12 * NTHREADS) { float tv[12];
#pragma unroll
        for (int q = 0; q < 12; ++q) { const int i = i0 + F.tid + q * NTHREADS; tv[q] = mod_value(F, i / 2048, i % 2048); }
#pragma unroll
        for (int q = 0; q < 12; ++q) { const int i = i0 + F.tid + q * NTHREADS; MODS[i] = (i % 2048) < 1024 ? tv[q] : 1.f + tv[q]; } }
    __syncthreads();
    const float* g0 = P.in[I_NORMG];
    f32x4 gv[4];
#pragma unroll
    for (int j = 0; j < 4; ++j) gv[j] = *(const f32x4*)(g0 + 256 * j + 4 * F.lane);
    float gb = 0.f; if (F.lane < 16) gb = P.in[I_GATEB][F.lane];
    f32x4 wreg[8][4];
#pragma unroll
    for (int gj = 0; gj < 8; ++gj)
#pragma unroll
        for (int j = 0; j < 4; ++j) wreg[gj][j] = *(const LAS f32x4*)(WG + gj * 1024 + 256 * j + 4 * F.lane);
    bf16_t* HL = (bf16_t*)(F.ws + WS_B); float* GT = (float*)(F.ws + WS_GATES);
    const int gw = F.blk * NWAVES + F.wave, NGW = F.G * NWAVES;
    f32x4 xn[4];
    if (gw < TT) { const float* xr = gw < T ? P.in[I_X] + (size_t)gw * DM : P.in[I_CTX] + (size_t)(gw - T) * DM;
#pragma unroll
        for (int j = 0; j < 4; ++j) xn[j] = *(const f32x4*)(xr + 256 * j + 4 * F.lane); }
    for (int row = gw; row < TT; row += NGW) {
        const int v = row < T ? (row >> 13) : 8;
        f32x4 x[4]; float ss = 0.f;
#pragma unroll
        for (int j = 0; j < 4; ++j) { x[j] = xn[j]; ss += x[j].x * x[j].x + x[j].y * x[j].y + x[j].z * x[j].z + x[j].w * x[j].w; }
        { const int nr = row + NGW; if (nr < TT) { const float* xr = nr < T ? P.in[I_X] + (size_t)nr * DM : P.in[I_CTX] + (size_t)(nr - T) * DM;
#pragma unroll
            for (int j = 0; j < 4; ++j) xn[j] = *(const f32x4*)(xr + 256 * j + 4 * F.lane); } }
        const float rstd = rsqrtf(wave_sum(ss) * (1.f / DM) + EPS);
        const LAS float* ms = MODS + v * 2048;
#pragma unroll
        for (int j = 0; j < 4; ++j) { const f32x4 sh = *(const LAS f32x4*)(ms + 256 * j + 4 * F.lane), sc = *(const LAS f32x4*)(ms + 1024 + 256 * j + 4 * F.lane);
            x[j] = (x[j] * rstd * gv[j]) * sc + sh;
            u32x2 o; o.x = cvt_pk_bf16(x[j].x, x[j].y); o.y = cvt_pk_bf16(x[j].z, x[j].w);
            *(u32x2*)(HL + (size_t)row * DM + 256 * j + 4 * F.lane) = o; }
        float ga[16];
#pragma unroll
        for (int gj = 0; gj < 16; ++gj) { float a = 0.f;
#pragma unroll
            for (int j = 0; j < 4; ++j) { f32x4 w; if (gj < 8) w = wreg[gj][j]; else w = *(const LAS f32x4*)(WG + gj * 1024 + 256 * j + 4 * F.lane);
                a += x[j].x * w.x + x[j].y * w.y + x[j].z * w.z + x[j].w * w.w; }
            ga[gj] = a; }
        float myg;
        {   const bool b0 = F.lane & 1, b1 = F.lane & 2, b2 = F.lane & 4, b3 = F.lane & 8;
            float g8[8], g4[4], g2[2];
#pragma unroll
            for (int j = 0; j < 8; ++j) g8[j] = (b0 ? ga[2 * j + 1] : ga[2 * j]) + dpp_x1(b0 ? ga[2 * j] : ga[2 * j + 1]);
#pragma unroll
            for (int j = 0; j < 4; ++j) g4[j] = (b1 ? g8[2 * j + 1] : g8[2 * j]) + dpp_x2(b1 ? g8[2 * j] : g8[2 * j + 1]);
#pragma unroll
            for (int j = 0; j < 2; ++j) g2[j] = (b2 ? g4[2 * j + 1] : g4[2 * j]) + dpp_x4(b2 ? g4[2 * j] : g4[2 * j + 1]);
            myg = (b3 ? g2[1] : g2[0]) + dpp_x8(b3 ? g2[0] : g2[1]);
            myg += __shfl_xor(myg, 16); myg += __shfl_xor(myg, 32); }
        if (F.lane < 16) GT[(size_t)row * 16 + F.lane] = myg + gb;
    }
}

struct SchedProj {
    int G, c;
    DEVI bool next(int i, pg8::Unit& u) const {
        const long L = (long)i * G + c;
        if (L < 4096) return pg8::static_unit(256, 16, L, u);
        const int j = (int)(L - 4096); if (j >= 64) return false;
        const int ct = j & 7; u.pm = 256 + (j >> 3); u.pn = (ct < 4 ? 2 + ct : 4 + ct); u.aux = 0; return true;
    }
    DEVI int arow(const pg8::Unit& u, int r) const { return u.pm * 256 + r; }
    static constexpr bool IDX_DMA = false; };
struct EpiProj {
    bf16_t* O;
    static constexpr bool PRE = false;
    DEVI void operator()(const f32x4 (&acc)[2][2][4][2], const pg8::Unit& u, int wr, int wc, int fr, int fq) const {
        const int row0 = u.pm * 256 + wr * 64 + fr, col0 = u.pn * 256 + wc * 32 + 8 * fq;
        const bool rope = (u.pn < 4) && (u.pm < 256);
        const float qs = (u.pn < 2) ? 0.08838834764831845f : 1.f;
        float f2[4];
#pragma unroll
        for (int i = 0; i < 4; ++i) f2[i] = exp2f(-(float)(16 * (wc & 1) + 4 * fq + i) * (13.287712379549449f / 32.f)) * 0.15915494309189535f;
#pragma unroll
        for (int ai = 0; ai < 2; ++ai)
#pragma unroll
            for (int m = 0; m < 4; ++m) {
                const int row = row0 + ai * 128 + m * 16; const int pos = row & (SEQ - 1);
                const float pp = (float)((wc < 2) ? (pos >> 6) : (pos & 63));
                float cs[4], sn[4];
                if (rope) {
#pragma unroll
                    for (int i = 0; i < 4; ++i) { const float rev = __builtin_amdgcn_fractf(pp * f2[i]); cs[i] = __builtin_amdgcn_cosf(rev); sn[i] = __builtin_amdgcn_sinf(rev); }
                }
                bf16_t* rowp = O + (size_t)row * PN + col0;
#pragma unroll
                for (int bj = 0; bj < 2; ++bj) { f32x4 v0 = acc[ai][bj][m][0], v1 = acc[ai][bj][m][1];
                    if (rope) {
#pragma unroll
                        for (int i = 0; i < 4; ++i) { const float t1 = v0[i], t2 = v1[i]; v0[i] = t1 * cs[i] - t2 * sn[i]; v1[i] = t2 * cs[i] + t1 * sn[i]; } }
                    v0 = v0 * qs; v1 = v1 * qs;
                    u32x4 w; w.x = cvt_pk_bf16(v0[0], v0[1]); w.y = cvt_pk_bf16(v0[2], v0[3]); w.z = cvt_pk_bf16(v1[0], v1[1]); w.w = cvt_pk_bf16(v1[2], v1[3]);
                    *(u32x4*)(rowp + bj * 128) = w; }
            }
    }
};
DEVI void phase_gemm_proj(Frame& F) {
    pg8::Gemm g{(const bf16_t*)(F.ws + WS_B), (const bf16_t*)(F.ws + WS_WINT), DM, DM};
    SchedProj S{F.G, F.blk}; EpiProj E{(bf16_t*)(F.ws + WS_PROJ)};
    pg8::gemm_phase(F.lds, g, S, E);
}

DEVI void phase_conv(Frame& F) {
    const Params& P = *F.p;
    const bf16_t* PR = (const bf16_t*)(F.ws + WS_PROJ); bf16_t* MQ = (bf16_t*)(F.ws + WS_B);
    const int cg = F.tid & 127, run = F.tid >> 7, c0 = cg * 8;
    float w0[8], w1[8], w2[8], bb[8];
#pragma unroll
    for (int i = 0; i < 8; ++i) { w0[i] = P.in[I_CONVW][c0 + i]; w1[i] = P.in[I_CONVW][1024 + c0 + i]; w2[i] = P.in[I_CONVW][2048 + c0 + i]; bb[i] = P.in[I_CONVB][c0 + i]; }
    const float osc = cg >= 64 ? 0.08838834764831845f : 1.f;
    for (int it = F.blk; it < TT / 64; it += F.G) {
        const int r0 = it * 64 + run * 16;
        const bool isctx = r0 >= T;
        if (isctx && cg < 64) continue;
        const int slen = isctx ? CTXL : SEQ, pos0 = isctx ? ((r0 - T) & (CTXL - 1)) : (r0 & (SEQ - 1));
        u32x4 prev = (u32x4){0u, 0u, 0u, 0u}, cur, nxt;
        if (pos0 > 0) prev = *(const u32x4*)(PR + (size_t)(r0 - 1) * PN + 1536 + c0);
        cur = *(const u32x4*)(PR + (size_t)r0 * PN + 1536 + c0);
        for (int t = 0; t < 16; ++t) {
            const int r = r0 + t;
            nxt = (u32x4){0u, 0u, 0u, 0u};
            if (pos0 + t + 1 < slen) nxt = *(const u32x4*)(PR + (size_t)(r + 1) * PN + 1536 + c0);
            float o[8];
#pragma unroll
            for (int q = 0; q < 4; ++q) {
                const float a0 = lo_bf(prev[q]), a1 = hi_bf(prev[q]), b0 = lo_bf(cur[q]), b1 = hi_bf(cur[q]), d0 = lo_bf(nxt[q]), d1 = hi_bf(nxt[q]);
                o[2 * q] = siluf_(w0[2 * q] * a0 + w1[2 * q] * b0 + w2[2 * q] * d0 + bb[2 * q]) * osc;
                o[2 * q + 1] = siluf_(w0[2 * q + 1] * a1 + w1[2 * q + 1] * b1 + w2[2 * q + 1] * d1 + bb[2 * q + 1]) * osc;
            }
            u32x4 w; w.x = cvt_pk_bf16(o[0], o[1]); w.y = cvt_pk_bf16(o[2], o[3]); w.z = cvt_pk_bf16(o[4], o[5]); w.w = cvt_pk_bf16(o[6], o[7]);
            *(u32x4*)(MQ + (size_t)r * DM + c0) = w;
            prev = cur; cur = nxt;
        }
    }
}

constexpr int LDT = 136;
constexpr int TILE_B = 128 * LDT * 2;
DEVI bf16x8 frag_rows(const LAS bf16_t* base, int row, int k) { return *(const LAS bf16x8*)(base + row * LDT + k); }
DEVI bf16x8 frag_cols(const LAS bf16_t* base, int k, int col) { bf16x8 v;
#pragma unroll
    for (int j = 0; j < 8; ++j) v[j] = (short)base[(k + j) * LDT + col];
    return v; }
DEVI void stage_tile(LAS bf16_t* dst, const bf16_t* src, size_t ld, int tid) {
#pragma unroll
    for (int i = 0; i < 4; ++i) { const int p = tid + NTHREADS * i, r = p >> 4, c = (p & 15) * 8; *(LAS u32x4*)(dst + r * LDT + c) = *(const u32x4*)(src + (size_t)r * ld + c); }
}
DEVI void stage_tile_scaled2(LAS bf16_t* d0, LAS bf16_t* d1, const LAS float* s0, const LAS float* s1, const bf16_t* src, size_t ld, int tid) {
#pragma unroll
    for (int i = 0; i < 4; ++i) { const int p = tid + NTHREADS * i, r = p >> 4, c = (p & 15) * 8; const u32x4 v = *(const u32x4*)(src + (size_t)r * ld + c);
        const float a = s0[r], b = s1[r]; u32x4 o0, o1;
#pragma unroll
        for (int q = 0; q < 4; ++q) { const float lo = lo_bf(v[q]), hi = hi_bf(v[q]); o0[q] = cvt_pk_bf16(lo * a, hi * a); o1[q] = cvt_pk_bf16(lo * b, hi * b); }
        *(LAS u32x4*)(d0 + r * LDT + c) = o0; *(LAS u32x4*)(d1 + r * LDT + c) = o1; }
}
typedef short v4i16_t __attribute__((ext_vector_type(4)));
DEVI bf16x8 frag_tr(const LAS bf16_t* base, int k, int c16, int fr) {
    const LAS bf16_t* p = base + (k + (fr >> 2)) * LDT + c16 + 4 * (fr & 3);
    const v4i16_t lo = __builtin_amdgcn_ds_read_tr16_b64_v4i16((LAS v4i16_t*)p), hi = __builtin_amdgcn_ds_read_tr16_b64_v4i16((LAS v4i16_t*)(p + 4 * LDT));
    return (bf16x8){lo[0], lo[1], lo[2], lo[3], hi[0], hi[1], hi[2], hi[3]};
}
template <bool MAXOP> DEVI float wave_incl_scan(float v, int lane) {
#pragma unroll
    for (int o = 1; o < 64; o <<= 1) { const float u = __shfl_up(v, o); if (lane >= o) v = MAXOP ? fmaxf(v, u) : v + u; }
    return v;
}
DEVI void mlstm_gates2(LAS float* vec, const float* GT, int row0, int h, int tid, int lane, int wave, float m_f, float m_b, bool need_mu) {
    const bool act = tid < 256, bw = tid >= 128; const int tau = bw ? 255 - tid : tid;
    float gi = 0.f, bsum = 0.f, a = 0.f, pm = 0.f;
    if (act) { const float* g = GT + (size_t)(row0 + tau) * 16; const float lf = logsigmoidf_(g[(bw ? 12 : 4) + h]); gi = g[(bw ? 8 : 0) + h];
        bsum = wave_incl_scan<false>(lf, lane); if (lane == 63) vec[3400 + wave] = bsum; }
    __syncthreads();
    if (act) { if (wave & 1) bsum += vec[3400 + wave - 1]; a = gi - bsum; vec[(bw ? 896 : 768) + tau] = bsum; vec[(bw ? 640 : 512) + tau] = a;
        pm = wave_incl_scan<true>(a, lane); if (lane == 63) vec[3404 + wave] = pm; }
    __syncthreads();
    if (act) { if (wave & 1) pm = fmaxf(pm, vec[3404 + wave - 1]);
        if (need_mu) vec[(bw ? 1408 : 1280) + tau] = fmaxf(bw ? m_b : m_f, pm);
        if (tid == 127) { vec[3410] = bsum; vec[3411] = pm; } if (tid == 255) { vec[3412] = bsum; vec[3413] = pm; } }
    __syncthreads();
}
DEVI void mlstm_gates3(LAS float* vec, float fg, float ig, int tid, int lane, int wave, float m_f, float m_b) {
    const bool act = tid < 256, bw = tid >= 128; const int tau = bw ? 255 - tid : tid;
    float bsum = 0.f, a = 0.f, pm = 0.f;
    if (act) { bsum = wave_incl_scan<false>(logsigmoidf_(fg), lane); if (lane == 63) vec[3400 + wave] = bsum; }
    __syncthreads();
    if (act) { if (wave & 1) bsum += vec[3400 + wave - 1]; a = ig - bsum; vec[(bw ? 896 : 768) + tau] = bsum; vec[(bw ? 640 : 512) + tau] = a;
        pm = wave_incl_scan<true>(a, lane); if (lane == 63) vec[3404 + wave] = pm; }
    __syncthreads();
    if (act) { if (wave & 1) pm = fmaxf(pm, vec[3404 + wave - 1]); vec[(bw ? 1408 : 1280) + tau] = fmaxf(bw ? m_b : m_f, pm);
        if (tid == 127) { vec[3410] = bsum; vec[3411] = pm; } if (tid == 255) { vec[3412] = bsum; vec[3413] = pm; } }
    __syncthreads();
}
DEVI void mlstm_chunk_gates(LAS float* vec, const float* GT, int row0, int h, int tid) {
    if (tid < 128) { const float* g = GT + (size_t)(row0 + tid) * 16;
        vec[tid] = logsigmoidf_(g[4 + h]); vec[128 + tid] = logsigmoidf_(g[12 + h]); vec[256 + tid] = g[h]; vec[384 + tid] = g[8 + h]; }
    __syncthreads();
    if (tid < 128) { float s = 0.f; for (int j = 0; j <= tid; ++j) s += vec[j]; vec[768 + tid] = s; vec[512 + tid] = vec[256 + tid] - s; }
    else if (tid < 256) { const int t = tid - 128; float s = 0.f; for (int j = 127; j >= t; --j) s += vec[128 + j]; vec[896 + t] = s; vec[640 + t] = vec[384 + t] - s; }
    __syncthreads();
}
DEVI size_t us_index(int ty, int b, int h, int dir, int slot) { return ((((size_t)(ty * 8 + b) * 4 + h) * 2 + dir) * NSLOT + slot) * 16384; }
DEVI size_t sm_index(int b, int h, int dir, int slot) { return (((size_t)b * 4 + h) * 2 + dir) * NSLOT + slot; }

DEVI void conv_tile_regs(u32x4 (&out)[4], const LAS bf16_t* Tl, const LAS bf16_t* halo, const float* cw, const float* cb, float oscale, int tid) {
    const int cc = (tid & 15) * 8;
    float w0[8], w1[8], w2[8], bb[8];
#pragma unroll
    for (int q = 0; q < 2; ++q) { const f32x4 a = *(const f32x4*)(cw + cc + 4 * q), b = *(const f32x4*)(cw + 1024 + cc + 4 * q), c = *(const f32x4*)(cw + 2048 + cc + 4 * q), d = *(const f32x4*)(cb + cc + 4 * q);
#pragma unroll
        for (int j = 0; j < 4; ++j) { w0[4 * q + j] = a[j]; w1[4 * q + j] = b[j]; w2[4 * q + j] = c[j]; bb[4 * q + j] = d[j]; } }
#pragma unroll
    for (int i = 0; i < 4; ++i) { const int r = (tid + NTHREADS * i) >> 4;
        const u32x4 cur = *(const LAS u32x4*)(Tl + r * LDT + cc);
        const LAS bf16_t* pp = r > 0 ? Tl + (r - 1) * LDT + cc : halo + cc; const LAS bf16_t* pn = r < 127 ? Tl + (r + 1) * LDT + cc : halo + 128 + cc;
        const u32x4 prev = *(const LAS u32x4*)pp, nxt = *(const LAS u32x4*)pn;
        float o[8];
#pragma unroll
        for (int q = 0; q < 4; ++q) {
            o[2 * q] = siluf_(w0[2 * q] * lo_bf(prev[q]) + w1[2 * q] * lo_bf(cur[q]) + w2[2 * q] * lo_bf(nxt[q]) + bb[2 * q]) * oscale;
            o[2 * q + 1] = siluf_(w0[2 * q + 1] * hi_bf(prev[q]) + w1[2 * q + 1] * hi_bf(cur[q]) + w2[2 * q + 1] * hi_bf(nxt[q]) + bb[2 * q + 1]) * oscale; }
        out[i].x = cvt_pk_bf16(o[0], o[1]); out[i].y = cvt_pk_bf16(o[2], o[3]); out[i].z = cvt_pk_bf16(o[4], o[5]); out[i].w = cvt_pk_bf16(o[6], o[7]); }
}

DEVI void phase_chunk_u(Frame& F) {
    const Params& P = *F.p;
    LAS bf16_t* Vs = (LAS bf16_t*)F.lds; LAS bf16_t* Kf = (LAS bf16_t*)(F.lds + TILE_B); LAS bf16_t* Kb = (LAS bf16_t*)(F.lds + 2 * TILE_B);
    LAS float* vec = (LAS float*)(F.lds + 3 * TILE_B);
    const bf16_t* PR = (const bf16_t*)(F.ws + WS_PROJ); const float* GT = (const float*)(F.ws + WS_GATES);
    bf16_t* US = (bf16_t*)(F.ws + WS_US);
    const int wr0 = F.wave >> 1, wc0 = F.wave & 1, fr0 = F.lane & 15, fq0 = F.lane >> 4;
    constexpr int NIT4 = 2 * 8 * 4 * NSLOT;
    u32x4 kreg[4], vreg[4], kcur[4], vcur[4], phalo = (u32x4){0u, 0u, 0u, 0u}; float pfg = 0.f, pig = 0.f;
    LAS bf16_t* HL = (LAS bf16_t*)(vec + 2432);
#define P4_ISSUE(IT) do { const int slot_ = (IT) % NSLOT, h_ = ((IT) / NSLOT) & 3, b_ = ((IT) / (NSLOT * 4)) & 7, ty_ = (IT) / (NSLOT * 32); \
        const int row0_ = slot_ < NCC ? T + b_ * CTXL + slot_ * CH : b_ * SEQ + (slot_ - NCC) * CH; \
        const bf16_t* ks_ = PR + (size_t)row0_ * PN + (ty_ == 0 ? 512 : 2048) + h_ * 128; const size_t kl_ = PN; \
        if (ty_ == 1 && F.tid < 32) { const int wh_ = F.tid >> 4; const int sl_ = slot_ < NCC ? slot_ : slot_ - NCC, ns_ = slot_ < NCC ? NCC : NCH; \
            const bool ok_ = wh_ ? (sl_ + 1 < ns_) : (sl_ > 0); phalo = (u32x4){0u, 0u, 0u, 0u}; \
            if (ok_) phalo = *(const u32x4*)(ks_ + (long)(wh_ ? 128 : -1) * (long)PN + (F.tid & 15) * 8); } \
        const bf16_t* vs_ = PR + (size_t)row0_ * PN + (ty_ == 0 ? 1024 : 2560) + h_ * 128; \
        _Pragma("unroll") for (int i = 0; i < 4; ++i) { const int p = F.tid + NTHREADS * i, r = p >> 4, c = (p & 15) * 8; kreg[i] = *(const u32x4*)(ks_ + (size_t)r * kl_ + c); vreg[i] = *(const u32x4*)(vs_ + (size_t)r * PN + c); } \
        if (ty_ == 1 && F.tid < 256) { const int bw_ = F.tid >> 7, tau_ = bw_ ? 255 - F.tid : F.tid; const float* g_ = GT + (size_t)(row0_ + tau_) * 16; pfg = g_[(bw_ ? 12 : 4) + h_]; pig = g_[(bw_ ? 8 : 0) + h_]; } } while (0)
    if (F.blk < NIT4) P4_ISSUE(F.blk);
    for (int it = F.blk; it < NIT4; it += F.G) {
        const int slot = it % NSLOT, h = (it / NSLOT) & 3, b = (it / (NSLOT * 4)) & 7, ty = it / (NSLOT * 32);
        int fr = fr0, fq = fq0, wr = wr0, wc = wc0;
        asm volatile("" : "+v"(fr), "+v"(fq), "+s"(wr), "+s"(wc));
        __syncthreads();
#pragma unroll
        for (int i = 0; i < 4; ++i) { kcur[i] = kreg[i]; vcur[i] = vreg[i]; }
        const float cfg = pfg, cig = pig; const u32x4 chalo = phalo;
        if (it + F.G < NIT4) P4_ISSUE(it + F.G);
        if (ty == 1) {
#pragma unroll
            for (int i = 0; i < 4; ++i) { const int p = F.tid + NTHREADS * i, r = p >> 4, c = (p & 15) * 8; *(LAS u32x4*)(Kf + r * LDT + c) = kcur[i]; }
            if (F.tid < 32) *(LAS u32x4*)(HL + (F.tid >> 4) * 128 + (F.tid & 15) * 8) = chalo;
            __syncthreads();
            conv_tile_regs(kcur, Kf, HL, P.in[I_CONVW] + 512 + h * 128, P.in[I_CONVB] + 512 + h * 128, 0.08838834764831845f, F.tid);
        }
        if (ty == 0) {
            const float lf = -expf(P.in[I_RDEC][h]) * 1.4426950408889634f, lb = -expf(P.in[I_RDEC][4 + h]) * 1.4426950408889634f;
            if (F.tid < 128) { vec[1024 + F.tid] = exp2f((float)(127 - F.tid) * lf); vec[1152 + F.tid] = exp2f((float)F.tid * lb); }
        } else {
            mlstm_gates3(vec, cfg, cig, F.tid, F.lane, F.wave, 0.f, 0.f);
            const float mf = vec[3411], mb = vec[3413];
            if (F.tid < 128) { vec[1024 + F.tid] = __expf(vec[512 + F.tid] - mf); vec[1152 + F.tid] = __expf(vec[640 + F.tid] - mb); }
            if (F.tid == 0) { float* chs = (float*)(F.ws + WS_CHS);
                chs[sm_index(b, h, 0, slot) * 2 + 0] = vec[3410]; chs[sm_index(b, h, 0, slot) * 2 + 1] = mf;
                chs[sm_index(b, h, 1, slot) * 2 + 0] = vec[3412]; chs[sm_index(b, h, 1, slot) * 2 + 1] = mb; }
        }
        __syncthreads();
#pragma unroll
        for (int i = 0; i < 4; ++i) { const int p = F.tid + NTHREADS * i, r = p >> 4, c = (p & 15) * 8;
            *(LAS u32x4*)(Vs + r * LDT + c) = vcur[i];
            const float wa = vec[1024 + r], wb = vec[1152 + r]; u32x4 o0, o1;
#pragma unroll
            for (int q = 0; q < 4; ++q) { const float lo = lo_bf(kcur[i][q]), hi = hi_bf(kcur[i][q]); o0[q] = cvt_pk_bf16(lo * wa, hi * wa); o1[q] = cvt_pk_bf16(lo * wb, hi * wb); }
            *(LAS u32x4*)(Kf + r * LDT + c) = o0; *(LAS u32x4*)(Kb + r * LDT + c) = o1; }
        __syncthreads();
        f32x4 af[2][4], ab[2][4];
#pragma unroll
        for (int m = 0; m < 2; ++m)
#pragma unroll
            for (int n = 0; n < 4; ++n) { af[m][n] = (f32x4){0.f, 0.f, 0.f, 0.f}; ab[m][n] = (f32x4){0.f, 0.f, 0.f, 0.f}; }
#pragma unroll 1
        for (int ks = 0; ks < 4; ++ks) {
            bf16x8 kf2[2], kb2[2];
#pragma unroll
            for (int m = 0; m < 2; ++m) { kf2[m] = frag_tr(Kf, ks * 32 + 8 * fq, 32 * wr + 16 * m, fr); kb2[m] = frag_tr(Kb, ks * 32 + 8 * fq, 32 * wr + 16 * m, fr); }
#pragma unroll
            for (int n = 0; n < 4; ++n) { const bf16x8 bv = frag_tr(Vs, ks * 32 + 8 * fq, 64 * wc + 16 * n, fr);
#pragma unroll
                for (int m = 0; m < 2; ++m) { af[m][n] = __builtin_amdgcn_mfma_f32_16x16x32_bf16(kf2[m], bv, af[m][n], 0, 0, 0); ab[m][n] = __builtin_amdgcn_mfma_f32_16x16x32_bf16(kb2[m], bv, ab[m][n], 0, 0, 0); } }
        }
        if (ty == 1 && F.tid < 256) {
            const int dir = F.tid >> 7, d = F.tid & 127; const LAS bf16_t* kk = dir ? Kb : Kf; float s = 0.f;
#pragma unroll 8
            for (int t = 0; t < 128; ++t) s += bf2f(kk[t * LDT + d]);
            ((float*)(F.ws + WS_UN))[sm_index(b, h, dir, slot) * 128 + d] = s;
        }
        __syncthreads();
#pragma unroll
        for (int m = 0; m < 2; ++m)
#pragma unroll
            for (int n = 0; n < 4; ++n) { const int e = 64 * wc + 16 * n + fr, d0 = 32 * wr + 16 * m + 4 * fq;
                u32x2 o; o.x = cvt_pk_bf16(af[m][n][0], af[m][n][1]); o.y = cvt_pk_bf16(af[m][n][2], af[m][n][3]); *(LAS u32x2*)(Kf + e * LDT + d0) = o;
                o.x = cvt_pk_bf16(ab[m][n][0], ab[m][n][1]); o.y = cvt_pk_bf16(ab[m][n][2], ab[m][n][3]); *(LAS u32x2*)(Kb + e * LDT + d0) = o; }
        __syncthreads();
        bf16_t* uf = US + us_index(ty, b, h, 0, slot); bf16_t* ub = US + us_index(ty, b, h, 1, slot);
#pragma unroll
        for (int i = 0; i < 4; ++i) { const int p = F.tid + NTHREADS * i, r = p >> 4, c = (p & 15) * 8;
            *(u32x4*)(uf + r * 128 + c) = *(const LAS u32x4*)(Kf + r * LDT + c); *(u32x4*)(ub + r * 128 + c) = *(const LAS u32x4*)(Kb + r * LDT + c); }
    }
#undef P4_ISSUE
}

DEVI int scan_slot(int dir, int s) { return dir == 0 ? s : (s < NCC ? (NCC - 1 - s) : (NSLOT - 1 - (s - NCC))); }
DEVI void phase_scan_states(Frame& F) {
    const Params& P = *F.p;
    bf16_t* US = (bf16_t*)(F.ws + WS_US);
    for (int it = F.blk; it < 256; it += F.G) {
        const int half = it & 1, chain = it >> 1, dir = chain & 1, h = (chain >> 1) & 3, b = (chain >> 3) & 7, ty = chain >> 6;
        bf16_t* base = US + us_index(ty, b, h, dir, 0) + half * 8192 + F.tid * 16;
        float st[16];
#pragma unroll
        for (int i = 0; i < 16; ++i) st[i] = 0.f;
        float m = 0.f, nst = 0.f;
        const float gdec = ty == 0 ? expf(-expf(P.in[I_RDEC][dir * 4 + h]) * 128.f) : 0.f;
        const float* chs = (const float*)(F.ws + WS_CHS) + sm_index(b, h, dir, 0) * 2;
        float* smv = (float*)(F.ws + WS_SM) + sm_index(b, h, dir, 0);
        float* un = (float*)(F.ws + WS_UN) + sm_index(b, h, dir, 0) * 128;
        const bool do_n = (ty == 1) && half == 0 && F.tid < 128;
        u32x4 q0[6], q1[6];
#pragma unroll
        for (int j = 0; j < 6; ++j) { const bf16_t* p = base + (size_t)scan_slot(dir, j) * 16384; q0[j] = *(const u32x4*)p; q1[j] = *(const u32x4*)(p + 8); }
        for (int s3 = 0; s3 < NSLOT; s3 += 6) {
#pragma unroll
            for (int j = 0; j < 6; ++j) {
                const int s = s3 + j; const int slot = scan_slot(dir, s);
                bf16_t* p = base + (size_t)slot * 16384;
                const u32x4 u0 = q0[j], u1 = q1[j];
                if (s + 6 < NSLOT) { const bf16_t* pn = base + (size_t)scan_slot(dir, s + 6) * 16384; q0[j] = *(const u32x4*)pn; q1[j] = *(const u32x4*)(pn + 8); }
                float dec = gdec, du = 1.f;
                if (ty == 1) { const float btot = chs[slot * 2], amax = chs[slot * 2 + 1]; const float mloc = btot + amax, mn = fmaxf(btot + m, mloc);
                    dec = __expf(btot + m - mn); du = __expf(mloc - mn);
                    if (half == 0 && F.tid == 0 && slot >= NCC) smv[slot] = m;
                    m = mn; }
                if (slot >= NCC) { u32x4 o0, o1;
#pragma unroll
                    for (int q = 0; q < 4; ++q) { o0[q] = cvt_pk_bf16(st[2 * q], st[2 * q + 1]); o1[q] = cvt_pk_bf16(st[8 + 2 * q], st[8 + 2 * q + 1]); }
                    *(u32x4*)p = o0; *(u32x4*)(p + 8) = o1; }
#pragma unroll
                for (int q = 0; q < 4; ++q) { st[2 * q] = dec * st[2 * q] + du * lo_bf(u0[q]); st[2 * q + 1] = dec * st[2 * q + 1] + du * hi_bf(u0[q]);
                    st[8 + 2 * q] = dec * st[8 + 2 * q] + du * lo_bf(u1[q]); st[8 + 2 * q + 1] = dec * st[8 + 2 * q + 1] + du * hi_bf(u1[q]); }
                if (do_n) { const float uv = un[slot * 128 + F.tid]; if (slot >= NCC) un[slot * 128 + F.tid] = nst; nst = dec * nst + du * uv; }
            }
        }
    }
}

DEVI void phase_chunk_out(Frame& F) {
    const Params& P = *F.p;
    LAS bf16_t* Qs = (LAS bf16_t*)F.lds; LAS bf16_t* R1 = (LAS bf16_t*)(F.lds + TILE_B); LAS bf16_t* Vs = (LAS bf16_t*)(F.lds + 2 * TILE_B); LAS bf16_t* R3 = (LAS bf16_t*)(F.lds + 3 * TILE_B);
    LAS float* Ot = (LAS float*)F.lds; constexpr int LDO = 132;
    LAS float* vec = (LAS float*)(F.lds + 4 * TILE_B);
    bf16_t* PR = (bf16_t*)(F.ws + WS_PROJ); const float* GT = (const float*)(F.ws + WS_GATES);
    const bf16_t* US = (const bf16_t*)(F.ws + WS_US);
    const int wr0 = F.wave >> 1, wc0 = F.wave & 1, fr0 = F.lane & 15, fq0 = F.lane >> 4, w0 = F.wave;
    u32x4 qreg[4], kreg[4], vreg[4], phalo = (u32x4){0u, 0u, 0u, 0u}; float pfg = 0.f, pig = 0.f, pnv = 0.f, pmf = 0.f, pmb = 0.f;
    LAS bf16_t* HL = (LAS bf16_t*)(vec + 2432);
#define P6_ISSUE(JJ) do { const int rt_ = F.blk + ((JJ) >> 4) * F.G, kk_ = (JJ) & 15; const int c_ = 2 * (rt_ & 31) + (kk_ & 1), h_ = (kk_ >> 1) & 3, b_ = rt_ >> 5, ty_ = kk_ >> 3; const int row0_ = b_ * SEQ + c_ * CH, slot_ = NCC + c_; \
        const bf16_t* qs_ = PR + (size_t)row0_ * PN + (ty_ == 0 ? 0 : 1536) + h_ * 128; const size_t ql_ = PN; \
        if (ty_ == 1 && tidv < 64) { const int tl_ = tidv >> 5, wh_ = (tidv >> 4) & 1; const bool ok_ = wh_ ? (c_ + 1 < NCH) : (c_ > 0); phalo = (u32x4){0u, 0u, 0u, 0u}; \
            if (ok_) phalo = *(const u32x4*)(qs_ + tl_ * 512 + (long)(wh_ ? 128 : -1) * (long)PN + (tidv & 15) * 8); } \
        const bf16_t* vs_ = PR + (size_t)row0_ * PN + (ty_ == 0 ? 1024 : 2560) + h_ * 128; \
        _Pragma("unroll") for (int i = 0; i < 4; ++i) { const int p = tidv + NTHREADS * i, r = p >> 4, cc = (p & 15) * 8; \
            qreg[i] = *(const u32x4*)(qs_ + (size_t)r * ql_ + cc); kreg[i] = *(const u32x4*)(qs_ + 512 + (size_t)r * ql_ + cc); vreg[i] = *(const u32x4*)(vs_ + (size_t)r * PN + cc); } \
        if (ty_ == 1) { pmf = ((const float*)(F.ws + WS_SM))[sm_index(b_, h_, 0, slot_)]; pmb = ((const float*)(F.ws + WS_SM))[sm_index(b_, h_, 1, slot_)]; \
            if (tidv < 256) { const int bw_ = tidv >> 7, tau_ = bw_ ? 255 - tidv : tidv; const float* g_ = GT + (size_t)(row0_ + tau_) * 16; \
                pfg = g_[(bw_ ? 12 : 4) + h_]; pig = g_[(bw_ ? 8 : 0) + h_]; pnv = ((const float*)(F.ws + WS_UN))[sm_index(b_, h_, bw_, slot_) * 128 + (tidv & 127)]; } } } while (0)
    int tidv = F.tid;
    const int njj = F.blk < T / 256 ? 16 * ((T / 256 - 1 - F.blk) / F.G + 1) : 0;
    if (njj > 0) P6_ISSUE(0);
    for (int jj = 0; jj < njj; ++jj) {
        const int rt = F.blk + (jj >> 4) * F.G, kk = jj & 15;
        const int c = 2 * (rt & 31) + (kk & 1), h = (kk >> 1) & 3, b = rt >> 5, ty = kk >> 3;
        const int row0 = b * SEQ + c * CH, slot = NCC + c;
        int fr = fr0, fq = fq0, wr = wr0, wc = wc0, wv = w0;
        tidv = F.tid;
        asm volatile("" : "+v"(fr), "+v"(fq), "+v"(tidv), "+s"(wr), "+s"(wc), "+s"(wv));
        __syncthreads();
#pragma unroll
        for (int i = 0; i < 4; ++i) { const int p = tidv + NTHREADS * i, r = p >> 4, cc = (p & 15) * 8;
            *(LAS u32x4*)(Qs + r * LDT + cc) = qreg[i]; *(LAS u32x4*)(R1 + r * LDT + cc) = kreg[i]; *(LAS u32x4*)(Vs + r * LDT + cc) = vreg[i]; }
        const float m_f = pmf, m_b = pmb;
        if (ty == 1) {
            if (tidv < 64) *(LAS u32x4*)(HL + (tidv >> 4) * 128 + (tidv & 15) * 8) = phalo;
            __syncthreads();
            u32x4 cq[4], ck[4];
            conv_tile_regs(cq, Qs, HL, P.in[I_CONVW] + h * 128, P.in[I_CONVB] + h * 128, 1.f, tidv);
            conv_tile_regs(ck, R1, HL + 256, P.in[I_CONVW] + 512 + h * 128, P.in[I_CONVB] + 512 + h * 128, 0.08838834764831845f, tidv);
            __syncthreads();
#pragma unroll
            for (int i = 0; i < 4; ++i) { const int p = tidv + NTHREADS * i, r = p >> 4, cc = (p & 15) * 8; *(LAS u32x4*)(Qs + r * LDT + cc) = cq[i]; *(LAS u32x4*)(R1 + r * LDT + cc) = ck[i]; }
        }
        const bf16_t* sfp = US + us_index(ty, b, h, 0, slot); const bf16_t* sbp = US + us_index(ty, b, h, 1, slot);
        u32x4 s0[4], s1[4];
#pragma unroll
        for (int i = 0; i < 4; ++i) { const int p = tidv + NTHREADS * i, r = p >> 4, cc = (p & 15) * 8; s0[i] = *(const u32x4*)(sfp + r * 128 + cc); s1[i] = *(const u32x4*)(sbp + r * 128 + cc); }
        float lgf = 0.f, lgb = 0.f;
        if (ty == 0) {
            lgf = -expf(P.in[I_RDEC][h]) * 1.4426950408889634f; lgb = -expf(P.in[I_RDEC][4 + h]) * 1.4426950408889634f;
            if (tidv < 128) { vec[1024 + tidv] = __builtin_amdgcn_exp2f((float)(tidv + 1) * lgf); vec[1152 + tidv] = __builtin_amdgcn_exp2f((float)(128 - tidv) * lgb); }
            __syncthreads();
        } else {
            if (tidv < 256) vec[1792 + tidv] = pnv;
            mlstm_gates3(vec, pfg, pig, tidv, F.lane, F.wave, m_f, m_b);
            {
                const int t = tidv >> 2, qq = tidv & 3; float sf = 0.f, sb = 0.f;
#pragma unroll 4
                for (int d = qq * 32; d < qq * 32 + 32; d += 2) { const unsigned qv = *(const LAS unsigned*)(Qs + t * LDT + d); const float q0 = lo_bf(qv), q1 = hi_bf(qv);
                    sf += q0 * vec[1792 + d] + q1 * vec[1792 + d + 1]; sb += q0 * vec[1920 + d] + q1 * vec[1920 + d + 1]; }
                sf = quad_sum(sf); sb = quad_sum(sb);
                if (qq == 0) { vec[2048 + t] = sf; vec[2176 + t] = sb; }
            }
        }
        f32x4 g[8];
#pragma unroll
        for (int m = 0; m < 8; ++m) g[m] = (f32x4){0.f, 0.f, 0.f, 0.f};
#pragma unroll 1
        for (int ks = 0; ks < 4; ++ks) {
            const bf16x8 bq = frag_rows(Qs, 16 * wv + fr, ks * 32 + 8 * fq);
#pragma unroll
            for (int m = 0; m < 8; ++m) { const bf16x8 ak = frag_rows(R1, 16 * m + fr, ks * 32 + 8 * fq); g[m] = __builtin_amdgcn_mfma_f32_16x16x32_bf16(ak, bq, g[m], 0, 0, 0); }
        }
        __syncthreads();
        {
            const int t = 16 * wv + fr;
            if (ty == 0) {
#pragma unroll
                for (int m = 0; m < 8; ++m) { float pv[4];
                    if (m < wv) {
#pragma unroll
                        for (int r = 0; r < 4; ++r) pv[r] = g[m][r] * __builtin_amdgcn_exp2f((float)(t - (16 * m + 4 * fq + r)) * lgf);
                    } else if (m > wv) {
#pragma unroll
                        for (int r = 0; r < 4; ++r) pv[r] = g[m][r] * __builtin_amdgcn_exp2f((float)((16 * m + 4 * fq + r) - t) * lgb);
                    } else {
#pragma unroll
                        for (int r = 0; r < 4; ++r) { const int dl = t - (16 * m + 4 * fq + r);
                            const float w = dl > 0 ? __builtin_amdgcn_exp2f((float)dl * lgf) : (dl < 0 ? __builtin_amdgcn_exp2f((float)(-dl) * lgb) : 2.f); pv[r] = g[m][r] * w; }
                    }
                    u32x2 o; o.x = cvt_pk_bf16(pv[0], pv[1]); o.y = cvt_pk_bf16(pv[2], pv[3]); *(LAS u32x2*)(R1 + t * LDT + 16 * m + 4 * fq) = o; }
            } else {
                const float muf = vec[1280 + t], mub = vec[1408 + t]; float rsf = 0.f, rsb = 0.f;
                f32x4 sb4[8];
#pragma unroll
                for (int m = 0; m < 8; ++m) {
                    if (m < wv) {
                        const f32x4 av = *(const LAS f32x4*)(vec + 512 + 16 * m + 4 * fq);
#pragma unroll
                        for (int r = 0; r < 4; ++r) { const float sf = g[m][r] * __expf(av[r] - muf); g[m][r] = sf; rsf += sf; }
                        sb4[m] = (f32x4){0.f, 0.f, 0.f, 0.f};
                    } else if (m > wv) {
                        const f32x4 bv = *(const LAS f32x4*)(vec + 640 + 16 * m + 4 * fq);
#pragma unroll
                        for (int r = 0; r < 4; ++r) { const float sb = g[m][r] * __expf(bv[r] - mub); sb4[m][r] = sb; rsb += sb; }
                        g[m] = (f32x4){0.f, 0.f, 0.f, 0.f};
                    } else {
                        const f32x4 av = *(const LAS f32x4*)(vec + 512 + 16 * m + 4 * fq), bv = *(const LAS f32x4*)(vec + 640 + 16 * m + 4 * fq);
#pragma unroll
                        for (int r = 0; r < 4; ++r) { const int tp = 16 * m + 4 * fq + r; const float gv = g[m][r];
                            const float sf = tp <= t ? gv * __expf(av[r] - muf) : 0.f, sb = tp >= t ? gv * __expf(bv[r] - mub) : 0.f;
                            g[m][r] = sf; sb4[m][r] = sb; rsf += sf; rsb += sb; }
                    } }
                rsf += __shfl_xor(rsf, 16); rsf += __shfl_xor(rsf, 32); rsb += __shfl_xor(rsb, 16); rsb += __shfl_xor(rsb, 32);
                const float interf = __expf(m_f - muf), interb = __expf(m_b - mub);
                const float denf = rsf + interf * vec[2048 + t], denb = rsb + interb * vec[2176 + t];
                const float rDf = __builtin_amdgcn_rcpf(fmaxf(fabsf(denf), __expf(-(vec[768 + t] + muf)))), rDb = __builtin_amdgcn_rcpf(fmaxf(fabsf(denb), __expf(-(vec[896 + t] + mub))));
                if (fq == 0) { vec[1024 + t] = interf * rDf; vec[1152 + t] = interb * rDb; }
#pragma unroll
                for (int m = 0; m < 8; ++m) { const f32x4 pv = g[m] * rDf + sb4[m] * rDb;
                    u32x2 o; o.x = cvt_pk_bf16(pv[0], pv[1]); o.y = cvt_pk_bf16(pv[2], pv[3]); *(LAS u32x2*)(R1 + t * LDT + 16 * m + 4 * fq) = o; }
            }
        }
        f32x4 o1[2][4];
        {
            f32x4 o2[2][4], o3[2][4];
#pragma unroll
            for (int m = 0; m < 2; ++m)
#pragma unroll
                for (int n = 0; n < 4; ++n) { o2[m][n] = (f32x4){0.f, 0.f, 0.f, 0.f}; o3[m][n] = (f32x4){0.f, 0.f, 0.f, 0.f}; }
#define P6_QS(ACC) do { _Pragma("unroll 1") for (int ks = 0; ks < 4; ++ks) { bf16x8 aq[2]; \
                _Pragma("unroll") for (int m = 0; m < 2; ++m) aq[m] = frag_rows(Qs, 32 * wr + 16 * m + fr, ks * 32 + 8 * fq); \
                _Pragma("unroll") for (int n = 0; n < 4; ++n) { const bf16x8 bs = frag_rows(R3, 64 * wc + 16 * n + fr, ks * 32 + 8 * fq); \
                    _Pragma("unroll") for (int m = 0; m < 2; ++m) ACC[m][n] = __builtin_amdgcn_mfma_f32_16x16x32_bf16(aq[m], bs, ACC[m][n], 0, 0, 0); } } } while (0)
#pragma unroll
            for (int i = 0; i < 4; ++i) { const int p = tidv + NTHREADS * i, r = p >> 4, cc = (p & 15) * 8; *(LAS u32x4*)(R3 + r * LDT + cc) = s0[i]; }
            __syncthreads();
            P6_QS(o2);
            __syncthreads();
#pragma unroll
            for (int i = 0; i < 4; ++i) { const int p = tidv + NTHREADS * i, r = p >> 4, cc = (p & 15) * 8; *(LAS u32x4*)(R3 + r * LDT + cc) = s1[i]; }
            __syncthreads();
            P6_QS(o3);
#pragma unroll
            for (int m = 0; m < 2; ++m)
#pragma unroll
                for (int r = 0; r < 4; ++r) { const int t = 32 * wr + 16 * m + 4 * fq + r; const float cf = vec[1024 + t], cb = vec[1152 + t];
#pragma unroll
                    for (int n = 0; n < 4; ++n) o1[m][n][r] = cf * o2[m][n][r] + cb * o3[m][n][r]; }
        }
        const float* gain = (ty == 0 ? P.in[I_RNG] : P.in[I_MNG]) + h * 128;
        bf16_t* obase = PR + (size_t)row0 * PN + 3072 + ty * 512 + h * 128;
        u32x4 gt[4];
#pragma unroll
        for (int i = 0; i < 4; ++i) { const int p = tidv + NTHREADS * i, r = p >> 4, cc = (p & 15) * 8; gt[i] = *(const u32x4*)(obase + (size_t)r * PN + cc); }
        if (jj + 1 < njj) P6_ISSUE(jj + 1);
#pragma unroll 1
        for (int ks = 0; ks < 4; ++ks) {
            bf16x8 ap[2];
#pragma unroll
            for (int m = 0; m < 2; ++m) ap[m] = frag_rows(R1, 32 * wr + 16 * m + fr, ks * 32 + 8 * fq);
#pragma unroll
            for (int n = 0; n < 4; ++n) { const bf16x8 bv = frag_tr(Vs, ks * 32 + 8 * fq, 64 * wc + 16 * n, fr);
#pragma unroll
                for (int m = 0; m < 2; ++m) o1[m][n] = __builtin_amdgcn_mfma_f32_16x16x32_bf16(ap[m], bv, o1[m][n], 0, 0, 0); }
        }
        __syncthreads();
#pragma unroll
        for (int m = 0; m < 2; ++m)
#pragma unroll
            for (int n = 0; n < 4; ++n)
#pragma unroll
                for (int r = 0; r < 4; ++r) Ot[(32 * wr + 16 * m + 4 * fq + r) * LDO + 64 * wc + 16 * n + fr] = o1[m][n][r];
        __syncthreads();
#pragma unroll
        for (int i = 0; i < 4; ++i) { const int p = tidv + NTHREADS * i, r = p >> 4, cc = (p & 15) * 8;
            const f32x4 a0 = *(const LAS f32x4*)(Ot + r * LDO + cc), a1 = *(const LAS f32x4*)(Ot + r * LDO + cc + 4);
            float sm = (a0.x + a0.y) + (a0.z + a0.w) + (a1.x + a1.y) + (a1.z + a1.w);
            float sq = (a0.x * a0.x + a0.y * a0.y) + (a0.z * a0.z + a0.w * a0.w) + (a1.x * a1.x + a1.y * a1.y) + (a1.z * a1.z + a1.w * a1.w);
            sm = row16_sum(sm); sq = row16_sum(sq);
            const float mean = sm * (1.f / 128.f), rstd = __builtin_amdgcn_rsqf(fmaxf(sq * (1.f / 128.f) - mean * mean, 0.f) + EPS);
            const f32x4 g0 = *(const f32x4*)(gain + cc), g1 = *(const f32x4*)(gain + cc + 4);
            float y[8]; const float av[8] = {a0.x, a0.y, a0.z, a0.w, a1.x, a1.y, a1.z, a1.w}; const float gn[8] = {g0.x, g0.y, g0.z, g0.w, g1.x, g1.y, g1.z, g1.w};
#pragma unroll
            for (int q = 0; q < 4; ++q) { const float t0 = lo_bf(gt[i][q]), t1 = hi_bf(gt[i][q]);
                const float c0 = ty == 0 ? siluf_(t0) : sigmoidf_(t0), c1 = ty == 0 ? siluf_(t1) : sigmoidf_(t1);
                y[2 * q] = (av[2 * q] - mean) * rstd * gn[2 * q] * c0; y[2 * q + 1] = (av[2 * q + 1] - mean) * rstd * gn[2 * q + 1] * c1; }
            u32x4 o; o.x = cvt_pk_bf16(y[0], y[1]); o.y = cvt_pk_bf16(y[2], y[3]); o.z = cvt_pk_bf16(y[4], y[5]); o.w = cvt_pk_bf16(y[6], y[7]);
            *(u32x4*)(obase + (size_t)r * PN + cc) = o; }
    }
#undef P6_ISSUE
#undef P6_QS
}

struct SchedY { int G, c;
    DEVI bool next(int i, pg8::Unit& u) const { return pg8::static_unit(256, 4, (long)i * G + c, u); }
    DEVI int arow(const pg8::Unit& u, int r) const { return u.pm * 256 + r; }
    static constexpr bool IDX_DMA = false; };
struct EpiBf16 { bf16_t* O; int ldc;
    static constexpr bool PRE = false;
    DEVI void operator()(const f32x4 (&acc)[2][2][4][2], const pg8::Unit& u, int wr, int wc, int fr, int fq) const {
        const int row0 = u.pm * 256 + wr * 64 + fr, col0 = u.pn * 256 + wc * 32 + 8 * fq;
#pragma unroll
        for (int ai = 0; ai < 2; ++ai)
#pragma unroll
            for (int m = 0; m < 4; ++m) { bf16_t* rowp = O + (size_t)(row0 + ai * 128 + m * 16) * ldc + col0;
#pragma unroll
                for (int bj = 0; bj < 2; ++bj) { const f32x4 v0 = acc[ai][bj][m][0], v1 = acc[ai][bj][m][1];
                    u32x4 w; w.x = cvt_pk_bf16(v0[0], v0[1]); w.y = cvt_pk_bf16(v0[2], v0[3]); w.z = cvt_pk_bf16(v1[0], v1[1]); w.w = cvt_pk_bf16(v1[2], v1[3]);
                    *(u32x4*)(rowp + bj * 128) = w; } }
    } };
DEVI void expert_weight_copies(Frame& F) {
    const Params& P = *F.p;
    __syncthreads();
    LAS float* scr = (LAS float*)(F.lds + F.wave * 8704);
    const int gw = F.blk * NWAVES + F.wave, NGW = F.G * NWAVES;
    constexpr int IGU = 16 * 16, IDN = 4 * 32;
    for (int it = gw; it < 65 * (IGU + IDN); it += NGW) {
        const int e = it / (IGU + IDN), r = it % (IGU + IDN);
        if (r < IGU) { const int kb = r >> 4, nb = r & 15;
            const float* wg = e < 64 ? P.in[I_WG] + (size_t)e * DM * EFF : P.in[I_SG]; const float* wu = e < 64 ? P.in[I_WU] + (size_t)e * DM * EFF : P.in[I_SU];
            transpose_item8(SrcGU{wg, (long)(wu - wg)}, (unsigned char*)(F.ws + WS_WGU) + (size_t)e * 512 * DM, DM, kb * 64, nb * 32, scr, F.lane, W_SCALE_GU); }
        else { const int q = r - IGU, kb = q >> 5, nb = q & 31;
            const float* wd = e < 64 ? P.in[I_WDN] + (size_t)e * EFF * DM : P.in[I_SD];
            transpose_item8(SrcPlain{wd, DM}, (unsigned char*)(F.ws + WS_WD) + (size_t)e * DM * EFF, EFF, kb * 64, nb * 32, scr, F.lane, W_SCALE_DN); }
    }
}
struct SchedRowTiles { int G, c;
    DEVI bool next(int i, pg8::Unit& u) const { const int rt = c + (i >> 2) * G; if (rt >= T / 256) return false; u.pm = rt; u.pn = i & 3; u.aux = 0; return true; }
    DEVI int arow(const pg8::Unit& u, int r) const { return u.pm * 256 + r; }
    static constexpr bool IDX_DMA = false; };
DEVI void wg_global_handoff(Frame& F) {
    asm volatile("s_waitcnt vmcnt(0)" ::: "memory");
    __syncthreads();
    if (F.tid == 0) { __builtin_amdgcn_fence(__ATOMIC_ACQUIRE, "agent"); asm volatile("s_waitcnt vmcnt(0)" ::: "memory"); }
    __syncthreads();
}
DEVI void phase_gemm_y(Frame& F) {
    pg8::Gemm g{(const bf16_t*)(F.ws + WS_PROJ) + 3072, (const bf16_t*)(F.ws + WS_WOUTT), PN, DM};
    SchedRowTiles S{F.G, F.blk}; EpiBf16 E{(bf16_t*)(F.ws + WS_PROJ), PN};
    pg8::gemm_phase(F.lds, g, S, E);
}

struct SchedOne { int pm; DEVI bool next(int i, pg8::Unit& u) const { if (i) return false; u.pm = pm; u.pn = 0; u.aux = 0; return true; }
    DEVI int arow(const pg8::Unit& u, int r) const { return u.pm * 256 + r; }
    static constexpr bool IDX_DMA = false; };
constexpr int LGP = 258;
struct EpiRouter { LAS float* L;
    static constexpr bool PRE = false;
    DEVI void operator()(const f32x4 (&acc)[2][2][4][2], const pg8::Unit&, int wr, int wc, int fr, int fq) const {
        if (wc < 2) {
#pragma unroll
            for (int ai = 0; ai < 2; ++ai)
#pragma unroll
                for (int m = 0; m < 4; ++m) { const int row = ai * 128 + wr * 64 + m * 16 + fr, ex = wc * 32 + 8 * fq;
                    const f32x4 v0 = acc[ai][0][m][0] + acc[ai][1][m][0], v1 = acc[ai][0][m][1] + acc[ai][1][m][1];
#pragma unroll
                    for (int i = 0; i < 4; ++i) { L[(ex + i) * LGP + row] = v0[i]; L[(ex + 4 + i) * LGP + row] = v1[i]; } }
        }
    } };
DEVI void phase_norm2(Frame& F) {
    const Params& P = *F.p;
    LAS float* LG = (LAS float*)F.lds;
    LAS float* MODS = (LAS float*)(F.lds + 131072);
    LAS int* hist = (LAS int*)(F.lds + 131072 + 12288);
    const float* ng = P.in[I_NORMG];
    const bf16_t* Y = (const bf16_t*)(F.ws + WS_PROJ); bf16_t* H2 = (bf16_t*)(F.ws + WS_PROJ) + 3072;
    int* EIDX = (int*)(F.ws + WS_EIDX); float* WTS = (float*)(F.ws + WS_WTS);
#pragma unroll 1
    for (int rb = F.blk; rb < T / 256; rb += F.G) {
        const int b = rb >> 5;
        __syncthreads();
        for (int i = F.tid; i < 3 * 1024; i += NTHREADS) { const int v = i >> 10, n = i & 1023; const float m = mod_value(F, b, (2 + v) * 1024 + n); MODS[i] = v == 2 ? 1.f + m : m; }
        __syncthreads();
        {
            int lane = F.lane; asm volatile("" : "+v"(lane));
            f32x4 g1v[4], g2v[4];
#pragma unroll
            for (int j = 0; j < 4; ++j) { g1v[j] = *(const f32x4*)(ng + 1024 + 256 * j + 4 * lane); g2v[j] = *(const f32x4*)(ng + 2048 + 256 * j + 4 * lane); }
            u32x2 yn[4]; f32x4 xn[4];
            { const int row = rb * 256 + F.wave;
#pragma unroll
              for (int j = 0; j < 4; ++j) { yn[j] = *(const u32x2*)(Y + (size_t)row * PN + 256 * j + 4 * lane); xn[j] = *(const f32x4*)(P.in[I_X] + (size_t)row * DM + 256 * j + 4 * lane); } }
            for (int i = 0; i < 32; ++i) {
                const int row = rb * 256 + F.wave + 8 * i;
                f32x4 y[4], x[4]; float ss = 0.f;
#pragma unroll
                for (int j = 0; j < 4; ++j) { const u32x2 yy = yn[j]; y[j] = (f32x4){lo_bf(yy.x), hi_bf(yy.x), lo_bf(yy.y), hi_bf(yy.y)};
                    x[j] = xn[j]; ss += y[j].x * y[j].x + y[j].y * y[j].y + y[j].z * y[j].z + y[j].w * y[j].w; }
                if (i + 1 < 32) { const int nr = row + 8;
#pragma unroll
                    for (int j = 0; j < 4; ++j) { yn[j] = *(const u32x2*)(Y + (size_t)nr * PN + 256 * j + 4 * lane); xn[j] = *(const f32x4*)(P.in[I_X] + (size_t)nr * DM + 256 * j + 4 * lane); } }
                const float rsy = rsqrtf(wave_sum(ss) * (1.f / DM) + EPS); float s2 = 0.f;
#pragma unroll
                for (int j = 0; j < 4; ++j) { const f32x4 gg = *(const LAS f32x4*)(MODS + 256 * j + 4 * lane); x[j] = x[j] + gg * (y[j] * rsy * g1v[j]);
                    { u32x2 xo; xo.x = cvt_pk_bf16(x[j].x, x[j].y); xo.y = cvt_pk_bf16(x[j].z, x[j].w); *(u32x2*)((bf16_t*)(P.out + (size_t)row * DM) + 256 * j + 4 * lane) = xo; } s2 += x[j].x * x[j].x + x[j].y * x[j].y + x[j].z * x[j].z + x[j].w * x[j].w; }
                const float rsx = rsqrtf(wave_sum(s2) * (1.f / DM) + EPS);
#pragma unroll
                for (int j = 0; j < 4; ++j) { const f32x4 sh = *(const LAS f32x4*)(MODS + 1024 + 256 * j + 4 * lane), sc = *(const LAS f32x4*)(MODS + 2048 + 256 * j + 4 * lane);
                    const f32x4 hv = (x[j] * rsx * g2v[j]) * sc + sh;
                    u32x2 o; o.x = cvt_pk_bf16(hv.x, hv.y); o.y = cvt_pk_bf16(hv.z, hv.w);
                    *(u32x2*)(H2 + (size_t)row * PN + 256 * j + 4 * lane) = o;
                    *(unsigned*)((unsigned char*)(F.ws + WS_PROJ) + (size_t)row * PN * 2 + 256 * j + 4 * lane) = pack_fp8x4(hv.x * H2_SCALE, hv.y * H2_SCALE, hv.z * H2_SCALE, hv.w * H2_SCALE); }
            }
        }
    }
    asm volatile("s_waitcnt vmcnt(0)" ::: "memory");
    __syncthreads();
    if (F.tid == 0) { __builtin_amdgcn_fence(__ATOMIC_ACQUIRE, "agent"); asm volatile("s_waitcnt vmcnt(0)" ::: "memory"); }
    __syncthreads();
#pragma unroll 1
    for (int rb = F.blk; rb < T / 256; rb += F.G) {
        __syncthreads();
        if (F.tid < 64) hist[F.tid] = 0;
        {
            pg8::Gemm g{(const bf16_t*)(F.ws + WS_PROJ) + 3072, (const bf16_t*)(F.ws + WS_WRT), PN, DM};
            SchedOne S{rb}; EpiRouter E{LG};
            pg8::gemm_phase<EpiRouter, SchedOne, true>(F.lds, g, S, E);
        }
        __syncthreads();
        if (F.tid < 256) {
            const int lr = F.tid, row = rb * 256 + lr;
            float sc[64], sel[64];
#pragma unroll
            for (int e = 0; e < 64; ++e) { const float s = sigmoidf_(LG[e * LGP + lr]); sc[e] = s; sel[e] = s + P.in[I_RB][e]; }
            float gs[8];
#pragma unroll
            for (int g2 = 0; g2 < 8; ++g2) { float m1 = -3.0e38f, m2 = -3.0e38f;
#pragma unroll
                for (int j = 0; j < 8; ++j) { const float v = sel[8 * g2 + j]; m2 = fmaxf(m2, fminf(m1, v)); m1 = fmaxf(m1, v); }
                gs[g2] = m1 + m2; }
#pragma unroll
            for (int g2 = 0; g2 < 8; ++g2) { int rank = 0;
#pragma unroll
                for (int g3 = 0; g3 < 8; ++g3) if (g3 != g2) rank += (gs[g3] > gs[g2] || (gs[g3] == gs[g2] && g3 < g2)) ? 1 : 0;
                if (rank >= 4) {
#pragma unroll
                    for (int j = 0; j < 8; ++j) sel[8 * g2 + j] = -3.0e38f; } }
            int idx[8]; float wv[8]; float wsum = 0.f;
#pragma unroll
            for (int k = 0; k < 8; ++k) { float best = -3.4e38f, bs = 0.f; int bi = 0;
#pragma unroll
                for (int e = 0; e < 64; ++e) { const bool c = sel[e] > best; best = c ? sel[e] : best; bi = c ? e : bi; bs = c ? sc[e] : bs; }
                idx[k] = bi; wv[k] = bs; wsum += bs;
#pragma unroll
                for (int e = 0; e < 64; ++e) sel[e] = (bi == e) ? -3.4e38f : sel[e]; }
            const float wn = 2.5f * __builtin_amdgcn_rcpf(wsum);
            *(u32x4*)(EIDX + (size_t)row * 8) = (u32x4){(unsigned)idx[0], (unsigned)idx[1], (unsigned)idx[2], (unsigned)idx[3]};
            *(u32x4*)(EIDX + (size_t)row * 8 + 4) = (u32x4){(unsigned)idx[4], (unsigned)idx[5], (unsigned)idx[6], (unsigned)idx[7]};
            *(f32x4*)(WTS + (size_t)row * 8) = (f32x4){wv[0] * wn, wv[1] * wn, wv[2] * wn, wv[3] * wn};
            *(f32x4*)(WTS + (size_t)row * 8 + 4) = (f32x4){wv[4] * wn, wv[5] * wn, wv[6] * wn, wv[7] * wn};
#pragma unroll
            for (int k = 0; k < 8; ++k) atomicAdd((int*)hist + idx[k], 1);
        }
        __syncthreads();
        if (F.tid < 64) ((int*)(F.ws + WS_BCNT))[rb * 64 + F.tid] = hist[F.tid];
    }
}

DEVI void phase_lists(Frame& F) {
    LAS int* base = (LAS int*)F.lds;
    LAS int* pst = base + 64;
    LAS int* tot = pst + 65;
    LAS int* lcnt = tot + 64;
    const int* BC = (const int*)(F.ws + WS_BCNT);
    const int* EIDX = (const int*)(F.ws + WS_EIDX); const float* WTS = (const float*)(F.ws + WS_WTS); int* POS = (int*)(F.ws + WS_POS);
    for (int rb = F.blk; rb < 256; rb += F.G) {
        const int hh = rb >> 7;
        __syncthreads();
        {   LAS int* psum = lcnt + 64;
            const int e = F.tid & 63, part = F.tid >> 6; int bs = 0, ts = 0;
#pragma unroll
            for (int i = 0; i < 16; ++i) { const int q = hh * 128 + part * 16 + i; const int v = BC[q * 64 + e]; ts += v; bs += q < rb ? v : 0; }
            psum[(part * 64 + e) * 2] = bs; psum[(part * 64 + e) * 2 + 1] = ts;
            __syncthreads();
            if (F.tid < 64) { int bsum = 0, tsum = 0;
#pragma unroll
                for (int p = 0; p < 8; ++p) { bsum += psum[(p * 64 + F.tid) * 2]; tsum += psum[(p * 64 + F.tid) * 2 + 1]; }
                base[F.tid] = bsum; tot[F.tid] = tsum; lcnt[F.tid] = 0; }
        }
        __syncthreads();
        if (F.tid == 0) { int s = 0; for (int e = 0; e < 64; ++e) { pst[e] = s; s += (tot[e] + 255) & ~255; } pst[64] = s; }
        __syncthreads();
        int* TOK = (int*)(F.ws + WS_TOKL) + (size_t)hh * ROWS_H; float* WL = (float*)(F.ws + WS_WL) + (size_t)hh * ROWS_H;
        for (int i = F.tid; i < 256 * 8; i += NTHREADS) { const int t = rb * 256 + (i >> 3), k = i & 7; const int e = EIDX[(size_t)t * 8 + k];
            const int loc = atomicAdd((int*)lcnt + e, 1); const int dest = pst[e] + base[e] + loc;
            TOK[dest] = t; WL[dest] = WTS[(size_t)t * 8 + k]; POS[(size_t)t * 8 + k] = dest + hh * ROWS_H; }
        if (F.tid < 256) { const int t = rb * 256 + F.tid; TOK[CAP_R + t - hh * HALF_T] = t; WL[CAP_R + t - hh * HALF_T] = 1.f; }
        const int e = rb & 127;
        if (e < 64) {
            for (int r = pst[e] + tot[e] + F.tid; r < pst[e + 1]; r += NTHREADS) { TOK[r] = -1; WL[r] = 0.f; }
            int* TE = (int*)(F.ws + WS_TEXP) + hh * CAP_TILES;
            for (int q = (pst[e] >> 8) + F.tid; q < (pst[e + 1] >> 8); q += NTHREADS) TE[q] = e;
            if (e == 0 && F.tid == 0) ((int*)(F.ws + WS_NT))[hh] = pst[64] >> 8;
        }
    }
}

struct SchedMoE {
    int G, c, nt0, nt1, npn, hsel; const int* texp; const int* tok; bool gather;
    DEVI bool next(int i, pg8::Unit& u) const {
        const int cc = (G == 256) ? ((c & 7) * 32 + (c >> 3)) : c;
        const int sh = npn == 8 ? 3 : (npn == 4 ? 2 : 1);
        const int L = i * G + cc; const int rtl = L >> sh; int pnl = L & (npn - 1);
        const int r0 = nt0 + SH_TILES, r1 = nt1 + SH_TILES;
        int hh, rl;
        if (hsel < 0) { if (rtl >= r0 + r1) return false; hh = rtl >= r0 ? 1 : 0; rl = rtl - hh * r0; }
        else {
            hh = hsel; const int nrt = hh ? r1 : r0, fr = nrt / G;
            if (i < npn * fr) { rl = (i >> sh) * G + cc; pnl = i & (npn - 1); }
            else { const int L2 = (i - npn * fr) * G + cc; rl = fr * G + (L2 >> sh); pnl = L2 & (npn - 1); if (rl >= nrt) return false; }
        }
        const int nth = hh ? nt1 : nt0;
        int e, lt; if (rl < nth) { lt = rl; e = texp[hh * CAP_TILES + rl]; } else { lt = CAP_TILES + (rl - nth); e = 64; }
        u.pm = hh * HTILES + lt; u.pn = e * npn + pnl; u.aux = pnl; return true;
    }
    DEVI int arow(const pg8::Unit& u, int r) const {
        if (!gather) return u.pm * 256 + r;
        const int t = tok[u.pm * 256 + r]; return t < 0 ? 0 : t;
    }
};
constexpr int UT_OFF = pg8::STAGE_BYTES, UT_MAX = 64;
constexpr int WLB_OFF = UT_OFF + 1024;
constexpr int IDX_OFF = UT_OFF + 3072;
template <bool GATHER>
struct SchedTab { const LAS int* tab; const int* tok;
    static constexpr bool IDX_DMA = GATHER;
    DEVI bool next(int i, pg8::Unit& u) const {
        if (i >= UT_MAX) return false;
        const int pm = tab[4 * i]; if (pm < 0) return false;
        u.pm = pm; u.pn = tab[4 * i + 1]; u.aux = tab[4 * i + 2]; return true;
    }
    DEVI int arow(const pg8::Unit& u, int r) const {
        if (!GATHER) return u.pm * 256 + r;
        return tok[u.pm * 256 + r];
    }
    DEVI void idx_dma(LAS unsigned char* l, const pg8::Unit& u, int ui, int wid, int lane) const {
        if (wid >= 4) __builtin_amdgcn_global_load_lds((const unsigned*)(tok + u.pm * 256 + (wid - 4) * 64 + lane), (LAS unsigned*)(l + IDX_OFF + (ui & 1) * 1024 + (wid - 4) * 256), 4, 0, 0);
    }
    DEVI int idx_lds(LAS unsigned char* l, int ui, int r) const { return ((const LAS int*)(l + IDX_OFF + (ui & 1) * 1024))[r]; }
};
template <bool GATHER>
DEVI SchedTab<GATHER> build_unit_table(Frame& F, const SchedMoE& S) {
    LAS int* tab = (LAS int*)(F.lds + UT_OFF);
    __syncthreads();
    int ti = F.tid; asm volatile("" : "+v"(ti));
    if (ti < UT_MAX) { pg8::Unit u; u.pm = 0; u.pn = 0; u.aux = 0; const bool ok = S.next(ti, u);
        tab[4 * ti] = ok ? u.pm : -1; tab[4 * ti + 1] = ok ? u.pn : 0; tab[4 * ti + 2] = ok ? u.aux : 0; }
    __syncthreads();
    return SchedTab<GATHER>{tab, S.tok};
}
struct EpiGU { unsigned char* O; const float* wl; float inv; LAS unsigned char* lds;
    static constexpr bool PRE = true;
    DEVI void prefetch(LAS unsigned char* l, const pg8::Unit& u, int wid, int lane) const {
        if (wid < 4) __builtin_amdgcn_global_load_lds((const unsigned*)(wl + u.pm * 256 + wid * 64 + lane), (LAS unsigned*)(l + WLB_OFF + (u.seq & 1) * 1024 + wid * 256), 4, 0, 0);
    }
    DEVI void operator()(const f32x4 (&acc)[2][2][4][2], const pg8::Unit& u, int wr, int wc, int fr, int fq) const {
        asm volatile("" : "+v"(fr), "+v"(fq));
        const int row0 = u.pm * 256 + wr * 64 + fr, col0 = u.aux * 64 + wc * 16 + 4 * fq;
        const LAS float* wb = (const LAS float*)(lds + WLB_OFF + (u.seq & 1) * 1024) + wr * 64 + fr;
        float wv[2][4];
#pragma unroll
        for (int ai = 0; ai < 2; ++ai)
#pragma unroll
            for (int m = 0; m < 4; ++m) wv[ai][m] = wb[ai * 128 + m * 16];
#pragma unroll
        for (int ai = 0; ai < 2; ++ai)
#pragma unroll
            for (int m = 0; m < 4; ++m) { const f32x4 g0 = acc[ai][0][m][0], u0 = acc[ai][0][m][1]; const float w = wv[ai][m];
                float o[4];
#pragma unroll
                for (int i = 0; i < 4; ++i) o[i] = siluf_(g0[i]) * u0[i] * (w * ACT_SCALE);
                *(unsigned*)(O + (size_t)(row0 + ai * 128 + m * 16) * EFF + col0) = pack_fp8x4(o[0], o[1], o[2], o[3]); }
    } };
DEVI void phase_moe_gu(Frame& F) {
    const int nt0 = ((const int*)(F.ws + WS_NT))[0], nt1 = ((const int*)(F.ws + WS_NT))[1];
    static_assert(H2_SCALE * W_SCALE_GU == 16384.f, "the gate|up GEMM's operand scaling is undone by the MFMA block scale: 2^-14");
    pg8::Gemm g{(const bf16_t*)(F.ws + WS_PROJ), (const bf16_t*)(F.ws + WS_WGU), PN, DM / 2, 0x71717171};
    SchedMoE S0{F.G, F.blk, nt0, nt1, 4, -1, (const int*)(F.ws + WS_TEXP), (const int*)(F.ws + WS_TOKL), true};
    const SchedTab<true> S = build_unit_table<true>(F, S0);
    EpiGU E{(unsigned char*)(F.ws + WS_ACT), (const float*)(F.ws + WS_WL), 1.f, F.lds};
    pg8::gemm_phase<EpiGU, SchedTab<true>, false, true, true>(F.lds, g, S, E);
}
struct EpiDown { unsigned char* O; int hh; float sc;
    static constexpr bool PRE = false;
    static constexpr int NST = 8;
    DEVI void operator()(const f32x4 (&acc)[2][2][4][2], const pg8::Unit& u, int wr, int wc, int fr, int fq) const {
        asm volatile("" : "+v"(fr), "+v"(fq));
        const int row0 = (u.pm - hh * HTILES) * 256 + wr * 64 + fr, col0 = u.aux * 128 + wc * 32 + 8 * fq;
#pragma unroll
        for (int ai = 0; ai < 2; ++ai)
#pragma unroll
            for (int m = 0; m < 4; ++m) { const int row = row0 + ai * 128 + m * 16;
                const f32x4 a0 = acc[ai][0][m][0], a1 = acc[ai][0][m][1];
                u32x2 o; o.x = pack_fp8x4(a0[0], a0[1], a0[2], a0[3]); o.y = pack_fp8x4(a1[0], a1[1], a1[2], a1[3]);
                *(u32x2*)(O + (size_t)row * DM + col0) = o; }
    } };
DEVI void phase_moe_down(Frame& F, int hh) {
    const int nt0 = ((const int*)(F.ws + WS_NT))[0], nt1 = ((const int*)(F.ws + WS_NT))[1];
    static_assert(ROW_SCALE / (ACT_SCALE * W_SCALE_DN) == 1.f / 1024.f, "the down GEMM's output scaling rides on the MFMA block scale: 2^-10");
    SchedMoE S0{F.G, F.blk, nt0, nt1, 8, hh, (const int*)(F.ws + WS_TEXP), nullptr, false};
    const SchedTab<false> S = build_unit_table<false>(F, S0);
    pg8::DnArgs g{(const unsigned char*)(F.ws + WS_ACT), (const unsigned char*)(F.ws + WS_WD), (unsigned char*)(F.ws + (hh ? WS_ROWS1 : WS_ROWS0)), hh, 0x75757575};
    pg8::gemm_phase_dnreg(F.lds, g, S);
}
DEVI void phase_combine(Frame& F, int hh) {
    const Params& P = *F.p;
    LAS float* G2 = (LAS float*)F.lds;
    const unsigned char* ROWS = (const unsigned char*)(F.ws + (hh ? WS_ROWS1 : WS_ROWS0)); const int* POS = (const int*)(F.ws + WS_POS);
    const int cA = 16 * F.lane;
    f32x4 g3v[4];
#pragma unroll
    for (int j = 0; j < 4; ++j) g3v[j] = *(const f32x4*)(P.in[I_NORMG] + 3072 + cA + 4 * j);
    for (int rb = F.blk; rb < HALF_T / 128; rb += F.G) {
        const int t0 = hh * HALF_T + rb * 128, b = t0 >> 13;
        __syncthreads();
        for (int i = F.tid; i < 1024; i += NTHREADS) G2[i] = mod_value(F, b, 5 * 1024 + i);
        __syncthreads();
        int prv[16];
#pragma unroll
        for (int i = 0; i < 16; ++i) { prv[i] = 0; if (F.lane < 8) prv[i] = POS[(size_t)(t0 + F.wave + 8 * i) * 8 + F.lane] - hh * ROWS_H; }
#pragma unroll
        for (int i = 0; i < 16; ++i) {
            const int t = t0 + F.wave + 8 * i;
            const int pr = prv[i];
            const bf16_t* x1p = (const bf16_t*)(P.out + (size_t)t * DM);
            const u32x4 xa = *(const u32x4*)(x1p + cA), xb = *(const u32x4*)(x1p + cA + 8);
            u32x4 rv[9];
#pragma unroll
            for (int k = 0; k < 9; ++k) { const int r = k < 8 ? __shfl(pr, k) : CAP_R + (t - hh * HALF_T); rv[k] = *(const u32x4*)(ROWS + (size_t)r * DM + 16 * F.lane); }
            float a[16];
#pragma unroll
            for (int q = 0; q < 16; ++q) a[q] = 0.f;
#pragma unroll
            for (int k = 0; k < 9; ++k)
#pragma unroll
                for (int q = 0; q < 4; ++q) { const f32x2 lo = __builtin_amdgcn_cvt_pk_f32_fp8((int)rv[k][q], false), hi = __builtin_amdgcn_cvt_pk_f32_fp8((int)rv[k][q], true);
                    a[4 * q] += lo[0]; a[4 * q + 1] += lo[1]; a[4 * q + 2] += hi[0]; a[4 * q + 3] += hi[1]; }
            float ss = 0.f;
#pragma unroll
            for (int q = 0; q < 16; ++q) { a[q] *= (1.f / ROW_SCALE); ss += a[q] * a[q]; }
            const float rs = rsqrtf(wave_sum(ss) * (1.f / DM) + EPS);
            asm volatile("s_waitcnt vmcnt(0)" ::: "memory");
#pragma unroll
            for (int j = 0; j < 4; ++j) { const int col = cA + 4 * j; const f32x4 gg = *(const LAS f32x4*)(G2 + col);
                const u32x4 xs = (j >> 1) ? xb : xa; const unsigned w0 = (j & 1) ? xs.z : xs.x, w1 = (j & 1) ? xs.w : xs.y;
                const f32x4 x1 = (f32x4){lo_bf(w0), hi_bf(w0), lo_bf(w1), hi_bf(w1)};
                const f32x4 av = (f32x4){a[4 * j], a[4 * j + 1], a[4 * j + 2], a[4 * j + 3]};
                *(f32x4*)(P.out + (size_t)t * DM + col) = x1 + gg * (av * rs * g3v[j]); }
        }
    }
}

DEVI void phase_mixer_tail(Frame& F) {
    const bool first = (F.blk >> 3) & 1;
    if (first) { expert_weight_copies(F); __syncthreads(); }
    phase_chunk_out(F);
    wg_global_handoff(F);
    phase_gemm_y(F);
    wg_global_handoff(F);
    phase_norm2(F);
    if (!first) { __syncthreads(); expert_weight_copies(F); }
}

DEVI void phase_down1_combine0(Frame& F) {
    if ((F.blk >> 3) & 1) { phase_combine(F, 0); __syncthreads(); phase_moe_down(F, 1); }
    else { phase_moe_down(F, 1); __syncthreads(); phase_combine(F, 0); }
}

constexpr int N_PHASES = 11;
__global__ void __launch_bounds__(NTHREADS, 2) mk_fwd(Params prm) {
    extern __shared__ __attribute__((aligned(16))) unsigned char lds_raw[];
    Frame F; F.lds = (LAS unsigned char*)lds_raw; F.tid = threadIdx.x; F.lane = F.tid & 63; F.wave = __builtin_amdgcn_readfirstlane(F.tid >> 6);
    F.G = gridDim.x; F.blk = blockIdx.x; F.p = &prm; F.ws = prm.ws;
    volatile LAS unsigned* misc = (volatile LAS unsigned*)(F.lds + LDS_MISC);
    if (F.tid < 16) misc[F.tid] = 0u;
    __syncthreads();
    const int lo = prm.ph_lo, hi = prm.ph_hi;
    XcdBarrier bar; bar.bar = (unsigned*)(F.ws + WS_CTL); bar.x = 0; bar.st = misc;
    if (hi - lo > 1) bar = xcd_barrier_post((unsigned*)(F.ws + WS_CTL), misc);
#ifndef PH_MASK
#define PH_MASK 0xFFFF
#endif
#define RUN(k, call) do { if (((PH_MASK >> (k)) & 1) && lo <= (k) && (k) < hi) { call; if ((k) + 1 < hi) xcd_barrier(bar); } } while (0)
    RUN(0, phase_prep(F));
    RUN(1, phase_norm1(F));
    RUN(2, phase_gemm_proj(F));
    RUN(3, phase_chunk_u(F));
    RUN(4, phase_scan_states(F));
    RUN(5, phase_mixer_tail(F));
    RUN(6, phase_lists(F));
    RUN(7, phase_moe_gu(F));
    RUN(8, phase_moe_down(F, 0));
    RUN(9, phase_down1_combine0(F));
    RUN(10, phase_combine(F, 1));
#undef RUN
}

extern "C" void kernel_launch(void* const* d_in, const int* in_sizes, int n_in, void* d_out, int out_size, void* d_ws, size_t ws_size, hipStream_t stream) {
    static int grid = 0;
    if (grid == 0) {
        if (n_in != 23 || in_sizes[0] != T * DM || out_size != T * DM || ws_size < WS_END) {
            fprintf(stderr, "kernel_launch: unexpected shapes (n_in %d, in0 %d, out %d, ws %zu < %zu)\n", n_in, n_in > 0 ? in_sizes[0] : -1, out_size, ws_size, (size_t)WS_END); grid = -1; return; }
        int dev = 0, cus = 0, per_cu = 0;
        if (hipGetDevice(&dev) != hipSuccess || hipDeviceGetAttribute(&cus, hipDeviceAttributeMultiprocessorCount, dev) != hipSuccess) { grid = -1; return; }
        if (hipFuncSetAttribute((const void*)mk_fwd, hipFuncAttributeMaxDynamicSharedMemorySize, LDS_BYTES) != hipSuccess) { fprintf(stderr, "kernel_launch: hipFuncSetAttribute failed\n"); grid = -1; return; }
        if (hipOccupancyMaxActiveBlocksPerMultiprocessor(&per_cu, (const void*)mk_fwd, NTHREADS, LDS_BYTES) != hipSuccess || per_cu < 1) { fprintf(stderr, "kernel_launch: occupancy query says %d\n", per_cu); }
        (void)hipGetLastError();
        grid = cus;
    }
    if (grid < 0) return;
    (void)hipMemsetAsync((char*)d_ws + WS_CTL, 0, CTL_BYTES, stream);
    Params p{};
    for (int i = 0; i < 23; ++i) p.in[i] = (const float*)d_in[i];
    p.out = (float*)d_out; p.ws = (unsigned char*)d_ws;
#if MK_ONE_LAUNCH
    p.ph_lo = 0; p.ph_hi = N_PHASES;
    hipLaunchKernelGGL(mk_fwd, dim3(grid), dim3(NTHREADS), LDS_BYTES, stream, p);
#else
    for (int k = 0; k < N_PHASES; ++k) { p.ph_lo = k; p.ph_hi = k + 1; hipLaunchKernelGGL(mk_fwd, dim3(grid), dim3(NTHREADS), LDS_BYTES, stream, p); }
#endif
}
```

```cpp
#include <hip/hip_runtime.h>
#include <cstdio>
#include <cstdint>

#ifndef MK_ONE_LAUNCH
#define MK_ONE_LAUNCH 1
#endif

#define LAS __attribute__((address_space(3)))
#define DEVI __device__ __forceinline__
typedef unsigned short bf16_t;
typedef short bf16x8 __attribute__((ext_vector_type(8)));
typedef float f32x4 __attribute__((ext_vector_type(4)));
typedef float f32x2 __attribute__((ext_vector_type(2)));
typedef unsigned u32x4 __attribute__((ext_vector_type(4)));
typedef unsigned u32x2 __attribute__((ext_vector_type(2)));

constexpr int DM = 1024, NBATCH = 8, SEQ = 8192, T = NBATCH * SEQ, CTXL = 256, TC = NBATCH * CTXL, TT = T + TC;
constexpr int CH = 128, NCH = SEQ / CH, NCC = CTXL / CH, NSLOT = NCH + NCC;
constexpr int PN = 4096;
constexpr int INC = 4112;
constexpr int NE = 64, TOPK = 8, EFF = 256;
constexpr int NTHREADS = 512, NWAVES = 8;
constexpr int LDS_BYTES = 155648;
constexpr int LDS_MISC = LDS_BYTES - 64;
constexpr float EPS = 1e-6f;
constexpr int HALF_T = T / 2;
constexpr int CAP_R = HALF_T * TOPK + NE * 256;
constexpr int CAP_TILES = CAP_R / 256;
constexpr int ROWS_H = CAP_R + HALF_T;
constexpr int SH_TILES = HALF_T / 256;
constexpr int HTILES = ROWS_H / 256;
constexpr float ROW_SCALE = 8.f;
constexpr float ACT_SCALE = 16.f, W_SCALE_DN = 512.f;
constexpr float H2_SCALE = 16.f, W_SCALE_GU = 1024.f;

constexpr size_t MB = 1ull << 20;
constexpr size_t WS_CTL = 0;
constexpr size_t CTL_BYTES = 65536;
constexpr size_t WS_MODP = 1 * MB;
constexpr size_t WS_WINT = 3 * MB;
constexpr size_t WS_WOUTT = 11 * MB;
constexpr size_t WS_WRT = 13 * MB;
constexpr size_t WS_GATES = 14 * MB;
constexpr size_t WS_UN = 19 * MB;
constexpr size_t WS_CHS = 22 * MB;
constexpr size_t WS_SM = 22 * MB + 256 * 1024;
constexpr size_t WS_EIDX = 23 * MB;
constexpr size_t WS_WTS = 25 * MB;
constexpr size_t WS_POS = 27 * MB;
constexpr size_t WS_TOKL = 29 * MB;
constexpr size_t WS_WL = 32 * MB;
constexpr size_t WS_BCNT = 35 * MB;
constexpr size_t WS_TEXP = 35 * MB + 128 * 1024;
constexpr size_t WS_NT = 35 * MB + 256 * 1024;
constexpr size_t WS_B = 36 * MB;
constexpr size_t WS_PROJ = 168 * MB;
constexpr size_t WS_US = 696 * MB;
constexpr size_t WS_WGU = 36 * MB;
constexpr size_t WS_WD = 101 * MB;
constexpr size_t WS_ACT = 776 * MB;
constexpr size_t WS_ROWS0 = 168 * MB;
constexpr size_t WS_ROWS1 = 472 * MB;
constexpr size_t WS_END = 1000 * MB;
static_assert(WS_WD + 65ull * 1024 * 256 * 2 <= WS_PROJ && WS_ACT + 2ull * ROWS_H * 256 <= WS_END && WS_ROWS0 + (size_t)ROWS_H * 1024 <= WS_ROWS1
              && WS_ROWS1 + (size_t)ROWS_H * 1024 <= WS_ACT && WS_ACT >= WS_PROJ + (size_t)TT * PN * 2, "workspace overlap");

struct Params {
    const float* in[23];
    float* out;
    unsigned char* ws;
    int ph_lo, ph_hi;
};
enum { I_X = 0, I_C, I_CTX, I_CCTX, I_WMOD, I_BMOD, I_NORMG, I_WIN, I_RDEC, I_RNG, I_CONVW, I_CONVB, I_GATEB, I_MNG, I_WOUT,
       I_WR, I_RB, I_WG, I_WU, I_WDN, I_SG, I_SU, I_SD };

DEVI float bf2f(bf16_t b) { return __uint_as_float(((unsigned)b) << 16); }
DEVI unsigned cvt_pk_bf16(float lo, float hi) { unsigned r; asm volatile("v_cvt_pk_bf16_f32 %0, %1, %2" : "=v"(r) : "v"(lo), "v"(hi)); return r; }
DEVI bf16_t f2bf(float f) { return (bf16_t)(cvt_pk_bf16(f, 0.f) & 0xffffu); }
DEVI float lo_bf(unsigned u) { return __uint_as_float(u << 16); }
DEVI float hi_bf(unsigned u) { return __uint_as_float(u & 0xffff0000u); }
DEVI float wave_sum(float v) {
#pragma unroll
    for (int o = 1; o < 64; o <<= 1) v += __shfl_xor(v, o);
    return v;
}
DEVI float row16_sum(float v) {
    v += __builtin_bit_cast(float, __builtin_amdgcn_update_dpp(0, __builtin_bit_cast(int, v), 0xB1, 0xF, 0xF, true));
    v += __builtin_bit_cast(float, __builtin_amdgcn_update_dpp(0, __builtin_bit_cast(int, v), 0x4E, 0xF, 0xF, true));
    v += __builtin_bit_cast(float, __builtin_amdgcn_update_dpp(0, __builtin_bit_cast(int, v), 0x141, 0xF, 0xF, true));
    v += __builtin_bit_cast(float, __builtin_amdgcn_update_dpp(0, __builtin_bit_cast(int, v), 0x140, 0xF, 0xF, true));
    return v;
}
DEVI float dpp_x1(float x) { return __builtin_bit_cast(float, __builtin_amdgcn_update_dpp(0, __builtin_bit_cast(int, x), 0xB1, 0xF, 0xF, true)); }
DEVI float dpp_x2(float x) { return __builtin_bit_cast(float, __builtin_amdgcn_update_dpp(0, __builtin_bit_cast(int, x), 0x4E, 0xF, 0xF, true)); }
DEVI float dpp_x4(float x) { const int t = __builtin_amdgcn_update_dpp(0, __builtin_bit_cast(int, x), 0x114, 0xF, 0xA, true);
    return __builtin_bit_cast(float, __builtin_amdgcn_update_dpp(t, __builtin_bit_cast(int, x), 0x104, 0xF, 0x5, true)); }
DEVI float dpp_x8(float x) { const int t = __builtin_amdgcn_update_dpp(0, __builtin_bit_cast(int, x), 0x118, 0xF, 0xC, true);
    return __builtin_bit_cast(float, __builtin_amdgcn_update_dpp(t, __builtin_bit_cast(int, x), 0x108, 0xF, 0x3, true)); }
DEVI float quad_sum(float v) {
    v += __builtin_bit_cast(float, __builtin_amdgcn_update_dpp(0, __builtin_bit_cast(int, v), 0xB1, 0xF, 0xF, true));
    v += __builtin_bit_cast(float, __builtin_amdgcn_update_dpp(0, __builtin_bit_cast(int, v), 0x4E, 0xF, 0xF, true));
    return v;
}
DEVI float wave_max(float v) {
#pragma unroll
    for (int o = 1; o < 64; o <<= 1) v = fmaxf(v, __shfl_xor(v, o));
    return v;
}
DEVI float sigmoidf_(float x) { return __builtin_amdgcn_rcpf(1.f + __expf(-x)); }
DEVI float siluf_(float x) { return x * __builtin_amdgcn_rcpf(1.f + __expf(-x)); }
DEVI float logsigmoidf_(float x) { const float e = __expf(-fabsf(x)); return fminf(x, 0.f) - __logf(1.f + e); }
#define LDS_WAIT() asm volatile("s_waitcnt lgkmcnt(0)" ::: "memory")

#define XB_TMO      128
#define XB_XCNT(j)  (256  + 64 * (j))
#define XB_XSUB(j)  (1280 + 64 * (j))
#define XB_XGEN(j)  (2304 + 64 * (j))
#define XB_TOP      3328
#define XB_TOPGEN   3392
#define XCD_BAR_WORDS 3456
#define XB_SPIN_CAP (1u << 18)
DEVI unsigned xb_ld(unsigned* p)              { return __hip_atomic_load(p, __ATOMIC_RELAXED, __HIP_MEMORY_SCOPE_AGENT); }
DEVI unsigned xb_add(unsigned* p, unsigned v) { return __hip_atomic_fetch_add(p, v, __ATOMIC_RELAXED, __HIP_MEMORY_SCOPE_AGENT); }
DEVI unsigned xb_xcc_id() { return (unsigned)__builtin_amdgcn_s_getreg((3 << 11) | 20) & 0xFu; }
#define XB_SPIN(cond, bar) do { unsigned _sp = 0; while (cond) { __builtin_amdgcn_s_sleep(1); \
    if ((++_sp & 255u) == 0u) { if (xb_ld(&(bar)[XB_TMO])) break; if (_sp > XB_SPIN_CAP) { atomicAdd(&(bar)[XB_TMO], 1u); break; } } } } while (0)
struct XcdBarrier { unsigned* bar; unsigned x; volatile LAS unsigned* st; };
DEVI XcdBarrier xcd_barrier_post(unsigned* bar, volatile LAS unsigned* st) {
    XcdBarrier b; b.bar = bar; b.x = xb_xcc_id(); b.st = st;
    if (threadIdx.x == 0) (void)xb_add(&bar[XB_XCNT(b.x)], 1u);
    return b;
}
DEVI void xcd_barrier_complete(unsigned* bar, unsigned x, unsigned& nloc, unsigned& nx) {
    const unsigned G = gridDim.x * gridDim.y * gridDim.z;
    unsigned sum, cnt, mine, sp = 0u;
    for (;;) {
        sum = 0u; cnt = 0u; mine = 0u;
#pragma unroll
        for (unsigned j = 0; j < 16; ++j) { const unsigned c = xb_ld(&bar[XB_XCNT(j)]); sum += c; cnt += (c > 0u) ? 1u : 0u; mine = (j == x) ? c : mine; }
        if (sum == G) break;
        __builtin_amdgcn_s_sleep(1);
        if ((++sp & 255u) == 0u) { if (xb_ld(&bar[XB_TMO])) break; if (sp > XB_SPIN_CAP) { atomicAdd(&bar[XB_TMO], 1u); break; } }
    }
    nloc = mine > 0u ? mine : 1u; nx = cnt > 0u ? cnt : 1u;
}
DEVI void xcd_barrier(const XcdBarrier& b) {
    asm volatile("s_waitcnt vmcnt(0)" ::: "memory");
    __syncthreads();
    if (threadIdx.x == 0) {
        unsigned* bar = b.bar;
        __builtin_amdgcn_s_waitcnt(0);
        unsigned nloc = b.st[0], nx = b.st[1];
        if (nloc == 0u) { xcd_barrier_complete(bar, b.x, nloc, nx); b.st[0] = nloc; b.st[1] = nx; }
        const unsigned old = xb_add(&bar[XB_XSUB(b.x)], 1u);
        const unsigned gen = old / nloc;
        if (old + 1u == (gen + 1u) * nloc) {
            __builtin_amdgcn_fence(__ATOMIC_RELEASE, "agent");
            asm volatile("s_waitcnt vmcnt(0)" ::: "memory");
            const unsigned og = xb_add(&bar[XB_TOP], 1u);
            const unsigned tg = og / nx;
            if (og + 1u == (tg + 1u) * nx) xb_add(&bar[XB_TOPGEN], 1u);
            else XB_SPIN(xb_ld(&bar[XB_TOPGEN]) == tg, bar);
            __builtin_amdgcn_fence(__ATOMIC_ACQUIRE, "agent");
            xb_add(&bar[XB_XGEN(b.x)], 1u);
            asm volatile("s_waitcnt vmcnt(0)" ::: "memory");
        } else {
            XB_SPIN(xb_ld(&bar[XB_XGEN(b.x)]) == gen, bar);
            __builtin_amdgcn_fence(__ATOMIC_ACQUIRE, "agent");
            asm volatile("s_waitcnt vmcnt(0)" ::: "memory");
        }
    }
    __syncthreads();
}

DEVI unsigned pack_fp8x4(float a, float b, float c, float d);
namespace pg8 {
constexpr int BM = 256, BK = 64, HALF = 128, HTB = HALF * BK * 2, STAGE_BYTES = 8 * HTB, NXCD = 8, WGM = 8;
DEVI int lds_byte(int r, int c) { const int st = (r >> 4) * 2 + (c >> 5), rr = r & 15, cc = c & 31, ob = rr * 64 + cc * 2; return st * 1024 + (ob ^ (((ob >> 9) & 1) << 5)); }
DEVI void stage_rc(int b, int& R, int& C) { const int st = b / 1024, sb = b % 1024, swz = sb ^ (((sb >> 9) & 1) << 5); R = (st >> 1) * 16 + swz / 64; C = (st & 1) * 32 + (swz % 64) / 2; }
DEVI int perm32(int rho) { const int n = rho >> 4, i = rho & 15; return 8 * (i >> 2) + 4 * n + (i & 3); }
struct Unit { int pm, pn, aux, seq; };
struct Gemm { const bf16_t* A; const bf16_t* Bt; int lda; int K; int sa = 0x7f7f7f7f; };
DEVI bool static_unit(int nM, int nN, long L, Unit& u) {
    const int nwg = nM * nN; if (L >= nwg) return false;
    int wgid = (int)L; { const int q = nwg / NXCD, r = nwg % NXCD, xcd = wgid % NXCD, off = wgid / NXCD; wgid = (xcd < r ? xcd * (q + 1) : r * (q + 1) + (xcd - r) * q) + off; }
    const int nig = WGM * nN, gid = wgid / nig, fm = gid * WGM, gsz = (nM - fm) < WGM ? (nM - fm) : WGM;
    u.pm = fm + ((wgid % nig) % gsz); u.pn = (wgid % nig) / gsz; u.aux = 0; return true;
}

typedef int v4i_t __attribute__((ext_vector_type(4)));
typedef int v8i_t __attribute__((ext_vector_type(8)));
template <class Epi, class Sched, bool AFTER_DRAIN = false, bool HB = false, bool F8 = false>
DEVI void gemm_phase(LAS unsigned char* lds, const Gemm g, const Sched& S, const Epi& E) {
    static_assert(!F8 || HB, "the fp8 body is the half-width one");
    const int tid = threadIdx.x, wid = __builtin_amdgcn_readfirstlane(tid >> 6), lane = tid & 63, wr = wid >> 2, wc = wid & 3, fr = lane & 15, fq = lane >> 4;
    const int K = g.K, nt = K / BK;
    int sR[2], sC[2]; unsigned voffB[2];
#pragma unroll
    for (int i = 0; i < 2; ++i) { int R, C; stage_rc(tid * 16 + i * 8192, R, C); sR[i] = R; sC[i] = C; const int Rb = (R & ~31) + perm32(R & 31); voffB[i] = (unsigned)(Rb * K + C) * 2u; }
    const size_t kstep = (size_t)(BK * 2);
    const size_t hstepB = (size_t)HALF * K * 2;
    const size_t tstepB = HB ? hstepB : 2 * hstepB;
    const unsigned ldsw = (unsigned)wid * 1024u;
    const int aoff = lds_byte(wr * 64 + fr, fq * 8), boff = lds_byte(wc * 32 + fr, fq * 8);
#define PG8_SA(b, h) (((b) * 2 + (h)) * HTB)
#define PG8_SB(b, h) ((4 + (b) * 2 + (h)) * HTB)
#define PG8_STAGE(bufoff, gbase, voff) do { _Pragma("unroll") for (int _i = 0; _i < 2; ++_i) \
        __builtin_amdgcn_global_load_lds((const unsigned*)((const char*)(gbase) + (voff)[_i]), (LAS unsigned*)(lds + (bufoff) + ldsw + _i * 8192), 16, 0, 0); } while (0)
#define PG8_LD8(P) __builtin_shufflevector(*(const LAS v4i_t*)(P), *(const LAS v4i_t*)((P) + 1024), 0, 1, 2, 3, 4, 5, 6, 7)
#define PG8_LDA(dst, b, h) do { _Pragma("unroll") for (int m = 0; m < 4; ++m) { if constexpr (F8) dst##8[m] = PG8_LD8(lds + PG8_SA(b, h) + aoff + m * 2048); \
        else { _Pragma("unroll") for (int k = 0; k < 2; ++k) dst[m][k] = *(const LAS bf16x8*)(lds + PG8_SA(b, h) + aoff + m * 2048 + k * 1024); } } } while (0)
#define PG8_LDB(dst, b, h) do { _Pragma("unroll") for (int n = 0; n < 2; ++n) { if constexpr (F8) dst##8[n] = PG8_LD8(lds + PG8_SB(b, h) + boff + n * 2048); \
        else { _Pragma("unroll") for (int k = 0; k < 2; ++k) dst[n][k] = *(const LAS bf16x8*)(lds + PG8_SB(b, h) + boff + n * 2048 + k * 1024); } } } while (0)
#define PG8_MMA(ai, bj, At, Bt) do { __builtin_amdgcn_s_setprio(1); _Pragma("unroll") for (int m = 0; m < 4; ++m) _Pragma("unroll") for (int n = 0; n < 2; ++n) { \
        if constexpr (F8) acc[ai][bj][m][n] = __builtin_amdgcn_mfma_scale_f32_16x16x128_f8f6f4(Bt##8[n], At##8[m], acc[ai][bj][m][n], 0, 0, 0, g.sa, 0, 0x7f7f7f7f); \
        else { _Pragma("unroll") for (int k = 0; k < 2; ++k) acc[ai][bj][m][n] = __builtin_amdgcn_mfma_f32_16x16x32_bf16(Bt[n][k], At[m][k], acc[ai][bj][m][n], 0, 0, 0); } } \
        __builtin_amdgcn_s_setprio(0); } while (0)
#define PG8_WAIT_LOOP do { if constexpr (HB) PG8_WAIT_V(6); else PG8_WAIT_V(8); } while (0)
#define PG8_WAIT_V(n) asm volatile("s_waitcnt vmcnt(" #n ")" ::: "memory")
#define PG8_WAIT_L(n) asm volatile("s_waitcnt lgkmcnt(" #n ")" ::: "memory")
#define PG8_BAR __builtin_amdgcn_s_barrier()
#define PG8_SCHED __builtin_amdgcn_sched_barrier(0)
#define PG8_AOFFS(dst, u) do { _Pragma("unroll") for (int _h = 0; _h < 2; ++_h) _Pragma("unroll") for (int _i = 0; _i < 2; ++_i) \
        { const int raw_ = S.arow(u, _h * HALF + sR[_i]); dst[_h][_i] = ((unsigned)(raw_ < 0 ? 0 : raw_) * (unsigned)g.lda + (unsigned)sC[_i]) * 2u; } } while (0)
    Unit cur, nxt; int ui = 0;
    if (!S.next(0, cur)) return;
    f32x4 acc[2][2][4][2];
#pragma unroll
    for (int a = 0; a < 2; ++a)
#pragma unroll
        for (int b = 0; b < 2; ++b)
#pragma unroll
            for (int m = 0; m < 4; ++m)
#pragma unroll
                for (int n = 0; n < 2; ++n) acc[a][b][m][n] = (f32x4){0.f, 0.f, 0.f, 0.f};
    bf16x8 At[4][2], B0[2][2], B1[2][2]; v8i_t At8[4], B08[2], B18[2];
    unsigned cOff[2][2], nOff[2][2];
    PG8_AOFFS(cOff, cur);
    bool has_next = S.next(1, nxt);
    if (has_next) { PG8_AOFFS(nOff, nxt); } else {
#pragma unroll
        for (int _h = 0; _h < 2; ++_h)
#pragma unroll
            for (int _i = 0; _i < 2; ++_i) nOff[_h][_i] = cOff[_h][_i]; }
    const char* gA = (const char*)g.A;
    const char* cB = (const char*)g.Bt + (size_t)cur.pn * tstepB;
    PG8_STAGE(PG8_SB(0, 0), cB, voffB); if constexpr (!HB) PG8_STAGE(PG8_SB(0, 1), cB + hstepB, voffB); PG8_STAGE(PG8_SA(0, 0), gA, cOff[0]); PG8_STAGE(PG8_SA(0, 1), gA, cOff[1]);
    if (wr == 1) PG8_BAR;
    PG8_WAIT_V(2); PG8_BAR;
    PG8_STAGE(PG8_SB(1, 0), cB + kstep, voffB); PG8_STAGE(PG8_SA(1, 0), gA + kstep, cOff[0]); if constexpr (!HB) PG8_STAGE(PG8_SB(1, 1), cB + hstepB + kstep, voffB);
    if constexpr (HB) PG8_WAIT_V(4); else PG8_WAIT_V(6);
    PG8_BAR;
    for (;;) {
        const char* nB = has_next ? (const char*)g.Bt + (size_t)nxt.pn * tstepB : cB;
        cur.seq = ui;
        if constexpr (Epi::PRE) E.prefetch(lds, cur, wid, lane);
        Unit nn; int nnRaw[2][2];
        const bool has_nn = has_next && S.next(ui + 2, nn);
        if constexpr (Sched::IDX_DMA) { if (has_nn) S.idx_dma(lds, nn, ui, wid, lane); }
        else {
#pragma unroll
            for (int _h = 0; _h < 2; ++_h)
#pragma unroll
                for (int _i = 0; _i < 2; ++_i) nnRaw[_h][_i] = has_nn ? S.arow(nn, _h * HALF + sR[_i]) : 0; }
#pragma unroll 1
        for (int t = 0; t < nt; t += 2) {
            const bool last = (t == nt - 2);
            const char* a1 = gA + (size_t)(t + 1) * kstep;
            const char* a2 = last ? gA : gA + (size_t)(t + 2) * kstep; const char* b2 = last ? nB : cB + (size_t)(t + 2) * kstep;
            const char* a3 = a2 + kstep; const char* b3 = b2 + kstep;
            unsigned o2[2][2];
#pragma unroll
            for (int _h = 0; _h < 2; ++_h)
#pragma unroll
                for (int _i = 0; _i < 2; ++_i) o2[_h][_i] = last ? nOff[_h][_i] : cOff[_h][_i];
            PG8_LDB(B0, 0, 0); if constexpr (!HB) PG8_LDB(B1, 0, 1); PG8_SCHED; PG8_LDA(At, 0, 0); PG8_STAGE(PG8_SA(1, 1), a1, cOff[1]);
            PG8_WAIT_LOOP; PG8_WAIT_L(0); PG8_BAR; PG8_MMA(0, 0, At, B0); if constexpr (!HB) PG8_MMA(0, 1, At, B1); PG8_BAR; PG8_SCHED;
            PG8_LDA(At, 0, 1); PG8_STAGE(PG8_SB(0, 0), b2, voffB); if constexpr (!HB) PG8_STAGE(PG8_SB(0, 1), b2 + hstepB, voffB); PG8_STAGE(PG8_SA(0, 0), a2, o2[0]);
            PG8_WAIT_LOOP; PG8_WAIT_L(0); PG8_BAR; PG8_MMA(1, 0, At, B0); if constexpr (!HB) PG8_MMA(1, 1, At, B1); PG8_BAR; PG8_SCHED;
            PG8_LDB(B0, 1, 0); if constexpr (!HB) PG8_LDB(B1, 1, 1); PG8_SCHED; PG8_LDA(At, 1, 0); PG8_STAGE(PG8_SA(0, 1), a2, o2[1]);
            PG8_WAIT_LOOP; PG8_WAIT_L(0); PG8_BAR; PG8_MMA(0, 0, At, B0); if constexpr (!HB) PG8_MMA(0, 1, At, B1); PG8_BAR; PG8_SCHED;
            PG8_LDA(At, 1, 1); PG8_STAGE(PG8_SB(1, 0), b3, voffB); if constexpr (!HB) PG8_STAGE(PG8_SB(1, 1), b3 + hstepB, voffB); PG8_STAGE(PG8_SA(1, 0), a3, o2[0]);
            PG8_WAIT_LOOP; PG8_WAIT_L(0); PG8_BAR; PG8_MMA(1, 0, At, B0); if constexpr (!HB) PG8_MMA(1, 1, At, B1); PG8_BAR; PG8_SCHED;
        }
        if (wr == 0) PG8_BAR;
        if constexpr (!AFTER_DRAIN) E(acc, cur, wr, wc, fr, fq);
        if (!has_next) break;
#pragma unroll
        for (int a = 0; a < 2; ++a)
#pragma unroll
            for (int b = 0; b < 2; ++b)
#pragma unroll
                for (int m = 0; m < 4; ++m)
#pragma unroll
                    for (int n = 0; n < 2; ++n) acc[a][b][m][n] = (f32x4){0.f, 0.f, 0.f, 0.f};
        cur = nxt; cB = nB; ++ui; nxt = nn; has_next = has_nn;
#pragma unroll
        for (int _h = 0; _h < 2; ++_h)
#pragma unroll
            for (int _i = 0; _i < 2; ++_i) { int raw;
                if constexpr (Sched::IDX_DMA) raw = has_nn ? S.idx_lds(lds, ui - 1, _h * HALF + sR[_i]) : 0; else { raw = nnRaw[_h][_i]; asm volatile("" : "+v"(raw)); }
                cOff[_h][_i] = nOff[_h][_i]; if (has_nn) nOff[_h][_i] = ((unsigned)(raw < 0 ? 0 : raw) * (unsigned)g.lda + (unsigned)sC[_i]) * 2u; }
        if (wr == 1) PG8_BAR;
    }
    PG8_WAIT_V(0);
    PG8_BAR;
    if constexpr (AFTER_DRAIN) E(acc, cur, wr, wc, fr, fq);
#undef PG8_SA
#undef PG8_SB
#undef PG8_STAGE
#undef PG8_LDA
#undef PG8_LD8
#undef PG8_WAIT_LOOP
#undef PG8_LDB
#undef PG8_MMA
#undef PG8_WAIT_V
#undef PG8_WAIT_L
#undef PG8_BAR
#undef PG8_SCHED
#undef PG8_AOFFS
}

template <class Epi, class Sched, int GRP>
DEVI void gemm_phase_astat8(LAS unsigned char* lds, const Gemm g, const Sched& S, const Epi& E) {
    const int tid = threadIdx.x, wid = __builtin_amdgcn_readfirstlane(tid >> 6), lane = tid & 63, wr = GRP, wc = wid & 3, fr = lane & 15, fq = lane >> 4;
    const int K = g.K;
    int sR[2], sC[2]; unsigned voffB[2], vA[2][2];
#pragma unroll
    for (int i = 0; i < 2; ++i) { int R, C; stage_rc(tid * 16 + i * 8192, R, C); sR[i] = R; sC[i] = C; const int Rb = (R & ~31) + perm32(R & 31); voffB[i] = (unsigned)(Rb * K + C) * 2u; }
#pragma unroll
    for (int h = 0; h < 2; ++h)
#pragma unroll
        for (int i = 0; i < 2; ++i) vA[h][i] = ((unsigned)(h * HALF + sR[i]) * (unsigned)g.lda + (unsigned)sC[i]) * 2u;
    const size_t kstep = (size_t)(BK * 2);
    const size_t tstepB = (size_t)HALF * K * 2;
    const unsigned ldsw = (unsigned)wid * 1024u;
    const int aoff = lds_byte(wr * 64 + fr, fq * 8), boff = lds_byte(wc * 32 + fr, fq * 8);
#define AS_STAGE(bufoff, gbase, voff) do { _Pragma("unroll") for (int _i = 0; _i < 2; ++_i) \
        __builtin_amdgcn_global_load_lds((const unsigned*)((const char*)(gbase) + (voff)[_i]), (LAS unsigned*)(lds + (bufoff) + ldsw + _i * 8192), 16, 0, 0); } while (0)
#define AS_STAGE_A(kt, pm_) do { const char* ab_ = gA + (size_t)(pm_) * 256u * (size_t)g.lda * 2u + (size_t)(kt) * kstep; \
        AS_STAGE(((kt) * 2) * HTB, ab_, vA[0]); AS_STAGE(((kt) * 2 + 1) * HTB, ab_, vA[1]); } while (0)
#define AS_STAGE_B(ht, Bp, kt) AS_STAGE((4 + (ht)) * HTB, (Bp) + (size_t)(kt) * kstep, voffB)
#define AS_LD8(P) __builtin_shufflevector(*(const LAS v4i_t*)(P), *(const LAS v4i_t*)((P) + 1024), 0, 1, 2, 3, 4, 5, 6, 7)
#define AS_LOADF(kt, slot) do { \
        _Pragma("unroll") for (int n = 0; n < 2; ++n) b8[n] = AS_LD8(lds + (4 + (slot) * 2 + (kt)) * HTB + boff + n * 2048); \
        _Pragma("unroll") for (int a = 0; a < 2; ++a) _Pragma("unroll") for (int m = 0; m < 4; ++m) a8[a][m] = AS_LD8(lds + ((kt) * 2 + a) * HTB + aoff + m * 2048); } while (0)
#define AS_MMA() do { __builtin_amdgcn_s_setprio(1); \
        _Pragma("unroll") for (int a = 0; a < 2; ++a) _Pragma("unroll") for (int m = 0; m < 4; ++m) _Pragma("unroll") for (int n = 0; n < 2; ++n) \
            acc[a][0][m][n] = __builtin_amdgcn_mfma_scale_f32_16x16x128_f8f6f4(b8[n], a8[a][m], acc[a][0][m][n], 0, 0, 0, g.sa, 0, 0x7f7f7f7f); \
        __builtin_amdgcn_s_setprio(0); } while (0)
#define AS_ZERO() do { _Pragma("unroll") for (int a = 0; a < 2; ++a) _Pragma("unroll") for (int m = 0; m < 4; ++m) _Pragma("unroll") for (int n = 0; n < 2; ++n) acc[a][0][m][n] = (f32x4){0.f, 0.f, 0.f, 0.f}; } while (0)
#define AS_WAIT(N) asm volatile("s_waitcnt vmcnt(" #N ") lgkmcnt(0)" ::: "memory")
#define AS_LWAIT() do { asm volatile("s_waitcnt lgkmcnt(0)" ::: "memory"); __builtin_amdgcn_sched_barrier(0); } while (0)
    static_assert(Epi::NST == 8, "the counted waits below assume 8 stores per epilogue");
    Unit cur, nxt, prv; int ui = 0;
    if (!S.next(0, cur)) return;
    prv = cur;
    f32x4 acc[2][2][4][2];
    AS_ZERO();
    v8i_t b8[2], a8[2][4];
    bool has_next = S.next(1, nxt);
    const char* gA = (const char*)g.A;
    const char* cB = (const char*)g.Bt + (size_t)cur.pn * tstepB;
    AS_STAGE_A(0, cur.pm); AS_STAGE_A(1, cur.pm); AS_STAGE_B(0, cB, 0); AS_STAGE_B(1, cB, 1);
    bool switched = false;
    for (;;) {
        const char* nB = has_next ? (const char*)g.Bt + (size_t)nxt.pn * tstepB : cB;
        const int slot = ui & 1;
        if (ui == 0 || (GRP == 1 && ui == 1)) AS_WAIT(0); else AS_WAIT(8);
        __builtin_amdgcn_s_barrier();
        __builtin_amdgcn_sched_barrier(0);
        if (switched) {
            AS_STAGE_A(0, cur.pm); AS_STAGE_A(1, cur.pm);
            asm volatile("s_waitcnt vmcnt(0)" ::: "memory");
            __builtin_amdgcn_s_barrier();
            __builtin_amdgcn_sched_barrier(0);
        }
        AS_STAGE_B((slot ^ 1) * 2, nB, 0); AS_STAGE_B((slot ^ 1) * 2 + 1, nB, 1);
        if constexpr (GRP == 0) {
            AS_LOADF(0, slot); AS_LWAIT(); AS_MMA(); __builtin_amdgcn_sched_barrier(0);
            AS_LOADF(1, slot); AS_LWAIT(); AS_MMA(); __builtin_amdgcn_sched_barrier(0);
            E(acc, cur, wr, wc, fr, fq); AS_ZERO();
        } else {
            if (ui > 0) { AS_MMA(); __builtin_amdgcn_sched_barrier(0); E(acc, prv, wr, wc, fr, fq); AS_ZERO(); }
            __builtin_amdgcn_sched_barrier(0);
            AS_LOADF(0, slot); AS_LWAIT(); AS_MMA(); __builtin_amdgcn_sched_barrier(0);
            AS_LOADF(1, slot);
        }
        __builtin_amdgcn_sched_barrier(0);
        prv = cur;
        if (!has_next) break;
        switched = nxt.pm != cur.pm; cur = nxt; cB = nB; ++ui; has_next = S.next(ui + 1, nxt);
    }
    if constexpr (GRP == 1) { AS_LWAIT(); AS_MMA(); E(acc, prv, wr, wc, fr, fq); }
    asm volatile("s_waitcnt vmcnt(0)" ::: "memory");
    __builtin_amdgcn_s_barrier();
#undef AS_LOADF
#undef AS_MMA
#undef AS_WAIT
#undef AS_LWAIT
#undef AS_STAGE
#undef AS_STAGE_A
#undef AS_STAGE_B
#undef AS_LD8
#undef AS_ZERO
}

struct DnArgs { const unsigned char* A; const unsigned char* Bt; unsigned char* O; int hh; int sa; };
template <class Sched>
DEVI void gemm_phase_dnreg(LAS unsigned char* lds, const DnArgs g, const Sched& S) {
    const int tid = threadIdx.x, wid = __builtin_amdgcn_readfirstlane(tid >> 6), lane = tid & 63, fr = lane & 15, fq = lane >> 4;
    constexpr int KB = 256;
    unsigned voffB[2];
#pragma unroll
    for (int i = 0; i < 2; ++i) { int R, C; stage_rc(tid * 16 + i * 8192, R, C); const int j = R >> 4, q4 = (R >> 2) & 3, r = R & 3;
        const int col = 64 * (j >> 2) + 16 * q4 + 4 * (j & 3) + r; voffB[i] = (unsigned)(col * KB + C * 2); }
    const unsigned ldsw = (unsigned)wid * 1024u;
    const int boff = lds_byte(fr, fq * 8);
#define DN_STAGE_B(slot, Bp, kt) do { _Pragma("unroll") for (int _i = 0; _i < 2; ++_i) \
        __builtin_amdgcn_global_load_lds((const unsigned*)((Bp) + (kt) * 128 + voffB[_i]), (LAS unsigned*)(lds + (slot) * HTB + ldsw + _i * 8192), 16, 0, 0); } while (0)
#define DN_LOADA(dst, pm_) do { const unsigned char* ap_ = g.A + ((size_t)(pm_) * 256u + 32u * wid + fr) * KB + 16 * fq; \
        _Pragma("unroll") for (int kt = 0; kt < 2; ++kt) _Pragma("unroll") for (int m = 0; m < 2; ++m) { \
            const v4i_t lo_ = *(const v4i_t*)(ap_ + m * 16 * KB + kt * 128), hi_ = *(const v4i_t*)(ap_ + m * 16 * KB + kt * 128 + 64); \
            dst[kt][m] = __builtin_shufflevector(lo_, hi_, 0, 1, 2, 3, 4, 5, 6, 7); } } while (0)
#define DN_LD8(P) __builtin_shufflevector(*(const LAS v4i_t*)(P), *(const LAS v4i_t*)((P) + 1024), 0, 1, 2, 3, 4, 5, 6, 7)
#define DN_TILE(kt, slot) do { v8i_t b8[8]; \
        _Pragma("unroll") for (int j = 0; j < 8; ++j) b8[j] = DN_LD8(lds + (slot) * HTB + boff + j * 2048); \
        __builtin_amdgcn_s_setprio(1); \
        _Pragma("unroll") for (int j = 0; j < 8; ++j) _Pragma("unroll") for (int m = 0; m < 2; ++m) \
            acc[m][j] = __builtin_amdgcn_mfma_scale_f32_16x16x128_f8f6f4(b8[j], a8[kt][m], acc[m][j], 0, 0, 0, g.sa, 0, 0x7f7f7f7f); \
        __builtin_amdgcn_s_setprio(0); } while (0)
    Unit cur, nxt, fut;
    if (!S.next(0, cur)) return;
    f32x4 acc[2][8];
#pragma unroll
    for (int m = 0; m < 2; ++m)
#pragma unroll
        for (int j = 0; j < 8; ++j) acc[m][j] = (f32x4){0.f, 0.f, 0.f, 0.f};
    v8i_t a8[2][2], a8n[2][2];
    constexpr size_t TB = (size_t)128 * KB;
#pragma unroll
    for (int v = 0; v < 3; ++v) { Unit uv; const bool ok = S.next(v, uv); const unsigned char* bp = g.Bt + (size_t)(ok ? uv.pn : cur.pn) * TB;
        DN_STAGE_B(2 * v, bp, 0); DN_STAGE_B(2 * v + 1, bp, 1); }
    DN_LOADA(a8, cur.pm);
#pragma unroll
    for (int kt = 0; kt < 2; ++kt)
#pragma unroll
        for (int m = 0; m < 2; ++m) a8n[kt][m] = a8[kt][m];
    bool has_next = S.next(1, nxt);
    for (int ui = 0;; ++ui) {
        asm volatile("s_waitcnt vmcnt(8) lgkmcnt(0)" ::: "memory");
        __builtin_amdgcn_s_barrier();
        __builtin_amdgcn_sched_barrier(0);
        { const bool okf = S.next(ui + 3, fut); const unsigned char* bp = g.Bt + (size_t)(okf ? fut.pn : cur.pn) * TB;
          const int s3 = (2 * ui + 6) & 7; DN_STAGE_B(s3, bp, 0); DN_STAGE_B(s3 + 1, bp, 1); }
        const bool sw = has_next && nxt.pm != cur.pm;
        if (sw) DN_LOADA(a8n, nxt.pm);
        __builtin_amdgcn_sched_barrier(0);
        const int s0 = (2 * ui) & 7;
        DN_TILE(0, s0);
        DN_TILE(1, s0 + 1);
        {
            int frr = fr, fqq = fq; asm volatile("" : "+v"(frr), "+v"(fqq));
            unsigned char* op = g.O + (size_t)((cur.pm - g.hh * HTILES) * 256 + 32 * wid + frr) * DM + cur.aux * 128 + 16 * fqq;
#pragma unroll
            for (int m = 0; m < 2; ++m)
#pragma unroll
                for (int hf = 0; hf < 2; ++hf) { u32x4 o;
#pragma unroll
                    for (int jj = 0; jj < 4; ++jj) { const f32x4 v = acc[m][4 * hf + jj]; o[jj] = pack_fp8x4(v[0], v[1], v[2], v[3]); }
                    *(u32x4*)(op + (size_t)m * 16 * DM + 64 * hf) = o; }
        }
        if (!has_next) break;
#pragma unroll
        for (int m = 0; m < 2; ++m)
#pragma unroll
            for (int j = 0; j < 8; ++j) acc[m][j] = (f32x4){0.f, 0.f, 0.f, 0.f};
        if (sw) {
#pragma unroll
            for (int kt = 0; kt < 2; ++kt)
#pragma unroll
                for (int m = 0; m < 2; ++m) a8[kt][m] = a8n[kt][m]; }
        cur = nxt; has_next = S.next(ui + 2, nxt);
    }
    asm volatile("s_waitcnt vmcnt(0)" ::: "memory");
    __builtin_amdgcn_s_barrier();
#undef DN_STAGE_B
#undef DN_LOADA
#undef DN_LD8
#undef DN_TILE
}
}


struct Frame {
    LAS unsigned char* lds;
    int tid, lane, wave, G, blk;
    const Params* p;
    unsigned char* ws;
};

DEVI float clamp_fp8(float x) { return __builtin_amdgcn_fmed3f(x, -440.f, 440.f); }
DEVI unsigned pack_fp8x4(float a, float b, float c, float d) { int p = __builtin_amdgcn_cvt_pk_fp8_f32(clamp_fp8(a), clamp_fp8(b), 0, false); p = __builtin_amdgcn_cvt_pk_fp8_f32(clamp_fp8(c), clamp_fp8(d), p, true); return (unsigned)p; }
template <class SrcF>
DEVI void transpose_item8(const SrcF& src, unsigned char* WT8, int K, int k0, int n0, LAS float* scr, int lane, float scale) {
#pragma unroll 8
    for (int i = 0; i < 32; ++i) { const int kk = 2 * i + (lane >> 5); scr[kk * 33 + (lane & 31)] = *src(k0 + kk, n0 + (lane & 31)); }
    LDS_WAIT(); asm volatile("" ::: "memory");
    const int n = lane >> 1, hf = lane & 1; const LAS float* sp = scr + (32 * hf) * 33 + n;
    u32x4 o0, o1;
#pragma unroll
    for (int q = 0; q < 4; ++q) { o0[q] = pack_fp8x4(sp[(4 * q) * 33] * scale, sp[(4 * q + 1) * 33] * scale, sp[(4 * q + 2) * 33] * scale, sp[(4 * q + 3) * 33] * scale);
        o1[q] = pack_fp8x4(sp[(16 + 4 * q) * 33] * scale, sp[(17 + 4 * q) * 33] * scale, sp[(18 + 4 * q) * 33] * scale, sp[(19 + 4 * q) * 33] * scale); }
    unsigned char* dst = WT8 + (size_t)(n0 + n) * K + k0 + 32 * hf;
    *(u32x4*)dst = o0; *(u32x4*)(dst + 16) = o1;
    LDS_WAIT(); asm volatile("" ::: "memory");
}
template <class SrcF>
DEVI void transpose_item(const SrcF& src, bf16_t* WT, int K, int k0, int n0, LAS float* scr, int lane) {
#pragma unroll 8
    for (int i = 0; i < 32; ++i) { const int kk = 2 * i + (lane >> 5); scr[kk * 33 + (lane & 31)] = *src(k0 + kk, n0 + (lane & 31)); }
    LDS_WAIT(); asm volatile("" ::: "memory");
    const int c = lane & 7;
#pragma unroll
    for (int j = 0; j < 4; ++j) { const int n = (lane >> 3) + 8 * j; const LAS float* s = scr + (8 * c) * 33 + n;
        u32x4 o; o.x = cvt_pk_bf16(s[0 * 33], s[1 * 33]); o.y = cvt_pk_bf16(s[2 * 33], s[3 * 33]); o.z = cvt_pk_bf16(s[4 * 33], s[5 * 33]); o.w = cvt_pk_bf16(s[6 * 33], s[7 * 33]);
        *(u32x4*)(WT + (size_t)(n0 + n) * K + k0 + 8 * c) = o; }
    LDS_WAIT(); asm volatile("" ::: "memory");
}
DEVI int win_src_col(int c) {
    const int sec = c >> 9, h = (c >> 7) & 3, s = c & 127;
    int ssec = sec;
    if (sec == 3) ssec = 4; else if (sec == 4) ssec = 5; else if (sec == 5) ssec = 6; else if (sec == 6) ssec = 3;
    int d = s;
    if (sec < 2) { const int wc = s >> 5, fq = (s >> 3) & 3, n = (s >> 2) & 1, i = s & 3; d = 64 * n + 16 * wc + 4 * fq + i; }
    return ssec * 512 + h * 128 + d;
}
struct SrcWin { const float* w; DEVI const float* operator()(int k, int n) const { return w + (size_t)k * INC + win_src_col(n); } };
struct SrcPlain { const float* w; int N; DEVI const float* operator()(int k, int n) const { return w + (size_t)k * N + n; } };
struct SrcGU { const float* wg; long dwu; DEVI const float* operator()(int k, int r) const {
        const int ff = 64 * (r >> 7) + 16 * ((r >> 5) & 3) + 4 * ((r >> 3) & 3) + (r & 3); const long sel = ((r >> 2) & 1) ? dwu : 0l; return wg + ((long)k * EFF + ff + sel); } };

DEVI void phase_prep(Frame& F) {
    const Params& P = *F.p;
    if (F.blk < 96) {
        LAS float* sc = (LAS float*)F.lds;
        LAS float* red = sc + 9 * 1024;
        for (int i = F.tid; i < 9 * 1024; i += NTHREADS) { const int v = i >> 10, k = i & 1023; const float cv = v < 8 ? P.in[I_C][v * DM + k] : P.in[I_CCTX][k]; sc[i] = cv / (1.f + __expf(-cv)); }
        __syncthreads();
        const int c = F.tid & 63, ks = F.tid >> 6, n = F.blk * 64 + c;
        float a[9];
#pragma unroll
        for (int v = 0; v < 9; ++v) a[v] = 0.f;
        const float* w = P.in[I_WMOD] + (size_t)(ks * 128) * 6144 + n;
#pragma unroll 16
        for (int k = 0; k < 128; ++k) { const float wv = w[(size_t)k * 6144];
#pragma unroll
            for (int v = 0; v < 9; ++v) a[v] += sc[v * 1024 + ks * 128 + k] * wv; }
#pragma unroll
        for (int v = 0; v < 9; ++v) red[(ks * 9 + v) * 64 + c] = a[v];
        __syncthreads();
        for (int i = F.tid; i < 9 * 64; i += NTHREADS) { const int v = i >> 6, cc = i & 63; float sum = P.in[I_BMOD][F.blk * 64 + cc];
#pragma unroll
            for (int q = 0; q < 8; ++q) sum += red[(q * 9 + v) * 64 + cc];
            ((float*)(F.ws + WS_MODP))[(size_t)v * 6144 + F.blk * 64 + cc] = sum; }
        __syncthreads();
    }
    for (int i = F.blk * NTHREADS + F.tid; i < 256 * 1024; i += F.G * NTHREADS) { const int r = i >> 10, k = i & 1023; bf16_t v = 0;
        if (r < 64) v = f2bf(P.in[I_WR][k * NE + r]);
        else if (r >= 128 && r < 192) { const float w = P.in[I_WR][k * NE + r - 128]; v = f2bf(w - bf2f(f2bf(w))); }
        ((bf16_t*)(F.ws + WS_WRT))[i] = v; }
    LAS float* scr = (LAS float*)(F.lds + 57344 + F.wave * 8704);
    const int gw = F.blk * NWAVES + F.wave, NGW = F.G * NWAVES;
    constexpr int I_IN = (DM / 64) * (PN / 32), I_OUT = (DM / 64) * (DM / 32);
    for (int it = gw; it < I_IN + I_OUT; it += NGW) {
        if (it < I_IN) { const int kb = it / (PN / 32), nb = it % (PN / 32); transpose_item(SrcWin{P.in[I_WIN]}, (bf16_t*)(F.ws + WS_WINT), DM, kb * 64, nb * 32, scr, F.lane); }
        else { const int r = it - I_IN, kb = r / (DM / 32), nb = r % (DM / 32); transpose_item(SrcPlain{P.in[I_WOUT], DM}, (bf16_t*)(F.ws + WS_WOUTT), DM, kb * 64, nb * 32, scr, F.lane); }
    }
}
DEVI float mod_value(Frame& F, int v, int n) { return ((const float*)(F.ws + WS_MODP))[(size_t)v * 6144 + n]; }

DEVI void phase_norm1(Frame& F) {
    const Params& P = *F.p;
    LAS float* WG = (LAS float*)F.lds;
    LAS float* MODS = (LAS float*)(F.lds + 65536);
    for (int i0 = 0; i0 < 16 * 1024; i0 += 8 * NTHREADS) { float tv[8];
#pragma unroll
        for (int q = 0; q < 8; ++q) { const int i = i0 + F.tid + q * NTHREADS; tv[q] = P.in[I_WIN][(size_t)(i >> 4) * INC + 4096 + (i & 15)]; }
#pragma unroll
        for (int q = 0; q < 8; ++q) { const int i = i0 + F.tid + q * NTHREADS; WG[(i & 15) * 1024 + (i >> 4)] = tv[q]; } }
    for (int i0 = 0; i0 < 9 * 2048; i0 += 12 * NTHREADS) { float tv[12];
#pragma unroll
        for (int q = 0; q < 12; ++q) { const int i = i0 + F.tid + q * NTHREADS; tv[q] = mod_value(F, i / 2048, i % 2048); }
#pragma unroll
        for (int q = 0; q < 12; ++q) { const int i = i0 + F.tid + q * NTHREADS; MODS[i] = (i % 2048) < 1024 ? tv[q] : 1.f + tv[q]; } }
    __syncthreads();
    const float* g0 = P.in[I_NORMG];
    f32x4 gv[4];
#pragma unroll
    for (int j = 0; j < 4; ++j) gv[j] = *(const f32x4*)(g0 + 256 * j + 4 * F.lane);
    float gb = 0.f; if (F.lane < 16) gb = P.in[I_GATEB][F.lane];
    f32x4 wreg[8][4];
#pragma unroll
    for (int gj = 0; gj < 8; ++gj)
#pragma unroll
        for (int j = 0; j < 4; ++j) wreg[gj][j] = *(const LAS f32x4*)(WG + gj * 1024 + 256 * j + 4 * F.lane);
    bf16_t* HL = (bf16_t*)(F.ws + WS_B); float* GT = (float*)(F.ws + WS_GATES);
    const int gw = F.blk * NWAVES + F.wave, NGW = F.G * NWAVES;
    f32x4 xn[4];
    if (gw < TT) { const float* xr = gw < T ? P.in[I_X] + (size_t)gw * DM : P.in[I_CTX] + (size_t)(gw - T) * DM;
#pragma unroll
        for (int j = 0; j < 4; ++j) xn[j] = *(const f32x4*)(xr + 256 * j + 4 * F.lane); }
    for (int row = gw; row < TT; row += NGW) {
        const int v = row < T ? (row >> 13) : 8;
        f32x4 x[4]; float ss = 0.f;
#pragma unroll
        for (int j = 0; j < 4; ++j) { x[j] = xn[j]; ss += x[j].x * x[j].x + x[j].y * x[j].y + x[j].z * x[j].z + x[j].w * x[j].w; }
        { const int nr = row + NGW; if (nr < TT) { const float* xr = nr < T ? P.in[I_X] + (size_t)nr * DM : P.in[I_CTX] + (size_t)(nr - T) * DM;
#pragma unroll
            for (int j = 0; j < 4; ++j) xn[j] = *(const f32x4*)(xr + 256 * j + 4 * F.lane); } }
        const float rstd = rsqrtf(wave_sum(ss) * (1.f / DM) + EPS);
        const LAS float* ms = MODS + v * 2048;
#pragma unroll
        for (int j = 0; j < 4; ++j) { const f32x4 sh = *(const LAS f32x4*)(ms + 256 * j + 4 * F.lane), sc = *(const LAS f32x4*)(ms + 1024 + 256 * j + 4 * F.lane);
            x[j] = (x[j] * rstd * gv[j]) * sc + sh;
            u32x2 o; o.x = cvt_pk_bf16(x[j].x, x[j].y); o.y = cvt_pk_bf16(x[j].z, x[j].w);
            *(u32x2*)(HL + (size_t)row * DM + 256 * j + 4 * F.lane) = o; }
        float ga[16];
#pragma unroll
        for (int gj = 0; gj < 16; ++gj) { f32x2 a2 = (f32x2){0.f, 0.f};
#pragma unroll
            for (int j = 0; j < 4; ++j) { f32x4 w; if (gj < 8) w = wreg[gj][j]; else w = *(const LAS f32x4*)(WG + gj * 1024 + 256 * j + 4 * F.lane);
                a2 = __builtin_elementwise_fma(x[j].lo, w.lo, a2); a2 = __builtin_elementwise_fma(x[j].hi, w.hi, a2); }
            ga[gj] = a2.x + a2.y; }
        float myg;
        {   const bool b0 = F.lane & 1, b1 = F.lane & 2, b2 = F.lane & 4, b3 = F.lane & 8;
            float g8[8], g4[4], g2[2];
#pragma unroll
            for (int j = 0; j < 8; ++j) g8[j] = (b0 ? ga[2 * j + 1] : ga[2 * j]) + dpp_x1(b0 ? ga[2 * j] : ga[2 * j + 1]);
#pragma unroll
            for (int j = 0; j < 4; ++j) g4[j] = (b1 ? g8[2 * j + 1] : g8[2 * j]) + dpp_x2(b1 ? g8[2 * j] : g8[2 * j + 1]);
#pragma unroll
            for (int j = 0; j < 2; ++j) g2[j] = (b2 ? g4[2 * j + 1] : g4[2 * j]) + dpp_x4(b2 ? g4[2 * j] : g4[2 * j + 1]);
            myg = (b3 ? g2[1] : g2[0]) + dpp_x8(b3 ? g2[0] : g2[1]);
            myg += __shfl_xor(myg, 16); myg += __shfl_xor(myg, 32); }
        if (F.lane < 16) GT[(size_t)row * 16 + F.lane] = myg + gb;
    }
}

struct SchedProj {
    int G, c;
    DEVI bool next(int i, pg8::Unit& u) const {
        const long L = (long)i * G + c;
        if (L < 4096) return pg8::static_unit(256, 16, L, u);
        const int j = (int)(L - 4096); if (j >= 64) return false;
        const int ct = j & 7; u.pm = 256 + (j >> 3); u.pn = (ct < 4 ? 2 + ct : 4 + ct); u.aux = 0; return true;
    }
    DEVI int arow(const pg8::Unit& u, int r) const { return u.pm * 256 + r; }
    static constexpr bool IDX_DMA = false; };
struct EpiProj {
    bf16_t* O;
    static constexpr bool PRE = false;
    DEVI void operator()(const f32x4 (&acc)[2][2][4][2], const pg8::Unit& u, int wr, int wc, int fr, int fq) const {
        const int row0 = u.pm * 256 + wr * 64 + fr, col0 = u.pn * 256 + wc * 32 + 8 * fq;
        const bool rope = (u.pn < 4) && (u.pm < 256);
        const float qs = (u.pn < 2) ? 0.08838834764831845f : 1.f;
        float f2[4];
#pragma unroll
        for (int i = 0; i < 4; ++i) f2[i] = exp2f(-(float)(16 * (wc & 1) + 4 * fq + i) * (13.287712379549449f / 32.f)) * 0.15915494309189535f;
#pragma unroll
        for (int ai = 0; ai < 2; ++ai)
#pragma unroll
            for (int m = 0; m < 4; ++m) {
                const int row = row0 + ai * 128 + m * 16; const int pos = row & (SEQ - 1);
                const float pp = (float)((wc < 2) ? (pos >> 6) : (pos & 63));
                float cs[4], sn[4];
                if (rope) {
#pragma unroll
                    for (int i = 0; i < 4; ++i) { const float rev = __builtin_amdgcn_fractf(pp * f2[i]); cs[i] = __builtin_amdgcn_cosf(rev); sn[i] = __builtin_amdgcn_sinf(rev); }
                }
                bf16_t* rowp = O + (size_t)row * PN + col0;
#pragma unroll
                for (int bj = 0; bj < 2; ++bj) { f32x4 v0 = acc[ai][bj][m][0], v1 = acc[ai][bj][m][1];
                    if (rope) {
#pragma unroll
                        for (int i = 0; i < 4; ++i) { const float t1 = v0[i], t2 = v1[i]; v0[i] = t1 * cs[i] - t2 * sn[i]; v1[i] = t2 * cs[i] + t1 * sn[i]; } }
                    v0 = v0 * qs; v1 = v1 * qs;
                    u32x4 w; w.x = cvt_pk_bf16(v0[0], v0[1]); w.y = cvt_pk_bf16(v0[2], v0[3]); w.z = cvt_pk_bf16(v1[0], v1[1]); w.w = cvt_pk_bf16(v1[2], v1[3]);
                    *(u32x4*)(rowp + bj * 128) = w; }
            }
    }
};
DEVI void phase_gemm_proj(Frame& F) {
    pg8::Gemm g{(const bf16_t*)(F.ws + WS_B), (const bf16_t*)(F.ws + WS_WINT), DM, DM};
    SchedProj S{F.G, F.blk}; EpiProj E{(bf16_t*)(F.ws + WS_PROJ)};
    pg8::gemm_phase(F.lds, g, S, E);
}

DEVI void phase_conv(Frame& F) {
    const Params& P = *F.p;
    const bf16_t* PR = (const bf16_t*)(F.ws + WS_PROJ); bf16_t* MQ = (bf16_t*)(F.ws + WS_B);
    const int cg = F.tid & 127, run = F.tid >> 7, c0 = cg * 8;
    float w0[8], w1[8], w2[8], bb[8];
#pragma unroll
    for (int i = 0; i < 8; ++i) { w0[i] = P.in[I_CONVW][c0 + i]; w1[i] = P.in[I_CONVW][1024 + c0 + i]; w2[i] = P.in[I_CONVW][2048 + c0 + i]; bb[i] = P.in[I_CONVB][c0 + i]; }
    const float osc = cg >= 64 ? 0.08838834764831845f : 1.f;
    for (int it = F.blk; it < TT / 64; it += F.G) {
        const int r0 = it * 64 + run * 16;
        const bool isctx = r0 >= T;
        if (isctx && cg < 64) continue;
        const int slen = isctx ? CTXL : SEQ, pos0 = isctx ? ((r0 - T) & (CTXL - 1)) : (r0 & (SEQ - 1));
        u32x4 prev = (u32x4){0u, 0u, 0u, 0u}, cur, nxt;
        if (pos0 > 0) prev = *(const u32x4*)(PR + (size_t)(r0 - 1) * PN + 1536 + c0);
        cur = *(const u32x4*)(PR + (size_t)r0 * PN + 1536 + c0);
        for (int t = 0; t < 16; ++t) {
            const int r = r0 + t;
            nxt = (u32x4){0u, 0u, 0u, 0u};
            if (pos0 + t + 1 < slen) nxt = *(const u32x4*)(PR + (size_t)(r + 1) * PN + 1536 + c0);
            float o[8];
#pragma unroll
            for (int q = 0; q < 4; ++q) {
                const float a0 = lo_bf(prev[q]), a1 = hi_bf(prev[q]), b0 = lo_bf(cur[q]), b1 = hi_bf(cur[q]), d0 = lo_bf(nxt[q]), d1 = hi_bf(nxt[q]);
                o[2 * q] = siluf_(w0[2 * q] * a0 + w1[2 * q] * b0 + w2[2 * q] * d0 + bb[2 * q]) * osc;
                o[2 * q + 1] = siluf_(w0[2 * q + 1] * a1 + w1[2 * q + 1] * b1 + w2[2 * q + 1] * d1 + bb[2 * q + 1]) * osc;
            }
            u32x4 w; w.x = cvt_pk_bf16(o[0], o[1]); w.y = cvt_pk_bf16(o[2], o[3]); w.z = cvt_pk_bf16(o[4], o[5]); w.w = cvt_pk_bf16(o[6], o[7]);
            *(u32x4*)(MQ + (size_t)r * DM + c0) = w;
            prev = cur; cur = nxt;
        }
    }
}

constexpr int LDT = 136;
constexpr int TILE_B = 128 * LDT * 2;
DEVI bf16x8 frag_rows(const LAS bf16_t* base, int row, int k) { return *(const LAS bf16x8*)(base + row * LDT + k); }
DEVI bf16x8 frag_cols(const LAS bf16_t* base, int k, int col) { bf16x8 v;
#pragma unroll
    for (int j = 0; j < 8; ++j) v[j] = (short)base[(k + j) * LDT + col];
    return v; }
DEVI void stage_tile(LAS bf16_t* dst, const bf16_t* src, size_t ld, int tid) {
#pragma unroll
    for (int i = 0; i < 4; ++i) { const int p = tid + NTHREADS * i, r = p >> 4, c = (p & 15) * 8; *(LAS u32x4*)(dst + r * LDT + c) = *(const u32x4*)(src + (size_t)r * ld + c); }
}
DEVI void stage_tile_scaled2(LAS bf16_t* d0, LAS bf16_t* d1, const LAS float* s0, const LAS float* s1, const bf16_t* src, size_t ld, int tid) {
#pragma unroll
    for (int i = 0; i < 4; ++i) { const int p = tid + NTHREADS * i, r = p >> 4, c = (p & 15) * 8; const u32x4 v = *(const u32x4*)(src + (size_t)r * ld + c);
        const float a = s0[r], b = s1[r]; u32x4 o0, o1;
#pragma unroll
        for (int q = 0; q < 4; ++q) { const float lo = lo_bf(v[q]), hi = hi_bf(v[q]); o0[q] = cvt_pk_bf16(lo * a, hi * a); o1[q] = cvt_pk_bf16(lo * b, hi * b); }
        *(LAS u32x4*)(d0 + r * LDT + c) = o0; *(LAS u32x4*)(d1 + r * LDT + c) = o1; }
}
typedef short v4i16_t __attribute__((ext_vector_type(4)));
DEVI bf16x8 frag_tr(const LAS bf16_t* base, int k, int c16, int fr) {
    const LAS bf16_t* p = base + (k + (fr >> 2)) * LDT + c16 + 4 * (fr & 3);
    const v4i16_t lo = __builtin_amdgcn_ds_read_tr16_b64_v4i16((LAS v4i16_t*)p), hi = __builtin_amdgcn_ds_read_tr16_b64_v4i16((LAS v4i16_t*)(p + 4 * LDT));
    return (bf16x8){lo[0], lo[1], lo[2], lo[3], hi[0], hi[1], hi[2], hi[3]};
}
template <bool MAXOP> DEVI float wave_incl_scan(float v, int lane) {
#pragma unroll
    for (int o = 1; o < 64; o <<= 1) { const float u = __shfl_up(v, o); if (lane >= o) v = MAXOP ? fmaxf(v, u) : v + u; }
    return v;
}
DEVI void mlstm_gates2(LAS float* vec, const float* GT, int row0, int h, int tid, int lane, int wave, float m_f, float m_b, bool need_mu) {
    const bool act = tid < 256, bw = tid >= 128; const int tau = bw ? 255 - tid : tid;
    float gi = 0.f, bsum = 0.f, a = 0.f, pm = 0.f;
    if (act) { const float* g = GT + (size_t)(row0 + tau) * 16; const float lf = logsigmoidf_(g[(bw ? 12 : 4) + h]); gi = g[(bw ? 8 : 0) + h];
        bsum = wave_incl_scan<false>(lf, lane); if (lane == 63) vec[3400 + wave] = bsum; }
    __syncthreads();
    if (act) { if (wave & 1) bsum += vec[3400 + wave - 1]; a = gi - bsum; vec[(bw ? 896 : 768) + tau] = bsum; vec[(bw ? 640 : 512) + tau] = a;
        pm = wave_incl_scan<true>(a, lane); if (lane == 63) vec[3404 + wave] = pm; }
    __syncthreads();
    if (act) { if (wave & 1) pm = fmaxf(pm, vec[3404 + wave - 1]);
        if (need_mu) vec[(bw ? 1408 : 1280) + tau] = fmaxf(bw ? m_b : m_f, pm);
        if (tid == 127) { vec[3410] = bsum; vec[3411] = pm; } if (tid == 255) { vec[3412] = bsum; vec[3413] = pm; } }
    __syncthreads();
}
DEVI void mlstm_gates3(LAS float* vec, float fg, float ig, int tid, int lane, int wave, float m_f, float m_b) {
    const bool act = tid < 256, bw = tid >= 128; const int tau = bw ? 255 - tid : tid;
    float bsum = 0.f, a = 0.f, pm = 0.f;
    if (act) { bsum = wave_incl_scan<false>(logsigmoidf_(fg), lane); if (lane == 63) vec[3400 + wave] = bsum; }
    __syncthreads();
    if (act) { if (wave & 1) bsum += vec[3400 + wave - 1]; a = ig - bsum; vec[(bw ? 896 : 768) + tau] = bsum; vec[(bw ? 640 : 512) + tau] = a;
        pm = wave_incl_scan<true>(a, lane); if (lane == 63) vec[3404 + wave] = pm; }
    __syncthreads();
    if (act) { if (wave & 1) pm = fmaxf(pm, vec[3404 + wave - 1]); vec[(bw ? 1408 : 1280) + tau] = fmaxf(bw ? m_b : m_f, pm);
        if (tid == 127) { vec[3410] = bsum; vec[3411] = pm; } if (tid == 255) { vec[3412] = bsum; vec[3413] = pm; } }
    __syncthreads();
}
DEVI void mlstm_chunk_gates(LAS float* vec, const float* GT, int row0, int h, int tid) {
    if (tid < 128) { const float* g = GT + (size_t)(row0 + tid) * 16;
        vec[tid] = logsigmoidf_(g[4 + h]); vec[128 + tid] = logsigmoidf_(g[12 + h]); vec[256 + tid] = g[h]; vec[384 + tid] = g[8 + h]; }
    __syncthreads();
    if (tid < 128) { float s = 0.f; for (int j = 0; j <= tid; ++j) s += vec[j]; vec[768 + tid] = s; vec[512 + tid] = vec[256 + tid] - s; }
    else if (tid < 256) { const int t = tid - 128; float s = 0.f; for (int j = 127; j >= t; --j) s += vec[128 + j]; vec[896 + t] = s; vec[640 + t] = vec[384 + t] - s; }
    __syncthreads();
}
DEVI size_t us_index(int ty, int b, int h, int dir, int slot) { return ((((size_t)(ty * 8 + b) * 4 + h) * 2 + dir) * NSLOT + slot) * 16384; }
DEVI size_t sm_index(int b, int h, int dir, int slot) { return (((size_t)b * 4 + h) * 2 + dir) * NSLOT + slot; }

DEVI void conv_tile_regs(u32x4 (&out)[4], const LAS bf16_t* Tl, const LAS bf16_t* halo, const float* cw, const float* cb, float oscale, int tid) {
    const int cc = (tid & 15) * 8;
    float w0[8], w1[8], w2[8], bb[8];
#pragma unroll
    for (int q = 0; q < 2; ++q) { const f32x4 a = *(const f32x4*)(cw + cc + 4 * q), b = *(const f32x4*)(cw + 1024 + cc + 4 * q), c = *(const f32x4*)(cw + 2048 + cc + 4 * q), d = *(const f32x4*)(cb + cc + 4 * q);
#pragma unroll
        for (int j = 0; j < 4; ++j) { w0[4 * q + j] = a[j]; w1[4 * q + j] = b[j]; w2[4 * q + j] = c[j]; bb[4 * q + j] = d[j]; } }
#pragma unroll
    for (int i = 0; i < 4; ++i) { const int r = (tid + NTHREADS * i) >> 4;
        const u32x4 cur = *(const LAS u32x4*)(Tl + r * LDT + cc);
        const LAS bf16_t* pp = r > 0 ? Tl + (r - 1) * LDT + cc : halo + cc; const LAS bf16_t* pn = r < 127 ? Tl + (r + 1) * LDT + cc : halo + 128 + cc;
        const u32x4 prev = *(const LAS u32x4*)pp, nxt = *(const LAS u32x4*)pn;
        float o[8];
#pragma unroll
        for (int q = 0; q < 4; ++q) {
            o[2 * q] = siluf_(w0[2 * q] * lo_bf(prev[q]) + w1[2 * q] * lo_bf(cur[q]) + w2[2 * q] * lo_bf(nxt[q]) + bb[2 * q]) * oscale;
            o[2 * q + 1] = siluf_(w0[2 * q + 1] * hi_bf(prev[q]) + w1[2 * q + 1] * hi_bf(cur[q]) + w2[2 * q + 1] * hi_bf(nxt[q]) + bb[2 * q + 1]) * oscale; }
        out[i].x = cvt_pk_bf16(o[0], o[1]); out[i].y = cvt_pk_bf16(o[2], o[3]); out[i].z = cvt_pk_bf16(o[4], o[5]); out[i].w = cvt_pk_bf16(o[6], o[7]); }
}

DEVI void phase_chunk_u(Frame& F) {
    const Params& P = *F.p;
    LAS bf16_t* Vs = (LAS bf16_t*)F.lds; LAS bf16_t* Kf = (LAS bf16_t*)(F.lds + TILE_B); LAS bf16_t* Kb = (LAS bf16_t*)(F.lds + 2 * TILE_B);
    LAS float* vec = (LAS float*)(F.lds + 3 * TILE_B);
    const bf16_t* PR = (const bf16_t*)(F.ws + WS_PROJ); const float* GT = (const float*)(F.ws + WS_GATES);
    bf16_t* US = (bf16_t*)(F.ws + WS_US);
    const int wr0 = F.wave >> 1, wc0 = F.wave & 1, fr0 = F.lane & 15, fq0 = F.lane >> 4;
    constexpr int NIT4 = 2 * 8 * 4 * NSLOT;
    u32x4 kreg[4], vreg[4], kcur[4], vcur[4], phalo = (u32x4){0u, 0u, 0u, 0u}; float pfg = 0.f, pig = 0.f;
    LAS bf16_t* HL = (LAS bf16_t*)(vec + 2432);
#define P4_ISSUE(IT) do { const int slot_ = (IT) % NSLOT, h_ = ((IT) / NSLOT) & 3, b_ = ((IT) / (NSLOT * 4)) & 7, ty_ = (IT) / (NSLOT * 32); \
        const int row0_ = slot_ < NCC ? T + b_ * CTXL + slot_ * CH : b_ * SEQ + (slot_ - NCC) * CH; \
        const bf16_t* ks_ = PR + (size_t)row0_ * PN + (ty_ == 0 ? 512 : 2048) + h_ * 128; const size_t kl_ = PN; \
        if (ty_ == 1 && F.tid < 32) { const int wh_ = F.tid >> 4; const int sl_ = slot_ < NCC ? slot_ : slot_ - NCC, ns_ = slot_ < NCC ? NCC : NCH; \
            const bool ok_ = wh_ ? (sl_ + 1 < ns_) : (sl_ > 0); phalo = (u32x4){0u, 0u, 0u, 0u}; \
            if (ok_) phalo = *(const u32x4*)(ks_ + (long)(wh_ ? 128 : -1) * (long)PN + (F.tid & 15) * 8); } \
        const bf16_t* vs_ = PR + (size_t)row0_ * PN + (ty_ == 0 ? 1024 : 2560) + h_ * 128; \
        _Pragma("unroll") for (int i = 0; i < 4; ++i) { const int p = F.tid + NTHREADS * i, r = p >> 4, c = (p & 15) * 8; kreg[i] = *(const u32x4*)(ks_ + (size_t)r * kl_ + c); vreg[i] = *(const u32x4*)(vs_ + (size_t)r * PN + c); } \
        if (ty_ == 1 && F.tid < 256) { const int bw_ = F.tid >> 7, tau_ = bw_ ? 255 - F.tid : F.tid; const float* g_ = GT + (size_t)(row0_ + tau_) * 16; pfg = g_[(bw_ ? 12 : 4) + h_]; pig = g_[(bw_ ? 8 : 0) + h_]; } } while (0)
    if (F.blk < NIT4) P4_ISSUE(F.blk);
    for (int it = F.blk; it < NIT4; it += F.G) {
        const int slot = it % NSLOT, h = (it / NSLOT) & 3, b = (it / (NSLOT * 4)) & 7, ty = it / (NSLOT * 32);
        int fr = fr0, fq = fq0, wr = wr0, wc = wc0;
        asm volatile("" : "+v"(fr), "+v"(fq), "+s"(wr), "+s"(wc));
        __syncthreads();
#pragma unroll
        for (int i = 0; i < 4; ++i) { kcur[i] = kreg[i]; vcur[i] = vreg[i]; }
        const float cfg = pfg, cig = pig; const u32x4 chalo = phalo;
        if (it + F.G < NIT4) P4_ISSUE(it + F.G);
        if (ty == 1) {
#pragma unroll
            for (int i = 0; i < 4; ++i) { const int p = F.tid + NTHREADS * i, r = p >> 4, c = (p & 15) * 8; *(LAS u32x4*)(Kf + r * LDT + c) = kcur[i]; }
            if (F.tid < 32) *(LAS u32x4*)(HL + (F.tid >> 4) * 128 + (F.tid & 15) * 8) = chalo;
            __syncthreads();
            conv_tile_regs(kcur, Kf, HL, P.in[I_CONVW] + 512 + h * 128, P.in[I_CONVB] + 512 + h * 128, 0.08838834764831845f, F.tid);
        }
        if (ty == 0) {
            const float lf = -expf(P.in[I_RDEC][h]) * 1.4426950408889634f, lb = -expf(P.in[I_RDEC][4 + h]) * 1.4426950408889634f;
            if (F.tid < 128) { vec[1024 + F.tid] = exp2f((float)(127 - F.tid) * lf); vec[1152 + F.tid] = exp2f((float)F.tid * lb); }
        } else {
            mlstm_gates3(vec, cfg, cig, F.tid, F.lane, F.wave, 0.f, 0.f);
            const float mf = vec[3411], mb = vec[3413];
            if (F.tid < 128) { vec[1024 + F.tid] = __expf(vec[512 + F.tid] - mf); vec[1152 + F.tid] = __expf(vec[640 + F.tid] - mb); }
            if (F.tid == 0) { float* chs = (float*)(F.ws + WS_CHS);
                chs[sm_index(b, h, 0, slot) * 2 + 0] = vec[3410]; chs[sm_index(b, h, 0, slot) * 2 + 1] = mf;
                chs[sm_index(b, h, 1, slot) * 2 + 0] = vec[3412]; chs[sm_index(b, h, 1, slot) * 2 + 1] = mb; }
        }
        __syncthreads();
#pragma unroll
        for (int i = 0; i < 4; ++i) { const int p = F.tid + NTHREADS * i, r = p >> 4, c = (p & 15) * 8;
            *(LAS u32x4*)(Vs + r * LDT + c) = vcur[i];
            const float wa = vec[1024 + r], wb = vec[1152 + r]; u32x4 o0, o1;
#pragma unroll
            for (int q = 0; q < 4; ++q) { const float lo = lo_bf(kcur[i][q]), hi = hi_bf(kcur[i][q]); o0[q] = cvt_pk_bf16(lo * wa, hi * wa); o1[q] = cvt_pk_bf16(lo * wb, hi * wb); }
            *(LAS u32x4*)(Kf + r * LDT + c) = o0; *(LAS u32x4*)(Kb + r * LDT + c) = o1; }
        __syncthreads();
        f32x4 af[2][4], ab[2][4];
#pragma unroll
        for (int m = 0; m < 2; ++m)
#pragma unroll
            for (int n = 0; n < 4; ++n) { af[m][n] = (f32x4){0.f, 0.f, 0.f, 0.f}; ab[m][n] = (f32x4){0.f, 0.f, 0.f, 0.f}; }
#pragma unroll 1
        for (int ks = 0; ks < 4; ++ks) {
            bf16x8 kf2[2], kb2[2];
#pragma unroll
            for (int m = 0; m < 2; ++m) { kf2[m] = frag_tr(Kf, ks * 32 + 8 * fq, 32 * wr + 16 * m, fr); kb2[m] = frag_tr(Kb, ks * 32 + 8 * fq, 32 * wr + 16 * m, fr); }
#pragma unroll
            for (int n = 0; n < 4; ++n) { const bf16x8 bv = frag_tr(Vs, ks * 32 + 8 * fq, 64 * wc + 16 * n, fr);
#pragma unroll
                for (int m = 0; m < 2; ++m) { af[m][n] = __builtin_amdgcn_mfma_f32_16x16x32_bf16(kf2[m], bv, af[m][n], 0, 0, 0); ab[m][n] = __builtin_amdgcn_mfma_f32_16x16x32_bf16(kb2[m], bv, ab[m][n], 0, 0, 0); } }
        }
        if (ty == 1 && F.tid < 256) {
            const int dir = F.tid >> 7, d = F.tid & 127; const LAS bf16_t* kk = dir ? Kb : Kf; float s = 0.f;
#pragma unroll 8
            for (int t = 0; t < 128; ++t) s += bf2f(kk[t * LDT + d]);
            ((float*)(F.ws + WS_UN))[sm_index(b, h, dir, slot) * 128 + d] = s;
        }
        __syncthreads();
#pragma unroll
        for (int m = 0; m < 2; ++m)
#pragma unroll
            for (int n = 0; n < 4; ++n) { const int e = 64 * wc + 16 * n + fr, d0 = 32 * wr + 16 * m + 4 * fq;
                u32x2 o; o.x = cvt_pk_bf16(af[m][n][0], af[m][n][1]); o.y = cvt_pk_bf16(af[m][n][2], af[m][n][3]); *(LAS u32x2*)(Kf + e * LDT + d0) = o;
                o.x = cvt_pk_bf16(ab[m][n][0], ab[m][n][1]); o.y = cvt_pk_bf16(ab[m][n][2], ab[m][n][3]); *(LAS u32x2*)(Kb + e * LDT + d0) = o; }
        __syncthreads();
        bf16_t* uf = US + us_index(ty, b, h, 0, slot); bf16_t* ub = US + us_index(ty, b, h, 1, slot);
#pragma unroll
        for (int i = 0; i < 4; ++i) { const int p = F.tid + NTHREADS * i, r = p >> 4, c = (p & 15) * 8;
            *(u32x4*)(uf + r * 128 + c) = *(const LAS u32x4*)(Kf + r * LDT + c); *(u32x4*)(ub + r * 128 + c) = *(const LAS u32x4*)(Kb + r * LDT + c); }
    }
#undef P4_ISSUE
}

DEVI int scan_slot(int dir, int s) { return dir == 0 ? s : (s < NCC ? (NCC - 1 - s) : (NSLOT - 1 - (s - NCC))); }
DEVI void phase_scan_states(Frame& F) {
    const Params& P = *F.p;
    bf16_t* US = (bf16_t*)(F.ws + WS_US);
    for (int it = F.blk; it < 256; it += F.G) {
        const int half = it & 1, chain = it >> 1, dir = chain & 1, h = (chain >> 1) & 3, b = (chain >> 3) & 7, ty = chain >> 6;
        bf16_t* base = US + us_index(ty, b, h, dir, 0) + half * 8192 + F.tid * 16;
        float st[16];
#pragma unroll
        for (int i = 0; i < 16; ++i) st[i] = 0.f;
        float m = 0.f, nst = 0.f;
        const float gdec = ty == 0 ? expf(-expf(P.in[I_RDEC][dir * 4 + h]) * 128.f) : 0.f;
        const float* chs = (const float*)(F.ws + WS_CHS) + sm_index(b, h, dir, 0) * 2;
        float* smv = (float*)(F.ws + WS_SM) + sm_index(b, h, dir, 0);
        float* un = (float*)(F.ws + WS_UN) + sm_index(b, h, dir, 0) * 128;
        const bool do_n = (ty == 1) && half == 0 && F.tid < 128;
        u32x4 q0[6], q1[6];
#pragma unroll
        for (int j = 0; j < 6; ++j) { const bf16_t* p = base + (size_t)scan_slot(dir, j) * 16384; q0[j] = *(const u32x4*)p; q1[j] = *(const u32x4*)(p + 8); }
        for (int s3 = 0; s3 < NSLOT; s3 += 6) {
#pragma unroll
            for (int j = 0; j < 6; ++j) {
                const int s = s3 + j; const int slot = scan_slot(dir, s);
                bf16_t* p = base + (size_t)slot * 16384;
                const u32x4 u0 = q0[j], u1 = q1[j];
                if (s + 6 < NSLOT) { const bf16_t* pn = base + (size_t)scan_slot(dir, s + 6) * 16384; q0[j] = *(const u32x4*)pn; q1[j] = *(const u32x4*)(pn + 8); }
                float dec = gdec, du = 1.f;
                if (ty == 1) { const float btot = chs[slot * 2], amax = chs[slot * 2 + 1]; const float mloc = btot + amax, mn = fmaxf(btot + m, mloc);
                    dec = __expf(btot + m - mn); du = __expf(mloc - mn);
                    if (half == 0 && F.tid == 0 && slot >= NCC) smv[slot] = m;
                    m = mn; }
                if (slot >= NCC) { u32x4 o0, o1;
#pragma unroll
                    for (int q = 0; q < 4; ++q) { o0[q] = cvt_pk_bf16(st[2 * q], st[2 * q + 1]); o1[q] = cvt_pk_bf16(st[8 + 2 * q], st[8 + 2 * q + 1]); }
                    *(u32x4*)p = o0; *(u32x4*)(p + 8) = o1; }
#pragma unroll
                for (int q = 0; q < 4; ++q) { st[2 * q] = dec * st[2 * q] + du * lo_bf(u0[q]); st[2 * q + 1] = dec * st[2 * q + 1] + du * hi_bf(u0[q]);
                    st[8 + 2 * q] = dec * st[8 + 2 * q] + du * lo_bf(u1[q]); st[8 + 2 * q + 1] = dec * st[8 + 2 * q + 1] + du * hi_bf(u1[q]); }
                if (do_n) { const float uv = un[slot * 128 + F.tid]; if (slot >= NCC) un[slot * 128 + F.tid] = nst; nst = dec * nst + du * uv; }
            }
        }
    }
}

DEVI void phase_chunk_out(Frame& F) {
    const Params& P = *F.p;
    LAS bf16_t* Qs = (LAS bf16_t*)F.lds; LAS bf16_t* R1 = (LAS bf16_t*)(F.lds + TILE_B); LAS bf16_t* Vs = (LAS bf16_t*)(F.lds + 2 * TILE_B); LAS bf16_t* R3 = (LAS bf16_t*)(F.lds + 3 * TILE_B);
    LAS float* Ot = (LAS float*)F.lds; constexpr int LDO = 132;
    LAS float* vec = (LAS float*)(F.lds + 4 * TILE_B);
    bf16_t* PR = (bf16_t*)(F.ws + WS_PROJ); const float* GT = (const float*)(F.ws + WS_GATES);
    const bf16_t* US = (const bf16_t*)(F.ws + WS_US);
    const int wr0 = F.wave >> 1, wc0 = F.wave & 1, fr0 = F.lane & 15, fq0 = F.lane >> 4, w0 = F.wave;
    u32x4 qreg[4], kreg[4], vreg[4], phalo = (u32x4){0u, 0u, 0u, 0u}; float pfg = 0.f, pig = 0.f, pnv = 0.f, pmf = 0.f, pmb = 0.f;
    LAS bf16_t* HL = (LAS bf16_t*)(vec + 2432);
#define P6_ISSUE(JJ) do { const int rt_ = F.blk + ((JJ) >> 4) * F.G, kk_ = (JJ) & 15; const int c_ = 2 * (rt_ & 31) + (kk_ & 1), h_ = (kk_ >> 1) & 3, b_ = rt_ >> 5, ty_ = kk_ >> 3; const int row0_ = b_ * SEQ + c_ * CH, slot_ = NCC + c_; \
        const bf16_t* qs_ = PR + (size_t)row0_ * PN + (ty_ == 0 ? 0 : 1536) + h_ * 128; const size_t ql_ = PN; \
        if (ty_ == 1 && tidv < 64) { const int tl_ = tidv >> 5, wh_ = (tidv >> 4) & 1; const bool ok_ = wh_ ? (c_ + 1 < NCH) : (c_ > 0); phalo = (u32x4){0u, 0u, 0u, 0u}; \
            if (ok_) phalo = *(const u32x4*)(qs_ + tl_ * 512 + (long)(wh_ ? 128 : -1) * (long)PN + (tidv & 15) * 8); } \
        const bf16_t* vs_ = PR + (size_t)row0_ * PN + (ty_ == 0 ? 1024 : 2560) + h_ * 128; \
        _Pragma("unroll") for (int i = 0; i < 4; ++i) { const int p = tidv + NTHREADS * i, r = p >> 4, cc = (p & 15) * 8; \
            qreg[i] = *(const u32x4*)(qs_ + (size_t)r * ql_ + cc); kreg[i] = *(const u32x4*)(qs_ + 512 + (size_t)r * ql_ + cc); vreg[i] = *(const u32x4*)(vs_ + (size_t)r * PN + cc); } \
        if (ty_ == 1) { pmf = ((const float*)(F.ws + WS_SM))[sm_index(b_, h_, 0, slot_)]; pmb = ((const float*)(F.ws + WS_SM))[sm_index(b_, h_, 1, slot_)]; \
            if (tidv < 256) { const int bw_ = tidv >> 7, tau_ = bw_ ? 255 - tidv : tidv; const float* g_ = GT + (size_t)(row0_ + tau_) * 16; \
                pfg = g_[(bw_ ? 12 : 4) + h_]; pig = g_[(bw_ ? 8 : 0) + h_]; pnv = ((const float*)(F.ws + WS_UN))[sm_index(b_, h_, bw_, slot_) * 128 + (tidv & 127)]; } } } while (0)
    int tidv = F.tid;
    const int njj = F.blk < T / 256 ? 16 * ((T / 256 - 1 - F.blk) / F.G + 1) : 0;
    if (njj > 0) P6_ISSUE(0);
    for (int jj = 0; jj < njj; ++jj) {
        const int rt = F.blk + (jj >> 4) * F.G, kk = jj & 15;
        const int c = 2 * (rt & 31) + (kk & 1), h = (kk >> 1) & 3, b = rt >> 5, ty = kk >> 3;
        const int row0 = b * SEQ + c * CH, slot = NCC + c;
        int fr = fr0, fq = fq0, wr = wr0, wc = wc0, wv = w0;
        tidv = F.tid;
        asm volatile("" : "+v"(fr), "+v"(fq), "+v"(tidv), "+s"(wr), "+s"(wc), "+s"(wv));
        __syncthreads();
#pragma unroll
        for (int i = 0; i < 4; ++i) { const int p = tidv + NTHREADS * i, r = p >> 4, cc = (p & 15) * 8;
            *(LAS u32x4*)(Qs + r * LDT + cc) = qreg[i]; *(LAS u32x4*)(R1 + r * LDT + cc) = kreg[i]; *(LAS u32x4*)(Vs + r * LDT + cc) = vreg[i]; }
        const float m_f = pmf, m_b = pmb;
        if (ty == 1) {
            if (tidv < 64) *(LAS u32x4*)(HL + (tidv >> 4) * 128 + (tidv & 15) * 8) = phalo;
            __syncthreads();
            u32x4 cq[4], ck[4];
            conv_tile_regs(cq, Qs, HL, P.in[I_CONVW] + h * 128, P.in[I_CONVB] + h * 128, 1.f, tidv);
            conv_tile_regs(ck, R1, HL + 256, P.in[I_CONVW] + 512 + h * 128, P.in[I_CONVB] + 512 + h * 128, 0.08838834764831845f, tidv);
            __syncthreads();
#pragma unroll
            for (int i = 0; i < 4; ++i) { const int p = tidv + NTHREADS * i, r = p >> 4, cc = (p & 15) * 8; *(LAS u32x4*)(Qs + r * LDT + cc) = cq[i]; *(LAS u32x4*)(R1 + r * LDT + cc) = ck[i]; }
        }
        const bf16_t* sfp = US + us_index(ty, b, h, 0, slot); const bf16_t* sbp = US + us_index(ty, b, h, 1, slot);
        u32x4 s0[4], s1[4];
#pragma unroll
        for (int i = 0; i < 4; ++i) { const int p = tidv + NTHREADS * i, r = p >> 4, cc = (p & 15) * 8; s0[i] = *(const u32x4*)(sfp + r * 128 + cc); s1[i] = *(const u32x4*)(sbp + r * 128 + cc); }
        float lgf = 0.f, lgb = 0.f;
        if (ty == 0) {
            lgf = -expf(P.in[I_RDEC][h]) * 1.4426950408889634f; lgb = -expf(P.in[I_RDEC][4 + h]) * 1.4426950408889634f;
            if (tidv < 128) { vec[1024 + tidv] = __builtin_amdgcn_exp2f((float)(tidv + 1) * lgf); vec[1152 + tidv] = __builtin_amdgcn_exp2f((float)(128 - tidv) * lgb); }
            __syncthreads();
        } else {
            if (tidv < 256) vec[1792 + tidv] = pnv;
            mlstm_gates3(vec, pfg, pig, tidv, F.lane, F.wave, m_f, m_b);
            {
                const int t = tidv >> 2, qq = tidv & 3; float sf = 0.f, sb = 0.f;
#pragma unroll 4
                for (int d = qq * 32; d < qq * 32 + 32; d += 2) { const unsigned qv = *(const LAS unsigned*)(Qs + t * LDT + d); const float q0 = lo_bf(qv), q1 = hi_bf(qv);
                    sf += q0 * vec[1792 + d] + q1 * vec[1792 + d + 1]; sb += q0 * vec[1920 + d] + q1 * vec[1920 + d + 1]; }
                sf = quad_sum(sf); sb = quad_sum(sb);
                if (qq == 0) { vec[2048 + t] = sf; vec[2176 + t] = sb; }
            }
        }
        f32x4 g[8];
#pragma unroll
        for (int m = 0; m < 8; ++m) g[m] = (f32x4){0.f, 0.f, 0.f, 0.f};
#pragma unroll 1
        for (int ks = 0; ks < 4; ++ks) {
            const bf16x8 bq = frag_rows(Qs, 16 * wv + fr, ks * 32 + 8 * fq);
#pragma unroll
            for (int m = 0; m < 8; ++m) { const bf16x8 ak = frag_rows(R1, 16 * m + fr, ks * 32 + 8 * fq); g[m] = __builtin_amdgcn_mfma_f32_16x16x32_bf16(ak, bq, g[m], 0, 0, 0); }
        }
        __syncthreads();
        {
            const int t = 16 * wv + fr;
            if (ty == 0) {
#pragma unroll
                for (int m = 0; m < 8; ++m) { float pv[4];
                    if (m < wv) {
#pragma unroll
                        for (int r = 0; r < 4; ++r) pv[r] = g[m][r] * __builtin_amdgcn_exp2f((float)(t - (16 * m + 4 * fq + r)) * lgf);
                    } else if (m > wv) {
#pragma unroll
                        for (int r = 0; r < 4; ++r) pv[r] = g[m][r] * __builtin_amdgcn_exp2f((float)((16 * m + 4 * fq + r) - t) * lgb);
                    } else {
#pragma unroll
                        for (int r = 0; r < 4; ++r) { const int dl = t - (16 * m + 4 * fq + r);
                            const float w = dl > 0 ? __builtin_amdgcn_exp2f((float)dl * lgf) : (dl < 0 ? __builtin_amdgcn_exp2f((float)(-dl) * lgb) : 2.f); pv[r] = g[m][r] * w; }
                    }
                    u32x2 o; o.x = cvt_pk_bf16(pv[0], pv[1]); o.y = cvt_pk_bf16(pv[2], pv[3]); *(LAS u32x2*)(R1 + t * LDT + 16 * m + 4 * fq) = o; }
            } else {
                const float muf = vec[1280 + t], mub = vec[1408 + t]; float rsf = 0.f, rsb = 0.f;
                f32x4 sb4[8];
#pragma unroll
                for (int m = 0; m < 8; ++m) {
                    if (m < wv) {
                        const f32x4 av = *(const LAS f32x4*)(vec + 512 + 16 * m + 4 * fq);
#pragma unroll
                        for (int r = 0; r < 4; ++r) { const float sf = g[m][r] * __expf(av[r] - muf); g[m][r] = sf; rsf += sf; }
                        sb4[m] = (f32x4){0.f, 0.f, 0.f, 0.f};
                    } else if (m > wv) {
                        const f32x4 bv = *(const LAS f32x4*)(vec + 640 + 16 * m + 4 * fq);
#pragma unroll
                        for (int r = 0; r < 4; ++r) { const float sb = g[m][r] * __expf(bv[r] - mub); sb4[m][r] = sb; rsb += sb; }
                        g[m] = (f32x4){0.f, 0.f, 0.f, 0.f};
                    } else {
                        const f32x4 av = *(const LAS f32x4*)(vec + 512 + 16 * m + 4 * fq), bv = *(const LAS f32x4*)(vec + 640 + 16 * m + 4 * fq);
#pragma unroll
                        for (int r = 0; r < 4; ++r) { const int tp = 16 * m + 4 * fq + r; const float gv = g[m][r];
                            const float sf = tp <= t ? gv * __expf(av[r] - muf) : 0.f, sb = tp >= t ? gv * __expf(bv[r] - mub) : 0.f;
                            g[m][r] = sf; sb4[m][r] = sb; rsf += sf; rsb += sb; }
                    } }
                rsf += __shfl_xor(rsf, 16); rsf += __shfl_xor(rsf, 32); rsb += __shfl_xor(rsb, 16); rsb += __shfl_xor(rsb, 32);
                const float interf = __expf(m_f - muf), interb = __expf(m_b - mub);
                const float denf = rsf + interf * vec[2048 + t], denb = rsb + interb * vec[2176 + t];
                const float rDf = __builtin_amdgcn_rcpf(fmaxf(fabsf(denf), __expf(-(vec[768 + t] + muf)))), rDb = __builtin_amdgcn_rcpf(fmaxf(fabsf(denb), __expf(-(vec[896 + t] + mub))));
                if (fq == 0) { vec[1024 + t] = interf * rDf; vec[1152 + t] = interb * rDb; }
#pragma unroll
                for (int m = 0; m < 8; ++m) { const f32x4 pv = g[m] * rDf + sb4[m] * rDb;
                    u32x2 o; o.x = cvt_pk_bf16(pv[0], pv[1]); o.y = cvt_pk_bf16(pv[2], pv[3]); *(LAS u32x2*)(R1 + t * LDT + 16 * m + 4 * fq) = o; }
            }
        }
        f32x4 o1[2][4];
        {
            f32x4 o2[2][4], o3[2][4];
#pragma unroll
            for (int m = 0; m < 2; ++m)
#pragma unroll
                for (int n = 0; n < 4; ++n) { o2[m][n] = (f32x4){0.f, 0.f, 0.f, 0.f}; o3[m][n] = (f32x4){0.f, 0.f, 0.f, 0.f}; }
#define P6_QS(ACC) do { _Pragma("unroll 1") for (int ks = 0; ks < 4; ++ks) { bf16x8 aq[2]; \
                _Pragma("unroll") for (int m = 0; m < 2; ++m) aq[m] = frag_rows(Qs, 32 * wr + 16 * m + fr, ks * 32 + 8 * fq); \
                _Pragma("unroll") for (int n = 0; n < 4; ++n) { const bf16x8 bs = frag_rows(R3, 64 * wc + 16 * n + fr, ks * 32 + 8 * fq); \
                    _Pragma("unroll") for (int m = 0; m < 2; ++m) ACC[m][n] = __builtin_amdgcn_mfma_f32_16x16x32_bf16(aq[m], bs, ACC[m][n], 0, 0, 0); } } } while (0)
#pragma unroll
            for (int i = 0; i < 4; ++i) { const int p = tidv + NTHREADS * i, r = p >> 4, cc = (p & 15) * 8; *(LAS u32x4*)(R3 + r * LDT + cc) = s0[i]; }
            __syncthreads();
            P6_QS(o2);
            __syncthreads();
#pragma unroll
            for (int i = 0; i < 4; ++i) { const int p = tidv + NTHREADS * i, r = p >> 4, cc = (p & 15) * 8; *(LAS u32x4*)(R3 + r * LDT + cc) = s1[i]; }
            __syncthreads();
            P6_QS(o3);
#pragma unroll
            for (int m = 0; m < 2; ++m)
#pragma unroll
                for (int r = 0; r < 4; ++r) { const int t = 32 * wr + 16 * m + 4 * fq + r; const float cf = vec[1024 + t], cb = vec[1152 + t];
#pragma unroll
                    for (int n = 0; n < 4; ++n) o1[m][n][r] = cf * o2[m][n][r] + cb * o3[m][n][r]; }
        }
        const float* gain = (ty == 0 ? P.in[I_RNG] : P.in[I_MNG]) + h * 128;
        bf16_t* obase = PR + (size_t)row0 * PN + 3072 + ty * 512 + h * 128;
        u32x4 gt[4];
#pragma unroll
        for (int i = 0; i < 4; ++i) { const int p = tidv + NTHREADS * i, r = p >> 4, cc = (p & 15) * 8; gt[i] = *(const u32x4*)(obase + (size_t)r * PN + cc); }
        if (jj + 1 < njj) P6_ISSUE(jj + 1);
#pragma unroll 1
        for (int ks = 0; ks < 4; ++ks) {
            bf16x8 ap[2];
#pragma unroll
            for (int m = 0; m < 2; ++m) ap[m] = frag_rows(R1, 32 * wr + 16 * m + fr, ks * 32 + 8 * fq);
#pragma unroll
            for (int n = 0; n < 4; ++n) { const bf16x8 bv = frag_tr(Vs, ks * 32 + 8 * fq, 64 * wc + 16 * n, fr);
#pragma unroll
                for (int m = 0; m < 2; ++m) o1[m][n] = __builtin_amdgcn_mfma_f32_16x16x32_bf16(ap[m], bv, o1[m][n], 0, 0, 0); }
        }
        __syncthreads();
#pragma unroll
        for (int m = 0; m < 2; ++m)
#pragma unroll
            for (int n = 0; n < 4; ++n)
#pragma unroll
                for (int r = 0; r < 4; ++r) Ot[(32 * wr + 16 * m + 4 * fq + r) * LDO + 64 * wc + 16 * n + fr] = o1[m][n][r];
        __syncthreads();
#pragma unroll
        for (int i = 0; i < 4; ++i) { const int p = tidv + NTHREADS * i, r = p >> 4, cc = (p & 15) * 8;
            const f32x4 a0 = *(const LAS f32x4*)(Ot + r * LDO + cc), a1 = *(const LAS f32x4*)(Ot + r * LDO + cc + 4);
            float sm = (a0.x + a0.y) + (a0.z + a0.w) + (a1.x + a1.y) + (a1.z + a1.w);
            float sq = (a0.x * a0.x + a0.y * a0.y) + (a0.z * a0.z + a0.w * a0.w) + (a1.x * a1.x + a1.y * a1.y) + (a1.z * a1.z + a1.w * a1.w);
            sm = row16_sum(sm); sq = row16_sum(sq);
            const float mean = sm * (1.f / 128.f), rstd = __builtin_amdgcn_rsqf(fmaxf(sq * (1.f / 128.f) - mean * mean, 0.f) + EPS);
            const f32x4 g0 = *(const f32x4*)(gain + cc), g1 = *(const f32x4*)(gain + cc + 4);
            float y[8]; const float av[8] = {a0.x, a0.y, a0.z, a0.w, a1.x, a1.y, a1.z, a1.w}; const float gn[8] = {g0.x, g0.y, g0.z, g0.w, g1.x, g1.y, g1.z, g1.w};
#pragma unroll
            for (int q = 0; q < 4; ++q) { const float t0 = lo_bf(gt[i][q]), t1 = hi_bf(gt[i][q]);
                const float c0 = ty == 0 ? siluf_(t0) : sigmoidf_(t0), c1 = ty == 0 ? siluf_(t1) : sigmoidf_(t1);
                y[2 * q] = (av[2 * q] - mean) * rstd * gn[2 * q] * c0; y[2 * q + 1] = (av[2 * q + 1] - mean) * rstd * gn[2 * q + 1] * c1; }
            u32x4 o; o.x = cvt_pk_bf16(y[0], y[1]); o.y = cvt_pk_bf16(y[2], y[3]); o.z = cvt_pk_bf16(y[4], y[5]); o.w = cvt_pk_bf16(y[6], y[7]);
            *(u32x4*)(obase + (size_t)r * PN + cc) = o; }
    }
#undef P6_ISSUE
#undef P6_QS
}

struct SchedY { int G, c;
    DEVI bool next(int i, pg8::Unit& u) const { return pg8::static_unit(256, 4, (long)i * G + c, u); }
    DEVI int arow(const pg8::Unit& u, int r) const { return u.pm * 256 + r; }
    static constexpr bool IDX_DMA = false; };
struct EpiBf16 { bf16_t* O; int ldc;
    static constexpr bool PRE = false;
    DEVI void operator()(const f32x4 (&acc)[2][2][4][2], const pg8::Unit& u, int wr, int wc, int fr, int fq) const {
        const int row0 = u.pm * 256 + wr * 64 + fr, col0 = u.pn * 256 + wc * 32 + 8 * fq;
#pragma unroll
        for (int ai = 0; ai < 2; ++ai)
#pragma unroll
            for (int m = 0; m < 4; ++m) { bf16_t* rowp = O + (size_t)(row0 + ai * 128 + m * 16) * ldc + col0;
#pragma unroll
                for (int bj = 0; bj < 2; ++bj) { const f32x4 v0 = acc[ai][bj][m][0], v1 = acc[ai][bj][m][1];
                    u32x4 w; w.x = cvt_pk_bf16(v0[0], v0[1]); w.y = cvt_pk_bf16(v0[2], v0[3]); w.z = cvt_pk_bf16(v1[0], v1[1]); w.w = cvt_pk_bf16(v1[2], v1[3]);
                    *(u32x4*)(rowp + bj * 128) = w; } }
    } };
DEVI void expert_weight_copies(Frame& F) {
    const Params& P = *F.p;
    __syncthreads();
    LAS float* scr = (LAS float*)(F.lds + F.wave * 8704);
    const int gw = F.blk * NWAVES + F.wave, NGW = F.G * NWAVES;
    constexpr int IGU = 16 * 16, IDN = 4 * 32;
    for (int it = gw; it < 65 * (IGU + IDN); it += NGW) {
        const int e = it / (IGU + IDN), r = it % (IGU + IDN);
        if (r < IGU) { const int kb = r >> 4, nb = r & 15;
            const float* wg = e < 64 ? P.in[I_WG] + (size_t)e * DM * EFF : P.in[I_SG]; const float* wu = e < 64 ? P.in[I_WU] + (size_t)e * DM * EFF : P.in[I_SU];
            transpose_item8(SrcGU{wg, (long)(wu - wg)}, (unsigned char*)(F.ws + WS_WGU) + (size_t)e * 512 * DM, DM, kb * 64, nb * 32, scr, F.lane, W_SCALE_GU); }
        else { const int q = r - IGU, kb = q >> 5, nb = q & 31;
            const float* wd = e < 64 ? P.in[I_WDN] + (size_t)e * EFF * DM : P.in[I_SD];
            transpose_item8(SrcPlain{wd, DM}, (unsigned char*)(F.ws + WS_WD) + (size_t)e * DM * EFF, EFF, kb * 64, nb * 32, scr, F.lane, W_SCALE_DN); }
    }
}
struct SchedRowTiles { int G, c;
    DEVI bool next(int i, pg8::Unit& u) const { const int rt = c + (i >> 2) * G; if (rt >= T / 256) return false; u.pm = rt; u.pn = i & 3; u.aux = 0; return true; }
    DEVI int arow(const pg8::Unit& u, int r) const { return u.pm * 256 + r; }
    static constexpr bool IDX_DMA = false; };
DEVI void wg_global_handoff(Frame& F) {
    asm volatile("s_waitcnt vmcnt(0)" ::: "memory");
    __syncthreads();
    if (F.tid == 0) { __builtin_amdgcn_fence(__ATOMIC_ACQUIRE, "agent"); asm volatile("s_waitcnt vmcnt(0)" ::: "memory"); }
    __syncthreads();
}
DEVI void phase_gemm_y(Frame& F) {
    pg8::Gemm g{(const bf16_t*)(F.ws + WS_PROJ) + 3072, (const bf16_t*)(F.ws + WS_WOUTT), PN, DM};
    SchedRowTiles S{F.G, F.blk}; EpiBf16 E{(bf16_t*)(F.ws + WS_PROJ), PN};
    pg8::gemm_phase(F.lds, g, S, E);
}

struct SchedOne { int pm; DEVI bool next(int i, pg8::Unit& u) const { if (i) return false; u.pm = pm; u.pn = 0; u.aux = 0; return true; }
    DEVI int arow(const pg8::Unit& u, int r) const { return u.pm * 256 + r; }
    static constexpr bool IDX_DMA = false; };
constexpr int LGP = 258;
struct EpiRouter { LAS float* L;
    static constexpr bool PRE = false;
    DEVI void operator()(const f32x4 (&acc)[2][2][4][2], const pg8::Unit&, int wr, int wc, int fr, int fq) const {
        if (wc < 2) {
#pragma unroll
            for (int ai = 0; ai < 2; ++ai)
#pragma unroll
                for (int m = 0; m < 4; ++m) { const int row = ai * 128 + wr * 64 + m * 16 + fr, ex = wc * 32 + 8 * fq;
                    const f32x4 v0 = acc[ai][0][m][0] + acc[ai][1][m][0], v1 = acc[ai][0][m][1] + acc[ai][1][m][1];
#pragma unroll
                    for (int i = 0; i < 4; ++i) { L[(ex + i) * LGP + row] = v0[i]; L[(ex + 4 + i) * LGP + row] = v1[i]; } }
        }
    } };
DEVI void phase_norm2(Frame& F) {
    const Params& P = *F.p;
    LAS float* LG = (LAS float*)F.lds;
    LAS float* MODS = (LAS float*)(F.lds + 131072);
    LAS int* hist = (LAS int*)(F.lds + 131072 + 12288);
    const float* ng = P.in[I_NORMG];
    const bf16_t* Y = (const bf16_t*)(F.ws + WS_PROJ); bf16_t* H2 = (bf16_t*)(F.ws + WS_PROJ) + 3072;
    int* EIDX = (int*)(F.ws + WS_EIDX); float* WTS = (float*)(F.ws + WS_WTS);
#pragma unroll 1
    for (int rb = F.blk; rb < T / 256; rb += F.G) {
        const int b = rb >> 5;
        __syncthreads();
        for (int i = F.tid; i < 3 * 1024; i += NTHREADS) { const int v = i >> 10, n = i & 1023; const float m = mod_value(F, b, (2 + v) * 1024 + n); MODS[i] = v == 2 ? 1.f + m : m; }
        __syncthreads();
        {
            int lane = F.lane; asm volatile("" : "+v"(lane));
            f32x4 g1v[4], g2v[4];
#pragma unroll
            for (int j = 0; j < 4; ++j) { g1v[j] = *(const f32x4*)(ng + 1024 + 256 * j + 4 * lane); g2v[j] = *(const f32x4*)(ng + 2048 + 256 * j + 4 * lane); }
            u32x2 yn[4]; f32x4 xn[4];
            { const int row = rb * 256 + F.wave;
#pragma unroll
              for (int j = 0; j < 4; ++j) { yn[j] = *(const u32x2*)(Y + (size_t)row * PN + 256 * j + 4 * lane); xn[j] = *(const f32x4*)(P.in[I_X] + (size_t)row * DM + 256 * j + 4 * lane); } }
            for (int i = 0; i < 32; ++i) {
                const int row = rb * 256 + F.wave + 8 * i;
                f32x4 y[4], x[4]; float ss = 0.f;
#pragma unroll
                for (int j = 0; j < 4; ++j) { const u32x2 yy = yn[j]; y[j] = (f32x4){lo_bf(yy.x), hi_bf(yy.x), lo_bf(yy.y), hi_bf(yy.y)};
                    x[j] = xn[j]; ss += y[j].x * y[j].x + y[j].y * y[j].y + y[j].z * y[j].z + y[j].w * y[j].w; }
                if (i + 1 < 32) { const int nr = row + 8;
#pragma unroll
                    for (int j = 0; j < 4; ++j) { yn[j] = *(const u32x2*)(Y + (size_t)nr * PN + 256 * j + 4 * lane); xn[j] = *(const f32x4*)(P.in[I_X] + (size_t)nr * DM + 256 * j + 4 * lane); } }
                const float rsy = rsqrtf(wave_sum(ss) * (1.f / DM) + EPS); float s2 = 0.f;
#pragma unroll
                for (int j = 0; j < 4; ++j) { const f32x4 gg = *(const LAS f32x4*)(MODS + 256 * j + 4 * lane); x[j] = x[j] + gg * (y[j] * rsy * g1v[j]);
                    { u32x2 xo; xo.x = cvt_pk_bf16(x[j].x, x[j].y); xo.y = cvt_pk_bf16(x[j].z, x[j].w); *(u32x2*)((bf16_t*)(P.out + (size_t)row * DM) + 256 * j + 4 * lane) = xo; } s2 += x[j].x * x[j].x + x[j].y * x[j].y + x[j].z * x[j].z + x[j].w * x[j].w; }
                const float rsx = rsqrtf(wave_sum(s2) * (1.f / DM) + EPS);
#pragma unroll
                for (int j = 0; j < 4; ++j) { const f32x4 sh = *(const LAS f32x4*)(MODS + 1024 + 256 * j + 4 * lane), sc = *(const LAS f32x4*)(MODS + 2048 + 256 * j + 4 * lane);
                    const f32x4 hv = (x[j] * rsx * g2v[j]) * sc + sh;
                    u32x2 o; o.x = cvt_pk_bf16(hv.x, hv.y); o.y = cvt_pk_bf16(hv.z, hv.w);
                    *(u32x2*)(H2 + (size_t)row * PN + 256 * j + 4 * lane) = o;
                    *(unsigned*)((unsigned char*)(F.ws + WS_PROJ) + (size_t)row * PN * 2 + 256 * j + 4 * lane) = pack_fp8x4(hv.x * H2_SCALE, hv.y * H2_SCALE, hv.z * H2_SCALE, hv.w * H2_SCALE); }
            }
        }
    }
    asm volatile("s_waitcnt vmcnt(0)" ::: "memory");
    __syncthreads();
    if (F.tid == 0) { __builtin_amdgcn_fence(__ATOMIC_ACQUIRE, "agent"); asm volatile("s_waitcnt vmcnt(0)" ::: "memory"); }
    __syncthreads();
#pragma unroll 1
    for (int rb = F.blk; rb < T / 256; rb += F.G) {
        __syncthreads();
        if (F.tid < 64) hist[F.tid] = 0;
        {
            pg8::Gemm g{(const bf16_t*)(F.ws + WS_PROJ) + 3072, (const bf16_t*)(F.ws + WS_WRT), PN, DM};
            SchedOne S{rb}; EpiRouter E{LG};
            pg8::gemm_phase<EpiRouter, SchedOne, true>(F.lds, g, S, E);
        }
        __syncthreads();
        if (F.tid < 256) {
            const int lr = F.tid, row = rb * 256 + lr;
            float sc[64], sel[64];
#pragma unroll
            for (int e = 0; e < 64; ++e) { const float s = sigmoidf_(LG[e * LGP + lr]); sc[e] = s; sel[e] = s + P.in[I_RB][e]; }
            float gs[8];
#pragma unroll
            for (int g2 = 0; g2 < 8; ++g2) { float m1 = -3.0e38f, m2 = -3.0e38f;
#pragma unroll
                for (int j = 0; j < 8; ++j) { const float v = sel[8 * g2 + j]; m2 = fmaxf(m2, fminf(m1, v)); m1 = fmaxf(m1, v); }
                gs[g2] = m1 + m2; }
#pragma unroll
            for (int g2 = 0; g2 < 8; ++g2) { int rank = 0;
#pragma unroll
                for (int g3 = 0; g3 < 8; ++g3) if (g3 != g2) rank += (gs[g3] > gs[g2] || (gs[g3] == gs[g2] && g3 < g2)) ? 1 : 0;
                if (rank >= 4) {
#pragma unroll
                    for (int j = 0; j < 8; ++j) sel[8 * g2 + j] = -3.0e38f; } }
            int idx[8]; float wv[8]; float wsum = 0.f;
#pragma unroll
            for (int k = 0; k < 8; ++k) { float best = -3.4e38f, bs = 0.f; int bi = 0;
#pragma unroll
                for (int e = 0; e < 64; ++e) { const bool c = sel[e] > best; best = c ? sel[e] : best; bi = c ? e : bi; bs = c ? sc[e] : bs; }
                idx[k] = bi; wv[k] = bs; wsum += bs;
#pragma unroll
                for (int e = 0; e < 64; ++e) sel[e] = (bi == e) ? -3.4e38f : sel[e]; }
            const float wn = 2.5f * __builtin_amdgcn_rcpf(wsum);
            *(u32x4*)(EIDX + (size_t)row * 8) = (u32x4){(unsigned)idx[0], (unsigned)idx[1], (unsigned)idx[2], (unsigned)idx[3]};
            *(u32x4*)(EIDX + (size_t)row * 8 + 4) = (u32x4){(unsigned)idx[4], (unsigned)idx[5], (unsigned)idx[6], (unsigned)idx[7]};
            *(f32x4*)(WTS + (size_t)row * 8) = (f32x4){wv[0] * wn, wv[1] * wn, wv[2] * wn, wv[3] * wn};
            *(f32x4*)(WTS + (size_t)row * 8 + 4) = (f32x4){wv[4] * wn, wv[5] * wn, wv[6] * wn, wv[7] * wn};
#pragma unroll
            for (int k = 0; k < 8; ++k) atomicAdd((int*)hist + idx[k], 1);
        }
        __syncthreads();
        if (F.tid < 64) ((int*)(F.ws + WS_BCNT))[rb * 64 + F.tid] = hist[F.tid];
    }
}

DEVI void phase_lists(Frame& F) {
    LAS int* base = (LAS int*)F.lds;
    LAS int* pst = base + 64;
    LAS int* tot = pst + 65;
    LAS int* lcnt = tot + 64;
    const int* BC = (const int*)(F.ws + WS_BCNT);
    const int* EIDX = (const int*)(F.ws + WS_EIDX); const float* WTS = (const float*)(F.ws + WS_WTS); int* POS = (int*)(F.ws + WS_POS);
    for (int rb = F.blk; rb < 256; rb += F.G) {
        const int hh = rb >> 7;
        __syncthreads();
        {   LAS int* psum = lcnt + 64;
            const int e = F.tid & 63, part = F.tid >> 6; int bs = 0, ts = 0;
#pragma unroll
            for (int i = 0; i < 16; ++i) { const int q = hh * 128 + part * 16 + i; const int v = BC[q * 64 + e]; ts += v; bs += q < rb ? v : 0; }
            psum[(part * 64 + e) * 2] = bs; psum[(part * 64 + e) * 2 + 1] = ts;
            __syncthreads();
            if (F.tid < 64) { int bsum = 0, tsum = 0;
#pragma unroll
                for (int p = 0; p < 8; ++p) { bsum += psum[(p * 64 + F.tid) * 2]; tsum += psum[(p * 64 + F.tid) * 2 + 1]; }
                base[F.tid] = bsum; tot[F.tid] = tsum; lcnt[F.tid] = 0; }
        }
        __syncthreads();
        if (F.tid == 0) { int s = 0; for (int e = 0; e < 64; ++e) { pst[e] = s; s += (tot[e] + 255) & ~255; } pst[64] = s; }
        __syncthreads();
        int* TOK = (int*)(F.ws + WS_TOKL) + (size_t)hh * ROWS_H; float* WL = (float*)(F.ws + WS_WL) + (size_t)hh * ROWS_H;
        for (int i = F.tid; i < 256 * 8; i += NTHREADS) { const int t = rb * 256 + (i >> 3), k = i & 7; const int e = EIDX[(size_t)t * 8 + k];
            const int loc = atomicAdd((int*)lcnt + e, 1); const int dest = pst[e] + base[e] + loc;
            TOK[dest] = t; WL[dest] = WTS[(size_t)t * 8 + k]; POS[(size_t)t * 8 + k] = dest + hh * ROWS_H; }
        if (F.tid < 256) { const int t = rb * 256 + F.tid; TOK[CAP_R + t - hh * HALF_T] = t; WL[CAP_R + t - hh * HALF_T] = 1.f; }
        const int e = rb & 127;
        if (e < 64) {
            for (int r = pst[e] + tot[e] + F.tid; r < pst[e + 1]; r += NTHREADS) { TOK[r] = -1; WL[r] = 0.f; }
            int* TE = (int*)(F.ws + WS_TEXP) + hh * CAP_TILES;
            for (int q = (pst[e] >> 8) + F.tid; q < (pst[e + 1] >> 8); q += NTHREADS) TE[q] = e;
            if (e == 0 && F.tid == 0) ((int*)(F.ws + WS_NT))[hh] = pst[64] >> 8;
        }
    }
}

struct SchedMoE {
    int G, c, nt0, nt1, npn, hsel; const int* texp; const int* tok; bool gather;
    DEVI bool next(int i, pg8::Unit& u) const {
        const int cc = (G == 256) ? ((c & 7) * 32 + (c >> 3)) : c;
        const int sh = npn == 8 ? 3 : (npn == 4 ? 2 : 1);
        const int L = i * G + cc; const int rtl = L >> sh; int pnl = L & (npn - 1);
        const int r0 = nt0 + SH_TILES, r1 = nt1 + SH_TILES;
        int hh, rl;
        if (hsel < 0) { if (rtl >= r0 + r1) return false; hh = rtl >= r0 ? 1 : 0; rl = rtl - hh * r0; }
        else {
            hh = hsel; const int nrt = hh ? r1 : r0, fr = nrt / G;
            if (i < npn * fr) { rl = (i >> sh) * G + cc; pnl = i & (npn - 1); }
            else { const int L2 = (i - npn * fr) * G + cc; rl = fr * G + (L2 >> sh); pnl = L2 & (npn - 1); if (rl >= nrt) return false; }
        }
        const int nth = hh ? nt1 : nt0;
        int e, lt; if (rl < nth) { lt = rl; e = texp[hh * CAP_TILES + rl]; } else { lt = CAP_TILES + (rl - nth); e = 64; }
        u.pm = hh * HTILES + lt; u.pn = e * npn + pnl; u.aux = pnl; return true;
    }
    DEVI int arow(const pg8::Unit& u, int r) const {
        if (!gather) return u.pm * 256 + r;
        const int t = tok[u.pm * 256 + r]; return t < 0 ? 0 : t;
    }
};
constexpr int UT_OFF = pg8::STAGE_BYTES, UT_MAX = 64;
constexpr int WLB_OFF = UT_OFF + 1024;
constexpr int IDX_OFF = UT_OFF + 3072;
template <bool GATHER>
struct SchedTab { const LAS int* tab; const int* tok;
    static constexpr bool IDX_DMA = GATHER;
    DEVI bool next(int i, pg8::Unit& u) const {
        if (i >= UT_MAX) return false;
        const int pm = tab[4 * i]; if (pm < 0) return false;
        u.pm = pm; u.pn = tab[4 * i + 1]; u.aux = tab[4 * i + 2]; return true;
    }
    DEVI int arow(const pg8::Unit& u, int r) const {
        if (!GATHER) return u.pm * 256 + r;
        return tok[u.pm * 256 + r];
    }
    DEVI void idx_dma(LAS unsigned char* l, const pg8::Unit& u, int ui, int wid, int lane) const {
        if (wid >= 4) __builtin_amdgcn_global_load_lds((const unsigned*)(tok + u.pm * 256 + (wid - 4) * 64 + lane), (LAS unsigned*)(l + IDX_OFF + (ui & 1) * 1024 + (wid - 4) * 256), 4, 0, 0);
    }
    DEVI int idx_lds(LAS unsigned char* l, int ui, int r) const { return ((const LAS int*)(l + IDX_OFF + (ui & 1) * 1024))[r]; }
};
template <bool GATHER>
DEVI SchedTab<GATHER> build_unit_table(Frame& F, const SchedMoE& S) {
    LAS int* tab = (LAS int*)(F.lds + UT_OFF);
    __syncthreads();
    int ti = F.tid; asm volatile("" : "+v"(ti));
    if (ti < UT_MAX) { pg8::Unit u; u.pm = 0; u.pn = 0; u.aux = 0; const bool ok = S.next(ti, u);
        tab[4 * ti] = ok ? u.pm : -1; tab[4 * ti + 1] = ok ? u.pn : 0; tab[4 * ti + 2] = ok ? u.aux : 0; }
    __syncthreads();
    return SchedTab<GATHER>{tab, S.tok};
}
struct EpiGU { unsigned char* O; const float* wl; float inv; LAS unsigned char* lds;
    static constexpr bool PRE = true;
    DEVI void prefetch(LAS unsigned char* l, const pg8::Unit& u, int wid, int lane) const {
        if (wid < 4) __builtin_amdgcn_global_load_lds((const unsigned*)(wl + u.pm * 256 + wid * 64 + lane), (LAS unsigned*)(l + WLB_OFF + (u.seq & 1) * 1024 + wid * 256), 4, 0, 0);
    }
    DEVI void operator()(const f32x4 (&acc)[2][2][4][2], const pg8::Unit& u, int wr, int wc, int fr, int fq) const {
        asm volatile("" : "+v"(fr), "+v"(fq));
        const int row0 = u.pm * 256 + wr * 64 + fr, col0 = u.aux * 64 + wc * 16 + 4 * fq;
        const LAS float* wb = (const LAS float*)(lds + WLB_OFF + (u.seq & 1) * 1024) + wr * 64 + fr;
        float wv[2][4];
#pragma unroll
        for (int ai = 0; ai < 2; ++ai)
#pragma unroll
            for (int m = 0; m < 4; ++m) wv[ai][m] = wb[ai * 128 + m * 16];
#pragma unroll
        for (int ai = 0; ai < 2; ++ai)
#pragma unroll
            for (int m = 0; m < 4; ++m) { const f32x4 g0 = acc[ai][0][m][0], u0 = acc[ai][0][m][1]; const float w = wv[ai][m];
                float o[4];
#pragma unroll
                for (int i = 0; i < 4; ++i) o[i] = siluf_(g0[i]) * u0[i] * (w * ACT_SCALE);
                *(unsigned*)(O + (size_t)(row0 + ai * 128 + m * 16) * EFF + col0) = pack_fp8x4(o[0], o[1], o[2], o[3]); }
    } };
DEVI void phase_moe_gu(Frame& F) {
    const int nt0 = ((const int*)(F.ws + WS_NT))[0], nt1 = ((const int*)(F.ws + WS_NT))[1];
    static_assert(H2_SCALE * W_SCALE_GU == 16384.f, "the gate|up GEMM's operand scaling is undone by the MFMA block scale: 2^-14");
    pg8::Gemm g{(const bf16_t*)(F.ws + WS_PROJ), (const bf16_t*)(F.ws + WS_WGU), PN, DM / 2, 0x71717171};
    SchedMoE S0{F.G, F.blk, nt0, nt1, 4, -1, (const int*)(F.ws + WS_TEXP), (const int*)(F.ws + WS_TOKL), true};
    const SchedTab<true> S = build_unit_table<true>(F, S0);
    EpiGU E{(unsigned char*)(F.ws + WS_ACT), (const float*)(F.ws + WS_WL), 1.f, F.lds};
    pg8::gemm_phase<EpiGU, SchedTab<true>, false, true, true>(F.lds, g, S, E);
}
struct EpiDown { unsigned char* O; int hh; float sc;
    static constexpr bool PRE = false;
    static constexpr int NST = 8;
    DEVI void operator()(const f32x4 (&acc)[2][2][4][2], const pg8::Unit& u, int wr, int wc, int fr, int fq) const {
        asm volatile("" : "+v"(fr), "+v"(fq));
        const int row0 = (u.pm - hh * HTILES) * 256 + wr * 64 + fr, col0 = u.aux * 128 + wc * 32 + 8 * fq;
#pragma unroll
        for (int ai = 0; ai < 2; ++ai)
#pragma unroll
            for (int m = 0; m < 4; ++m) { const int row = row0 + ai * 128 + m * 16;
                const f32x4 a0 = acc[ai][0][m][0], a1 = acc[ai][0][m][1];
                u32x2 o; o.x = pack_fp8x4(a0[0], a0[1], a0[2], a0[3]); o.y = pack_fp8x4(a1[0], a1[1], a1[2], a1[3]);
                *(u32x2*)(O + (size_t)row * DM + col0) = o; }
    } };
DEVI void phase_moe_down(Frame& F, int hh) {
    const int nt0 = ((const int*)(F.ws + WS_NT))[0], nt1 = ((const int*)(F.ws + WS_NT))[1];
    static_assert(ROW_SCALE / (ACT_SCALE * W_SCALE_DN) == 1.f / 1024.f, "the down GEMM's output scaling rides on the MFMA block scale: 2^-10");
    SchedMoE S0{F.G, F.blk, nt0, nt1, 8, hh, (const int*)(F.ws + WS_TEXP), nullptr, false};
    const SchedTab<false> S = build_unit_table<false>(F, S0);
    pg8::DnArgs g{(const unsigned char*)(F.ws + WS_ACT), (const unsigned char*)(F.ws + WS_WD), (unsigned char*)(F.ws + (hh ? WS_ROWS1 : WS_ROWS0)), hh, 0x75757575};
    pg8::gemm_phase_dnreg(F.lds, g, S);
}
DEVI void phase_combine(Frame& F, int hh) {
    const Params& P = *F.p;
    LAS float* G2 = (LAS float*)F.lds;
    const unsigned char* ROWS = (const unsigned char*)(F.ws + (hh ? WS_ROWS1 : WS_ROWS0)); const int* POS = (const int*)(F.ws + WS_POS);
    const int cA = 16 * F.lane;
    f32x4 g3v[4];
#pragma unroll
    for (int j = 0; j < 4; ++j) g3v[j] = *(const f32x4*)(P.in[I_NORMG] + 3072 + cA + 4 * j);
    for (int rb = F.blk; rb < HALF_T / 128; rb += F.G) {
        const int t0 = hh * HALF_T + rb * 128, b = t0 >> 13;
        __syncthreads();
        for (int i = F.tid; i < 1024; i += NTHREADS) G2[i] = mod_value(F, b, 5 * 1024 + i);
        __syncthreads();
        int prv[16];
#pragma unroll
        for (int i = 0; i < 16; ++i) { prv[i] = 0; if (F.lane < 8) prv[i] = POS[(size_t)(t0 + F.wave + 8 * i) * 8 + F.lane] - hh * ROWS_H; }
#pragma unroll
        for (int i = 0; i < 16; ++i) {
            const int t = t0 + F.wave + 8 * i;
            const int pr = prv[i];
            const bf16_t* x1p = (const bf16_t*)(P.out + (size_t)t * DM);
            const u32x4 xa = *(const u32x4*)(x1p + cA), xb = *(const u32x4*)(x1p + cA + 8);
            u32x4 rv[9];
#pragma unroll
            for (int k = 0; k < 9; ++k) { const int r = k < 8 ? __shfl(pr, k) : CAP_R + (t - hh * HALF_T); rv[k] = *(const u32x4*)(ROWS + (size_t)r * DM + 16 * F.lane); }
            float a[16];
#pragma unroll
            for (int q = 0; q < 16; ++q) a[q] = 0.f;
#pragma unroll
            for (int k = 0; k < 9; ++k)
#pragma unroll
                for (int q = 0; q < 4; ++q) { const f32x2 lo = __builtin_amdgcn_cvt_pk_f32_fp8((int)rv[k][q], false), hi = __builtin_amdgcn_cvt_pk_f32_fp8((int)rv[k][q], true);
                    a[4 * q] += lo[0]; a[4 * q + 1] += lo[1]; a[4 * q + 2] += hi[0]; a[4 * q + 3] += hi[1]; }
            float ss = 0.f;
#pragma unroll
            for (int q = 0; q < 16; ++q) { a[q] *= (1.f / ROW_SCALE); ss += a[q] * a[q]; }
            const float rs = rsqrtf(wave_sum(ss) * (1.f / DM) + EPS);
            asm volatile("s_waitcnt vmcnt(0)" ::: "memory");
#pragma unroll
            for (int j = 0; j < 4; ++j) { const int col = cA + 4 * j; const f32x4 gg = *(const LAS f32x4*)(G2 + col);
                const u32x4 xs = (j >> 1) ? xb : xa; const unsigned w0 = (j & 1) ? xs.z : xs.x, w1 = (j & 1) ? xs.w : xs.y;
                const f32x4 x1 = (f32x4){lo_bf(w0), hi_bf(w0), lo_bf(w1), hi_bf(w1)};
                const f32x4 av = (f32x4){a[4 * j], a[4 * j + 1], a[4 * j + 2], a[4 * j + 3]};
                *(f32x4*)(P.out + (size_t)t * DM + col) = x1 + gg * (av * rs * g3v[j]); }
        }
    }
}

DEVI void phase_mixer_tail(Frame& F) {
    const bool first = (F.blk >> 3) & 1;
    if (first) { expert_weight_copies(F); __syncthreads(); }
    phase_chunk_out(F);
    wg_global_handoff(F);
    phase_gemm_y(F);
    wg_global_handoff(F);
    phase_norm2(F);
    if (!first) { __syncthreads(); expert_weight_copies(F); }
}

DEVI void phase_down1_combine0(Frame& F) {
    if ((F.blk >> 3) & 1) { phase_combine(F, 0); __syncthreads(); phase_moe_down(F, 1); }
    else { phase_moe_down(F, 1); __syncthreads(); phase_combine(F, 0); }
}

constexpr int N_PHASES = 11;
__global__ void __launch_bounds__(NTHREADS, 2) mk_fwd(Params prm) {
    extern __shared__ __attribute__((aligned(16))) unsigned char lds_raw[];
    Frame F; F.lds = (LAS unsigned char*)lds_raw; F.tid = threadIdx.x; F.lane = F.tid & 63; F.wave = __builtin_amdgcn_readfirstlane(F.tid >> 6);
    F.G = gridDim.x; F.blk = blockIdx.x; F.p = &prm; F.ws = prm.ws;
    volatile LAS unsigned* misc = (volatile LAS unsigned*)(F.lds + LDS_MISC);
    if (F.tid < 16) misc[F.tid] = 0u;
    __syncthreads();
    const int lo = prm.ph_lo, hi = prm.ph_hi;
    XcdBarrier bar; bar.bar = (unsigned*)(F.ws + WS_CTL); bar.x = 0; bar.st = misc;
    if (hi - lo > 1) bar = xcd_barrier_post((unsigned*)(F.ws + WS_CTL), misc);
#ifndef PH_MASK
#define PH_MASK 0xFFFF
#endif
#define RUN(k, call) do { if (((PH_MASK >> (k)) & 1) && lo <= (k) && (k) < hi) { call; if ((k) + 1 < hi) xcd_barrier(bar); } } while (0)
    RUN(0, phase_prep(F));
    RUN(1, phase_norm1(F));
    RUN(2, phase_gemm_proj(F));
    RUN(3, phase_chunk_u(F));
    RUN(4, phase_scan_states(F));
    RUN(5, phase_mixer_tail(F));
    RUN(6, phase_lists(F));
    RUN(7, phase_moe_gu(F));
    RUN(8, phase_moe_down(F, 0));
    RUN(9, phase_down1_combine0(F));
    RUN(10, phase_combine(F, 1));
#undef RUN
}

extern "C" void kernel_launch(void* const* d_in, const int* in_sizes, int n_in, void* d_out, int out_size, void* d_ws, size_t ws_size, hipStream_t stream) {
    static int grid = 0;
    if (grid == 0) {
        if (n_in != 23 || in_sizes[0] != T * DM || out_size != T * DM || ws_size < WS_END) {
            fprintf(stderr, "kernel_launch: unexpected shapes (n_in %d, in0 %d, out %d, ws %zu < %zu)\n", n_in, n_in > 0 ? in_sizes[0] : -1, out_size, ws_size, (size_t)WS_END); grid = -1; return; }
        int dev = 0, cus = 0, per_cu = 0;
        if (hipGetDevice(&dev) != hipSuccess || hipDeviceGetAttribute(&cus, hipDeviceAttributeMultiprocessorCount, dev) != hipSuccess) { grid = -1; return; }
        if (hipFuncSetAttribute((const void*)mk_fwd, hipFuncAttributeMaxDynamicSharedMemorySize, LDS_BYTES) != hipSuccess) { fprintf(stderr, "kernel_launch: hipFuncSetAttribute failed\n"); grid = -1; return; }
        if (hipOccupancyMaxActiveBlocksPerMultiprocessor(&per_cu, (const void*)mk_fwd, NTHREADS, LDS_BYTES) != hipSuccess || per_cu < 1) { fprintf(stderr, "kernel_launch: occupancy query says %d\n", per_cu); }
        (void)hipGetLastError();
        grid = cus;
    }
    if (grid < 0) return;
    (void)hipMemsetAsync((char*)d_ws + WS_CTL, 0, CTL_BYTES, stream);
    Params p{};
    for (int i = 0; i < 23; ++i) p.in[i] = (const float*)d_in[i];
    p.out = (float*)d_out; p.ws = (unsigned char*)d_ws;
#if MK_ONE_LAUNCH
    p.ph_lo = 0; p.ph_hi = N_PHASES;
    hipLaunchKernelGGL(mk_fwd, dim3(grid), dim3(NTHREADS), LDS_BYTES, stream, p);
#else
    for (int k = 0; k < N_PHASES; ++k) { p.ph_lo = k; p.ph_hi = k + 1; hipLaunchKernelGGL(mk_fwd, dim3(grid), dim3(NTHREADS), LDS_BYTES, stream, p); }
#endif
}
```

```cpp
#include <hip/hip_runtime.h>
#include <cstdio>
#include <cstdint>

#ifndef MK_ONE_LAUNCH
#define MK_ONE_LAUNCH 1
#endif

#define LAS __attribute__((address_space(3)))
#define DEVI __device__ __forceinline__
typedef unsigned short bf16_t;
typedef short bf16x8 __attribute__((ext_vector_type(8)));
typedef float f32x4 __attribute__((ext_vector_type(4)));
typedef float f32x2 __attribute__((ext_vector_type(2)));
typedef unsigned u32x4 __attribute__((ext_vector_type(4)));
typedef unsigned u32x2 __attribute__((ext_vector_type(2)));

constexpr int DM = 1024, NBATCH = 8, SEQ = 8192, T = NBATCH * SEQ, CTXL = 256, TC = NBATCH * CTXL, TT = T + TC;
constexpr int CH = 128, NCH = SEQ / CH, NCC = CTXL / CH, NSLOT = NCH + NCC;
constexpr int PN = 4096;
constexpr int INC = 4112;
constexpr int NE = 64, TOPK = 8, EFF = 256;
constexpr int NTHREADS = 512, NWAVES = 8;
constexpr int LDS_BYTES = 155648;
constexpr int LDS_MISC = LDS_BYTES - 64;
constexpr float EPS = 1e-6f;
constexpr int HALF_T = T / 2;
constexpr int CAP_R = HALF_T * TOPK + NE * 256;
constexpr int CAP_TILES = CAP_R / 256;
constexpr int ROWS_H = CAP_R + HALF_T;
constexpr int SH_TILES = HALF_T / 256;
constexpr int HTILES = ROWS_H / 256;
constexpr float ROW_SCALE = 8.f;
constexpr float ACT_SCALE = 16.f, W_SCALE_DN = 512.f;
constexpr float H2_SCALE = 16.f, W_SCALE_GU = 1024.f;

constexpr size_t MB = 1ull << 20;
constexpr size_t WS_CTL = 0;
constexpr size_t CTL_BYTES = 65536;
constexpr size_t WS_MODP = 1 * MB;
constexpr size_t WS_WINT = 3 * MB;
constexpr size_t WS_WOUTT = 11 * MB;
constexpr size_t WS_WRT = 13 * MB;
constexpr size_t WS_GATES = 14 * MB;
constexpr size_t WS_UN = 19 * MB;
constexpr size_t WS_CHS = 22 * MB;
constexpr size_t WS_SM = 22 * MB + 256 * 1024;
constexpr size_t WS_EIDX = 23 * MB;
constexpr size_t WS_WTS = 25 * MB;
constexpr size_t WS_POS = 27 * MB;
constexpr size_t WS_TOKL = 29 * MB;
constexpr size_t WS_WL = 32 * MB;
constexpr size_t WS_BCNT = 35 * MB;
constexpr size_t WS_TEXP = 35 * MB + 128 * 1024;
constexpr size_t WS_NT = 35 * MB + 256 * 1024;
constexpr size_t WS_B = 36 * MB;
constexpr size_t WS_PROJ = 168 * MB;
constexpr size_t WS_US = 696 * MB;
constexpr size_t WS_WGU = 36 * MB;
constexpr size_t WS_WD = 101 * MB;
constexpr size_t WS_ACT = 776 * MB;
constexpr size_t WS_ROWS0 = 168 * MB;
constexpr size_t WS_ROWS1 = 472 * MB;
constexpr size_t WS_END = 1000 * MB;
static_assert(WS_WD + 65ull * 1024 * 256 * 2 <= WS_PROJ && WS_ACT + 2ull * ROWS_H * 256 <= WS_END && WS_ROWS0 + (size_t)ROWS_H * 1024 <= WS_ROWS1
              && WS_ROWS1 + (size_t)ROWS_H * 1024 <= WS_ACT && WS_ACT >= WS_PROJ + (size_t)TT * PN * 2, "workspace overlap");

struct Params {
    const float* in[23];
    float* out;
    unsigned char* ws;
    int ph_lo, ph_hi;
};
enum { I_X = 0, I_C, I_CTX, I_CCTX, I_WMOD, I_BMOD, I_NORMG, I_WIN, I_RDEC, I_RNG, I_CONVW, I_CONVB, I_GATEB, I_MNG, I_WOUT,
       I_WR, I_RB, I_WG, I_WU, I_WDN, I_SG, I_SU, I_SD };

DEVI float bf2f(bf16_t b) { return __uint_as_float(((unsigned)b) << 16); }
DEVI unsigned cvt_pk_bf16(float lo, float hi) { unsigned r; asm volatile("v_cvt_pk_bf16_f32 %0, %1, %2" : "=v"(r) : "v"(lo), "v"(hi)); return r; }
DEVI bf16_t f2bf(float f) { return (bf16_t)(cvt_pk_bf16(f, 0.f) & 0xffffu); }
DEVI float lo_bf(unsigned u) { return __uint_as_float(u << 16); }
DEVI float hi_bf(unsigned u) { return __uint_as_float(u & 0xffff0000u); }
DEVI float wave_sum(float v) {
#pragma unroll
    for (int o = 1; o < 64; o <<= 1) v += __shfl_xor(v, o);
    return v;
}
DEVI float row16_sum(float v) {
    v += __builtin_bit_cast(float, __builtin_amdgcn_update_dpp(0, __builtin_bit_cast(int, v), 0xB1, 0xF, 0xF, true));
    v += __builtin_bit_cast(float, __builtin_amdgcn_update_dpp(0, __builtin_bit_cast(int, v), 0x4E, 0xF, 0xF, true));
    v += __builtin_bit_cast(float, __builtin_amdgcn_update_dpp(0, __builtin_bit_cast(int, v), 0x141, 0xF, 0xF, true));
    v += __builtin_bit_cast(float, __builtin_amdgcn_update_dpp(0, __builtin_bit_cast(int, v), 0x140, 0xF, 0xF, true));
    return v;
}
DEVI float dpp_x1(float x) { return __builtin_bit_cast(float, __builtin_amdgcn_update_dpp(0, __builtin_bit_cast(int, x), 0xB1, 0xF, 0xF, true)); }
DEVI float dpp_x2(float x) { return __builtin_bit_cast(float, __builtin_amdgcn_update_dpp(0, __builtin_bit_cast(int, x), 0x4E, 0xF, 0xF, true)); }
DEVI float dpp_x4(float x) { const int t = __builtin_amdgcn_update_dpp(0, __builtin_bit_cast(int, x), 0x114, 0xF, 0xA, true);
    return __builtin_bit_cast(float, __builtin_amdgcn_update_dpp(t, __builtin_bit_cast(int, x), 0x104, 0xF, 0x5, true)); }
DEVI float dpp_x8(float x) { const int t = __builtin_amdgcn_update_dpp(0, __builtin_bit_cast(int, x), 0x118, 0xF, 0xC, true);
    return __builtin_bit_cast(float, __builtin_amdgcn_update_dpp(t, __builtin_bit_cast(int, x), 0x108, 0xF, 0x3, true)); }
DEVI float quad_sum(float v) {
    v += __builtin_bit_cast(float, __builtin_amdgcn_update_dpp(0, __builtin_bit_cast(int, v), 0xB1, 0xF, 0xF, true));
    v += __builtin_bit_cast(float, __builtin_amdgcn_update_dpp(0, __builtin_bit_cast(int, v), 0x4E, 0xF, 0xF, true));
    return v;
}
DEVI float wave_max(float v) {
#pragma unroll
    for (int o = 1; o < 64; o <<= 1) v = fmaxf(v, __shfl_xor(v, o));
    return v;
}
DEVI float sigmoidf_(float x) { return __builtin_amdgcn_rcpf(1.f + __expf(-x)); }
DEVI float siluf_(float x) { return x * __builtin_amdgcn_rcpf(1.f + __expf(-x)); }
DEVI f32x2 sigmoid2_(f32x2 x) { const f32x2 t = x * (f32x2){-1.4426950408889634f, -1.4426950408889634f}; f32x2 e; e.x = __builtin_amdgcn_exp2f(t.x); e.y = __builtin_amdgcn_exp2f(t.y);
    const f32x2 d = e + (f32x2){1.f, 1.f}; f32x2 r; r.x = __builtin_amdgcn_rcpf(d.x); r.y = __builtin_amdgcn_rcpf(d.y); return r; }
DEVI f32x2 silu2_(f32x2 x) { return x * sigmoid2_(x); }
DEVI f32x4 silu4_(f32x4 x) { const f32x2 a = silu2_(x.lo), b = silu2_(x.hi); return (f32x4){a.x, a.y, b.x, b.y}; }
DEVI f32x4 exp4_(f32x4 x) { const f32x4 t = x * 1.4426950408889634f; return (f32x4){__builtin_amdgcn_exp2f(t.x), __builtin_amdgcn_exp2f(t.y), __builtin_amdgcn_exp2f(t.z), __builtin_amdgcn_exp2f(t.w)}; }
DEVI f32x4 exp2_4_(f32x4 t) { return (f32x4){__builtin_amdgcn_exp2f(t.x), __builtin_amdgcn_exp2f(t.y), __builtin_amdgcn_exp2f(t.z), __builtin_amdgcn_exp2f(t.w)}; }
DEVI float logsigmoidf_(float x) { const float e = __expf(-fabsf(x)); return fminf(x, 0.f) - __logf(1.f + e); }
#define LDS_WAIT() asm volatile("s_waitcnt lgkmcnt(0)" ::: "memory")

#define XB_TMO      128
#define XB_XCNT(j)  (256  + 64 * (j))
#define XB_XSUB(j)  (1280 + 64 * (j))
#define XB_XGEN(j)  (2304 + 64 * (j))
#define XB_TOP      3328
#define XB_TOPGEN   3392
#define XCD_BAR_WORDS 3456
#define XB_SPIN_CAP (1u << 18)
DEVI unsigned xb_ld(unsigned* p)              { return __hip_atomic_load(p, __ATOMIC_RELAXED, __HIP_MEMORY_SCOPE_AGENT); }
DEVI unsigned xb_add(unsigned* p, unsigned v) { return __hip_atomic_fetch_add(p, v, __ATOMIC_RELAXED, __HIP_MEMORY_SCOPE_AGENT); }
DEVI unsigned xb_xcc_id() { return (unsigned)__builtin_amdgcn_s_getreg((3 << 11) | 20) & 0xFu; }
#define XB_SPIN(cond, bar) do { unsigned _sp = 0; while (cond) { __builtin_amdgcn_s_sleep(1); \
    if ((++_sp & 255u) == 0u) { if (xb_ld(&(bar)[XB_TMO])) break; if (_sp > XB_SPIN_CAP) { atomicAdd(&(bar)[XB_TMO], 1u); break; } } } } while (0)
struct XcdBarrier { unsigned* bar; unsigned x; volatile LAS unsigned* st; };
DEVI XcdBarrier xcd_barrier_post(unsigned* bar, volatile LAS unsigned* st) {
    XcdBarrier b; b.bar = bar; b.x = xb_xcc_id(); b.st = st;
    if (threadIdx.x == 0) (void)xb_add(&bar[XB_XCNT(b.x)], 1u);
    return b;
}
DEVI void xcd_barrier_complete(unsigned* bar, unsigned x, unsigned& nloc, unsigned& nx) {
    const unsigned G = gridDim.x * gridDim.y * gridDim.z;
    unsigned sum, cnt, mine, sp = 0u;
    for (;;) {
        sum = 0u; cnt = 0u; mine = 0u;
#pragma unroll
        for (unsigned j = 0; j < 16; ++j) { const unsigned c = xb_ld(&bar[XB_XCNT(j)]); sum += c; cnt += (c > 0u) ? 1u : 0u; mine = (j == x) ? c : mine; }
        if (sum == G) break;
        __builtin_amdgcn_s_sleep(1);
        if ((++sp & 255u) == 0u) { if (xb_ld(&bar[XB_TMO])) break; if (sp > XB_SPIN_CAP) { atomicAdd(&bar[XB_TMO], 1u); break; } }
    }
    nloc = mine > 0u ? mine : 1u; nx = cnt > 0u ? cnt : 1u;
}
DEVI void xcd_barrier(const XcdBarrier& b) {
    asm volatile("s_waitcnt vmcnt(0)" ::: "memory");
    __syncthreads();
    if (threadIdx.x == 0) {
        unsigned* bar = b.bar;
        __builtin_amdgcn_s_waitcnt(0);
        unsigned nloc = b.st[0], nx = b.st[1];
        if (nloc == 0u) { xcd_barrier_complete(bar, b.x, nloc, nx); b.st[0] = nloc; b.st[1] = nx; }
        const unsigned old = xb_add(&bar[XB_XSUB(b.x)], 1u);
        const unsigned gen = old / nloc;
        if (old + 1u == (gen + 1u) * nloc) {
            __builtin_amdgcn_fence(__ATOMIC_RELEASE, "agent");
            asm volatile("s_waitcnt vmcnt(0)" ::: "memory");
            const unsigned og = xb_add(&bar[XB_TOP], 1u);
            const unsigned tg = og / nx;
            if (og + 1u == (tg + 1u) * nx) xb_add(&bar[XB_TOPGEN], 1u);
            else XB_SPIN(xb_ld(&bar[XB_TOPGEN]) == tg, bar);
            __builtin_amdgcn_fence(__ATOMIC_ACQUIRE, "agent");
            xb_add(&bar[XB_XGEN(b.x)], 1u);
            asm volatile("s_waitcnt vmcnt(0)" ::: "memory");
        } else {
            XB_SPIN(xb_ld(&bar[XB_XGEN(b.x)]) == gen, bar);
            __builtin_amdgcn_fence(__ATOMIC_ACQUIRE, "agent");
            asm volatile("s_waitcnt vmcnt(0)" ::: "memory");
        }
    }
    __syncthreads();
}

DEVI unsigned pack_fp8x4(float a, float b, float c, float d);
namespace pg8 {
constexpr int BM = 256, BK = 64, HALF = 128, HTB = HALF * BK * 2, STAGE_BYTES = 8 * HTB, NXCD = 8, WGM = 8;
DEVI int lds_byte(int r, int c) { const int st = (r >> 4) * 2 + (c >> 5), rr = r & 15, cc = c & 31, ob = rr * 64 + cc * 2; return st * 1024 + (ob ^ (((ob >> 9) & 1) << 5)); }
DEVI void stage_rc(int b, int& R, int& C) { const int st = b / 1024, sb = b % 1024, swz = sb ^ (((sb >> 9) & 1) << 5); R = (st >> 1) * 16 + swz / 64; C = (st & 1) * 32 + (swz % 64) / 2; }
DEVI int perm32(int rho) { const int n = rho >> 4, i = rho & 15; return 8 * (i >> 2) + 4 * n + (i & 3); }
struct Unit { int pm, pn, aux, seq; };
struct Gemm { const bf16_t* A; const bf16_t* Bt; int lda; int K; int sa = 0x7f7f7f7f; };
DEVI bool static_unit(int nM, int nN, long L, Unit& u) {
    const int nwg = nM * nN; if (L >= nwg) return false;
    int wgid = (int)L; { const int q = nwg / NXCD, r = nwg % NXCD, xcd = wgid % NXCD, off = wgid / NXCD; wgid = (xcd < r ? xcd * (q + 1) : r * (q + 1) + (xcd - r) * q) + off; }
    const int nig = WGM * nN, gid = wgid / nig, fm = gid * WGM, gsz = (nM - fm) < WGM ? (nM - fm) : WGM;
    u.pm = fm + ((wgid % nig) % gsz); u.pn = (wgid % nig) / gsz; u.aux = 0; return true;
}

typedef int v4i_t __attribute__((ext_vector_type(4)));
typedef int v8i_t __attribute__((ext_vector_type(8)));
template <class Epi, class Sched, bool AFTER_DRAIN = false, bool HB = false, bool F8 = false>
DEVI void gemm_phase(LAS unsigned char* lds, const Gemm g, const Sched& S, const Epi& E) {
    static_assert(!F8 || HB, "the fp8 body is the half-width one");
    const int tid = threadIdx.x, wid = __builtin_amdgcn_readfirstlane(tid >> 6), lane = tid & 63, wr = wid >> 2, wc = wid & 3, fr = lane & 15, fq = lane >> 4;
    const int K = g.K, nt = K / BK;
    int sR[2], sC[2]; unsigned voffB[2];
#pragma unroll
    for (int i = 0; i < 2; ++i) { int R, C; stage_rc(tid * 16 + i * 8192, R, C); sR[i] = R; sC[i] = C; const int Rb = (R & ~31) + perm32(R & 31); voffB[i] = (unsigned)(Rb * K + C) * 2u; }
    const size_t kstep = (size_t)(BK * 2);
    const size_t hstepB = (size_t)HALF * K * 2;
    const size_t tstepB = HB ? hstepB : 2 * hstepB;
    const unsigned ldsw = (unsigned)wid * 1024u;
    const int aoff = lds_byte(wr * 64 + fr, fq * 8), boff = lds_byte(wc * 32 + fr, fq * 8);
#define PG8_SA(b, h) (((b) * 2 + (h)) * HTB)
#define PG8_SB(b, h) ((4 + (b) * 2 + (h)) * HTB)
#define PG8_STAGE(bufoff, gbase, voff) do { _Pragma("unroll") for (int _i = 0; _i < 2; ++_i) \
        __builtin_amdgcn_global_load_lds((const unsigned*)((const char*)(gbase) + (voff)[_i]), (LAS unsigned*)(lds + (bufoff) + ldsw + _i * 8192), 16, 0, 0); } while (0)
#define PG8_LD8(P) __builtin_shufflevector(*(const LAS v4i_t*)(P), *(const LAS v4i_t*)((P) + 1024), 0, 1, 2, 3, 4, 5, 6, 7)
#define PG8_LDA(dst, b, h) do { _Pragma("unroll") for (int m = 0; m < 4; ++m) { if constexpr (F8) dst##8[m] = PG8_LD8(lds + PG8_SA(b, h) + aoff + m * 2048); \
        else { _Pragma("unroll") for (int k = 0; k < 2; ++k) dst[m][k] = *(const LAS bf16x8*)(lds + PG8_SA(b, h) + aoff + m * 2048 + k * 1024); } } } while (0)
#define PG8_LDB(dst, b, h) do { _Pragma("unroll") for (int n = 0; n < 2; ++n) { if constexpr (F8) dst##8[n] = PG8_LD8(lds + PG8_SB(b, h) + boff + n * 2048); \
        else { _Pragma("unroll") for (int k = 0; k < 2; ++k) dst[n][k] = *(const LAS bf16x8*)(lds + PG8_SB(b, h) + boff + n * 2048 + k * 1024); } } } while (0)
#define PG8_MMA(ai, bj, At, Bt) do { __builtin_amdgcn_s_setprio(1); _Pragma("unroll") for (int m = 0; m < 4; ++m) _Pragma("unroll") for (int n = 0; n < 2; ++n) { \
        if constexpr (F8) acc[ai][bj][m][n] = __builtin_amdgcn_mfma_scale_f32_16x16x128_f8f6f4(Bt##8[n], At##8[m], acc[ai][bj][m][n], 0, 0, 0, g.sa, 0, 0x7f7f7f7f); \
        else { _Pragma("unroll") for (int k = 0; k < 2; ++k) acc[ai][bj][m][n] = __builtin_amdgcn_mfma_f32_16x16x32_bf16(Bt[n][k], At[m][k], acc[ai][bj][m][n], 0, 0, 0); } } \
        __builtin_amdgcn_s_setprio(0); } while (0)
#define PG8_WAIT_LOOP do { if constexpr (HB) PG8_WAIT_V(6); else PG8_WAIT_V(8); } while (0)
#define PG8_WAIT_V(n) asm volatile("s_waitcnt vmcnt(" #n ")" ::: "memory")
#define PG8_WAIT_L(n) asm volatile("s_waitcnt lgkmcnt(" #n ")" ::: "memory")
#define PG8_BAR __builtin_amdgcn_s_barrier()
#define PG8_SCHED __builtin_amdgcn_sched_barrier(0)
#define PG8_AOFFS(dst, u) do { _Pragma("unroll") for (int _h = 0; _h < 2; ++_h) _Pragma("unroll") for (int _i = 0; _i < 2; ++_i) \
        { const int raw_ = S.arow(u, _h * HALF + sR[_i]); dst[_h][_i] = ((unsigned)(raw_ < 0 ? 0 : raw_) * (unsigned)g.lda + (unsigned)sC[_i]) * 2u; } } while (0)
    Unit cur, nxt; int ui = 0;
    if (!S.next(0, cur)) return;
    f32x4 acc[2][2][4][2];
#pragma unroll
    for (int a = 0; a < 2; ++a)
#pragma unroll
        for (int b = 0; b < 2; ++b)
#pragma unroll
            for (int m = 0; m < 4; ++m)
#pragma unroll
                for (int n = 0; n < 2; ++n) acc[a][b][m][n] = (f32x4){0.f, 0.f, 0.f, 0.f};
    bf16x8 At[4][2], B0[2][2], B1[2][2]; v8i_t At8[4], B08[2], B18[2];
    unsigned cOff[2][2], nOff[2][2];
    PG8_AOFFS(cOff, cur);
    bool has_next = S.next(1, nxt);
    if (has_next) { PG8_AOFFS(nOff, nxt); } else {
#pragma unroll
        for (int _h = 0; _h < 2; ++_h)
#pragma unroll
            for (int _i = 0; _i < 2; ++_i) nOff[_h][_i] = cOff[_h][_i]; }
    const char* gA = (const char*)g.A;
    const char* cB = (const char*)g.Bt + (size_t)cur.pn * tstepB;
    PG8_STAGE(PG8_SB(0, 0), cB, voffB); if constexpr (!HB) PG8_STAGE(PG8_SB(0, 1), cB + hstepB, voffB); PG8_STAGE(PG8_SA(0, 0), gA, cOff[0]); PG8_STAGE(PG8_SA(0, 1), gA, cOff[1]);
    if (wr == 1) PG8_BAR;
    PG8_WAIT_V(2); PG8_BAR;
    PG8_STAGE(PG8_SB(1, 0), cB + kstep, voffB); PG8_STAGE(PG8_SA(1, 0), gA + kstep, cOff[0]); if constexpr (!HB) PG8_STAGE(PG8_SB(1, 1), cB + hstepB + kstep, voffB);
    if constexpr (HB) PG8_WAIT_V(4); else PG8_WAIT_V(6);
    PG8_BAR;
    for (;;) {
        const char* nB = has_next ? (const char*)g.Bt + (size_t)nxt.pn * tstepB : cB;
        cur.seq = ui;
        if constexpr (Epi::PRE) E.prefetch(lds, cur, wid, lane);
        Unit nn; int nnRaw[2][2];
        const bool has_nn = has_next && S.next(ui + 2, nn);
        if constexpr (Sched::IDX_DMA) { if (has_nn) S.idx_dma(lds, nn, ui, wid, lane); }
        else {
#pragma unroll
            for (int _h = 0; _h < 2; ++_h)
#pragma unroll
                for (int _i = 0; _i < 2; ++_i) nnRaw[_h][_i] = has_nn ? S.arow(nn, _h * HALF + sR[_i]) : 0; }
#pragma unroll 1
        for (int t = 0; t < nt; t += 2) {
            const bool last = (t == nt - 2);
            const char* a1 = gA + (size_t)(t + 1) * kstep;
            const char* a2 = last ? gA : gA + (size_t)(t + 2) * kstep; const char* b2 = last ? nB : cB + (size_t)(t + 2) * kstep;
            const char* a3 = a2 + kstep; const char* b3 = b2 + kstep;
            unsigned o2[2][2];
#pragma unroll
            for (int _h = 0; _h < 2; ++_h)
#pragma unroll
                for (int _i = 0; _i < 2; ++_i) o2[_h][_i] = last ? nOff[_h][_i] : cOff[_h][_i];
            PG8_LDB(B0, 0, 0); if constexpr (!HB) PG8_LDB(B1, 0, 1); PG8_SCHED; PG8_LDA(At, 0, 0); PG8_STAGE(PG8_SA(1, 1), a1, cOff[1]);
            PG8_WAIT_LOOP; PG8_WAIT_L(0); PG8_BAR; PG8_MMA(0, 0, At, B0); if constexpr (!HB) PG8_MMA(0, 1, At, B1); PG8_BAR; PG8_SCHED;
            PG8_LDA(At, 0, 1); PG8_STAGE(PG8_SB(0, 0), b2, voffB); if constexpr (!HB) PG8_STAGE(PG8_SB(0, 1), b2 + hstepB, voffB); PG8_STAGE(PG8_SA(0, 0), a2, o2[0]);
            PG8_WAIT_LOOP; PG8_WAIT_L(0); PG8_BAR; PG8_MMA(1, 0, At, B0); if constexpr (!HB) PG8_MMA(1, 1, At, B1); PG8_BAR; PG8_SCHED;
            PG8_LDB(B0, 1, 0); if constexpr (!HB) PG8_LDB(B1, 1, 1); PG8_SCHED; PG8_LDA(At, 1, 0); PG8_STAGE(PG8_SA(0, 1), a2, o2[1]);
            PG8_WAIT_LOOP; PG8_WAIT_L(0); PG8_BAR; PG8_MMA(0, 0, At, B0); if constexpr (!HB) PG8_MMA(0, 1, At, B1); PG8_BAR; PG8_SCHED;
            PG8_LDA(At, 1, 1); PG8_STAGE(PG8_SB(1, 0), b3, voffB); if constexpr (!HB) PG8_STAGE(PG8_SB(1, 1), b3 + hstepB, voffB); PG8_STAGE(PG8_SA(1, 0), a3, o2[0]);
            PG8_WAIT_LOOP; PG8_WAIT_L(0); PG8_BAR; PG8_MMA(1, 0, At, B0); if constexpr (!HB) PG8_MMA(1, 1, At, B1); PG8_BAR; PG8_SCHED;
        }
        if (wr == 0) PG8_BAR;
        if constexpr (!AFTER_DRAIN) E(acc, cur, wr, wc, fr, fq);
        if (!has_next) break;
#pragma unroll
        for (int a = 0; a < 2; ++a)
#pragma unroll
            for (int b = 0; b < 2; ++b)
#pragma unroll
                for (int m = 0; m < 4; ++m)
#pragma unroll
                    for (int n = 0; n < 2; ++n) acc[a][b][m][n] = (f32x4){0.f, 0.f, 0.f, 0.f};
        cur = nxt; cB = nB; ++ui; nxt = nn; has_next = has_nn;
#pragma unroll
        for (int _h = 0; _h < 2; ++_h)
#pragma unroll
            for (int _i = 0; _i < 2; ++_i) { int raw;
                if constexpr (Sched::IDX_DMA) raw = has_nn ? S.idx_lds(lds, ui - 1, _h * HALF + sR[_i]) : 0; else { raw = nnRaw[_h][_i]; asm volatile("" : "+v"(raw)); }
                cOff[_h][_i] = nOff[_h][_i]; if (has_nn) nOff[_h][_i] = ((unsigned)(raw < 0 ? 0 : raw) * (unsigned)g.lda + (unsigned)sC[_i]) * 2u; }
        if (wr == 1) PG8_BAR;
    }
    PG8_WAIT_V(0);
    PG8_BAR;
    if constexpr (AFTER_DRAIN) E(acc, cur, wr, wc, fr, fq);
#undef PG8_SA
#undef PG8_SB
#undef PG8_STAGE
#undef PG8_LDA
#undef PG8_LD8
#undef PG8_WAIT_LOOP
#undef PG8_LDB
#undef PG8_MMA
#undef PG8_WAIT_V
#undef PG8_WAIT_L
#undef PG8_BAR
#undef PG8_SCHED
#undef PG8_AOFFS
}

template <class Epi, class Sched, int GRP>
DEVI void gemm_phase_astat8(LAS unsigned char* lds, const Gemm g, const Sched& S, const Epi& E) {
    const int tid = threadIdx.x, wid = __builtin_amdgcn_readfirstlane(tid >> 6), lane = tid & 63, wr = GRP, wc = wid & 3, fr = lane & 15, fq = lane >> 4;
    const int K = g.K;
    int sR[2], sC[2]; unsigned voffB[2], vA[2][2];
#pragma unroll
    for (int i = 0; i < 2; ++i) { int R, C; stage_rc(tid * 16 + i * 8192, R, C); sR[i] = R; sC[i] = C; const int Rb = (R & ~31) + perm32(R & 31); voffB[i] = (unsigned)(Rb * K + C) * 2u; }
#pragma unroll
    for (int h = 0; h < 2; ++h)
#pragma unroll
        for (int i = 0; i < 2; ++i) vA[h][i] = ((unsigned)(h * HALF + sR[i]) * (unsigned)g.lda + (unsigned)sC[i]) * 2u;
    const size_t kstep = (size_t)(BK * 2);
    const size_t tstepB = (size_t)HALF * K * 2;
    const unsigned ldsw = (unsigned)wid * 1024u;
    const int aoff = lds_byte(wr * 64 + fr, fq * 8), boff = lds_byte(wc * 32 + fr, fq * 8);
#define AS_STAGE(bufoff, gbase, voff) do { _Pragma("unroll") for (int _i = 0; _i < 2; ++_i) \
        __builtin_amdgcn_global_load_lds((const unsigned*)((const char*)(gbase) + (voff)[_i]), (LAS unsigned*)(lds + (bufoff) + ldsw + _i * 8192), 16, 0, 0); } while (0)
#define AS_STAGE_A(kt, pm_) do { const char* ab_ = gA + (size_t)(pm_) * 256u * (size_t)g.lda * 2u + (size_t)(kt) * kstep; \
        AS_STAGE(((kt) * 2) * HTB, ab_, vA[0]); AS_STAGE(((kt) * 2 + 1) * HTB, ab_, vA[1]); } while (0)
#define AS_STAGE_B(ht, Bp, kt) AS_STAGE((4 + (ht)) * HTB, (Bp) + (size_t)(kt) * kstep, voffB)
#define AS_LD8(P) __builtin_shufflevector(*(const LAS v4i_t*)(P), *(const LAS v4i_t*)((P) + 1024), 0, 1, 2, 3, 4, 5, 6, 7)
#define AS_LOADF(kt, slot) do { \
        _Pragma("unroll") for (int n = 0; n < 2; ++n) b8[n] = AS_LD8(lds + (4 + (slot) * 2 + (kt)) * HTB + boff + n * 2048); \
        _Pragma("unroll") for (int a = 0; a < 2; ++a) _Pragma("unroll") for (int m = 0; m < 4; ++m) a8[a][m] = AS_LD8(lds + ((kt) * 2 + a) * HTB + aoff + m * 2048); } while (0)
#define AS_MMA() do { __builtin_amdgcn_s_setprio(1); \
        _Pragma("unroll") for (int a = 0; a < 2; ++a) _Pragma("unroll") for (int m = 0; m < 4; ++m) _Pragma("unroll") for (int n = 0; n < 2; ++n) \
            acc[a][0][m][n] = __builtin_amdgcn_mfma_scale_f32_16x16x128_f8f6f4(b8[n], a8[a][m], acc[a][0][m][n], 0, 0, 0, g.sa, 0, 0x7f7f7f7f); \
        __builtin_amdgcn_s_setprio(0); } while (0)
#define AS_ZERO() do { _Pragma("unroll") for (int a = 0; a < 2; ++a) _Pragma("unroll") for (int m = 0; m < 4; ++m) _Pragma("unroll") for (int n = 0; n < 2; ++n) acc[a][0][m][n] = (f32x4){0.f, 0.f, 0.f, 0.f}; } while (0)
#define AS_WAIT(N) asm volatile("s_waitcnt vmcnt(" #N ") lgkmcnt(0)" ::: "memory")
#define AS_LWAIT() do { asm volatile("s_waitcnt lgkmcnt(0)" ::: "memory"); __builtin_amdgcn_sched_barrier(0); } while (0)
    static_assert(Epi::NST == 8, "the counted waits below assume 8 stores per epilogue");
    Unit cur, nxt, prv; int ui = 0;
    if (!S.next(0, cur)) return;
    prv = cur;
    f32x4 acc[2][2][4][2];
    AS_ZERO();
    v8i_t b8[2], a8[2][4];
    bool has_next = S.next(1, nxt);
    const char* gA = (const char*)g.A;
    const char* cB = (const char*)g.Bt + (size_t)cur.pn * tstepB;
    AS_STAGE_A(0, cur.pm); AS_STAGE_A(1, cur.pm); AS_STAGE_B(0, cB, 0); AS_STAGE_B(1, cB, 1);
    bool switched = false;
    for (;;) {
        const char* nB = has_next ? (const char*)g.Bt + (size_t)nxt.pn * tstepB : cB;
        const int slot = ui & 1;
        if (ui == 0 || (GRP == 1 && ui == 1)) AS_WAIT(0); else AS_WAIT(8);
        __builtin_amdgcn_s_barrier();
        __builtin_amdgcn_sched_barrier(0);
        if (switched) {
            AS_STAGE_A(0, cur.pm); AS_STAGE_A(1, cur.pm);
            asm volatile("s_waitcnt vmcnt(0)" ::: "memory");
            __builtin_amdgcn_s_barrier();
            __builtin_amdgcn_sched_barrier(0);
        }
        AS_STAGE_B((slot ^ 1) * 2, nB, 0); AS_STAGE_B((slot ^ 1) * 2 + 1, nB, 1);
        if constexpr (GRP == 0) {
            AS_LOADF(0, slot); AS_LWAIT(); AS_MMA(); __builtin_amdgcn_sched_barrier(0);
            AS_LOADF(1, slot); AS_LWAIT(); AS_MMA(); __builtin_amdgcn_sched_barrier(0);
            E(acc, cur, wr, wc, fr, fq); AS_ZERO();
        } else {
            if (ui > 0) { AS_MMA(); __builtin_amdgcn_sched_barrier(0); E(acc, prv, wr, wc, fr, fq); AS_ZERO(); }
            __builtin_amdgcn_sched_barrier(0);
            AS_LOADF(0, slot); AS_LWAIT(); AS_MMA(); __builtin_amdgcn_sched_barrier(0);
            AS_LOADF(1, slot);
        }
        __builtin_amdgcn_sched_barrier(0);
        prv = cur;
        if (!has_next) break;
        switched = nxt.pm != cur.pm; cur = nxt; cB = nB; ++ui; has_next = S.next(ui + 1, nxt);
    }
    if constexpr (GRP == 1) { AS_LWAIT(); AS_MMA(); E(acc, prv, wr, wc, fr, fq); }
    asm volatile("s_waitcnt vmcnt(0)" ::: "memory");
    __builtin_amdgcn_s_barrier();
#undef AS_LOADF
#undef AS_MMA
#undef AS_WAIT
#undef AS_LWAIT
#undef AS_STAGE
#undef AS_STAGE_A
#undef AS_STAGE_B
#undef AS_LD8
#undef AS_ZERO
}

struct DnArgs { const unsigned char* A; const unsigned char* Bt; unsigned char* O; int hh; int sa; };
template <class Sched>
DEVI void gemm_phase_dnreg(LAS unsigned char* lds, const DnArgs g, const Sched& S) {
    const int tid = threadIdx.x, wid = __builtin_amdgcn_readfirstlane(tid >> 6), lane = tid & 63, fr = lane & 15, fq = lane >> 4;
    constexpr int KB = 256;
    unsigned voffB[2];
#pragma unroll
    for (int i = 0; i < 2; ++i) { int R, C; stage_rc(tid * 16 + i * 8192, R, C); const int j = R >> 4, q4 = (R >> 2) & 3, r = R & 3;
        const int col = 64 * (j >> 2) + 16 * q4 + 4 * (j & 3) + r; voffB[i] = (unsigned)(col * KB + C * 2); }
    const unsigned ldsw = (unsigned)wid * 1024u;
    const int boff = lds_byte(fr, fq * 8);
#define DN_STAGE_B(slot, Bp, kt) do { _Pragma("unroll") for (int _i = 0; _i < 2; ++_i) \
        __builtin_amdgcn_global_load_lds((const unsigned*)((Bp) + (kt) * 128 + voffB[_i]), (LAS unsigned*)(lds + (slot) * HTB + ldsw + _i * 8192), 16, 0, 0); } while (0)
#define DN_LOADA(dst, pm_) do { const unsigned char* ap_ = g.A + ((size_t)(pm_) * 256u + 32u * wid + fr) * KB + 16 * fq; \
        _Pragma("unroll") for (int kt = 0; kt < 2; ++kt) _Pragma("unroll") for (int m = 0; m < 2; ++m) { \
            const v4i_t lo_ = *(const v4i_t*)(ap_ + m * 16 * KB + kt * 128), hi_ = *(const v4i_t*)(ap_ + m * 16 * KB + kt * 128 + 64); \
            dst[kt][m] = __builtin_shufflevector(lo_, hi_, 0, 1, 2, 3, 4, 5, 6, 7); } } while (0)
#define DN_LD8(P) __builtin_shufflevector(*(const LAS v4i_t*)(P), *(const LAS v4i_t*)((P) + 1024), 0, 1, 2, 3, 4, 5, 6, 7)
#define DN_TILE(kt, slot) do { v8i_t b8[8]; \
        _Pragma("unroll") for (int j = 0; j < 8; ++j) b8[j] = DN_LD8(lds + (slot) * HTB + boff + j * 2048); \
        __builtin_amdgcn_s_setprio(1); \
        _Pragma("unroll") for (int j = 0; j < 8; ++j) _Pragma("unroll") for (int m = 0; m < 2; ++m) \
            acc[m][j] = __builtin_amdgcn_mfma_scale_f32_16x16x128_f8f6f4(b8[j], a8[kt][m], acc[m][j], 0, 0, 0, g.sa, 0, 0x7f7f7f7f); \
        __builtin_amdgcn_s_setprio(0); } while (0)
    Unit cur, nxt, fut;
    if (!S.next(0, cur)) return;
    f32x4 acc[2][8];
#pragma unroll
    for (int m = 0; m < 2; ++m)
#pragma unroll
        for (int j = 0; j < 8; ++j) acc[m][j] = (f32x4){0.f, 0.f, 0.f, 0.f};
    v8i_t a8[2][2], a8n[2][2];
    constexpr size_t TB = (size_t)128 * KB;
#pragma unroll
    for (int v = 0; v < 3; ++v) { Unit uv; const bool ok = S.next(v, uv); const unsigned char* bp = g.Bt + (size_t)(ok ? uv.pn : cur.pn) * TB;
        DN_STAGE_B(2 * v, bp, 0); DN_STAGE_B(2 * v + 1, bp, 1); }
    DN_LOADA(a8, cur.pm);
#pragma unroll
    for (int kt = 0; kt < 2; ++kt)
#pragma unroll
        for (int m = 0; m < 2; ++m) a8n[kt][m] = a8[kt][m];
    bool has_next = S.next(1, nxt);
    for (int ui = 0;; ++ui) {
        asm volatile("s_waitcnt vmcnt(8) lgkmcnt(0)" ::: "memory");
        __builtin_amdgcn_s_barrier();
        __builtin_amdgcn_sched_barrier(0);
        { const bool okf = S.next(ui + 3, fut); const unsigned char* bp = g.Bt + (size_t)(okf ? fut.pn : cur.pn) * TB;
          const int s3 = (2 * ui + 6) & 7; DN_STAGE_B(s3, bp, 0); DN_STAGE_B(s3 + 1, bp, 1); }
        const bool sw = has_next && nxt.pm != cur.pm;
        if (sw) DN_LOADA(a8n, nxt.pm);
        __builtin_amdgcn_sched_barrier(0);
        const int s0 = (2 * ui) & 7;
        DN_TILE(0, s0);
        DN_TILE(1, s0 + 1);
        {
            int frr = fr, fqq = fq; asm volatile("" : "+v"(frr), "+v"(fqq));
            unsigned char* op = g.O + (size_t)((cur.pm - g.hh * HTILES) * 256 + 32 * wid + frr) * DM + cur.aux * 128 + 16 * fqq;
#pragma unroll
            for (int m = 0; m < 2; ++m)
#pragma unroll
                for (int hf = 0; hf < 2; ++hf) { u32x4 o;
#pragma unroll
                    for (int jj = 0; jj < 4; ++jj) { const f32x4 v = acc[m][4 * hf + jj]; o[jj] = pack_fp8x4(v[0], v[1], v[2], v[3]); }
                    *(u32x4*)(op + (size_t)m * 16 * DM + 64 * hf) = o; }
        }
        if (!has_next) break;
#pragma unroll
        for (int m = 0; m < 2; ++m)
#pragma unroll
            for (int j = 0; j < 8; ++j) acc[m][j] = (f32x4){0.f, 0.f, 0.f, 0.f};
        if (sw) {
#pragma unroll
            for (int kt = 0; kt < 2; ++kt)
#pragma unroll
                for (int m = 0; m < 2; ++m) a8[kt][m] = a8n[kt][m]; }
        cur = nxt; has_next = S.next(ui + 2, nxt);
    }
    asm volatile("s_waitcnt vmcnt(0)" ::: "memory");
    __builtin_amdgcn_s_barrier();
#undef DN_STAGE_B
#undef DN_LOADA
#undef DN_LD8
#undef DN_TILE
}
}


struct Frame {
    LAS unsigned char* lds;
    int tid, lane, wave, G, blk;
    const Params* p;
    unsigned char* ws;
};

DEVI float clamp_fp8(float x) { return __builtin_amdgcn_fmed3f(x, -440.f, 440.f); }
DEVI unsigned pack_fp8x4(float a, float b, float c, float d) { int p = __builtin_amdgcn_cvt_pk_fp8_f32(clamp_fp8(a), clamp_fp8(b), 0, false); p = __builtin_amdgcn_cvt_pk_fp8_f32(clamp_fp8(c), clamp_fp8(d), p, true); return (unsigned)p; }
template <class SrcF>
DEVI void transpose_item8(const SrcF& src, unsigned char* WT8, int K, int k0, int n0, LAS float* scr, int lane, float scale) {
    float tv_[32];
#pragma unroll
    for (int i = 0; i < 32; ++i) { const int kk = 2 * i + (lane >> 5); tv_[i] = *src(k0 + kk, n0 + (lane & 31)); }
#pragma unroll
    for (int i = 0; i < 32; ++i) { const int kk = 2 * i + (lane >> 5); scr[kk * 33 + (lane & 31)] = tv_[i]; }
    LDS_WAIT(); asm volatile("" ::: "memory");
    const int n = lane >> 1, hf = lane & 1; const LAS float* sp = scr + (32 * hf) * 33 + n;
    u32x4 o0, o1;
#pragma unroll
    for (int q = 0; q < 4; ++q) { o0[q] = pack_fp8x4(sp[(4 * q) * 33] * scale, sp[(4 * q + 1) * 33] * scale, sp[(4 * q + 2) * 33] * scale, sp[(4 * q + 3) * 33] * scale);
        o1[q] = pack_fp8x4(sp[(16 + 4 * q) * 33] * scale, sp[(17 + 4 * q) * 33] * scale, sp[(18 + 4 * q) * 33] * scale, sp[(19 + 4 * q) * 33] * scale); }
    unsigned char* dst = WT8 + (size_t)(n0 + n) * K + k0 + 32 * hf;
    *(u32x4*)dst = o0; *(u32x4*)(dst + 16) = o1;
    LDS_WAIT(); asm volatile("" ::: "memory");
}
template <class SrcF>
DEVI void transpose_item(const SrcF& src, bf16_t* WT, int K, int k0, int n0, LAS float* scr, int lane) {
    float tv_[32];
#pragma unroll
    for (int i = 0; i < 32; ++i) { const int kk = 2 * i + (lane >> 5); tv_[i] = *src(k0 + kk, n0 + (lane & 31)); }
#pragma unroll
    for (int i = 0; i < 32; ++i) { const int kk = 2 * i + (lane >> 5); scr[kk * 33 + (lane & 31)] = tv_[i]; }
    LDS_WAIT(); asm volatile("" ::: "memory");
    const int c = lane & 7;
#pragma unroll
    for (int j = 0; j < 4; ++j) { const int n = (lane >> 3) + 8 * j; const LAS float* s = scr + (8 * c) * 33 + n;
        u32x4 o; o.x = cvt_pk_bf16(s[0 * 33], s[1 * 33]); o.y = cvt_pk_bf16(s[2 * 33], s[3 * 33]); o.z = cvt_pk_bf16(s[4 * 33], s[5 * 33]); o.w = cvt_pk_bf16(s[6 * 33], s[7 * 33]);
        *(u32x4*)(WT + (size_t)(n0 + n) * K + k0 + 8 * c) = o; }
    LDS_WAIT(); asm volatile("" ::: "memory");
}
DEVI int win_src_col(int c) {
    const int sec = c >> 9, h = (c >> 7) & 3, s = c & 127;
    int ssec = sec;
    if (sec == 3) ssec = 4; else if (sec == 4) ssec = 5; else if (sec == 5) ssec = 6; else if (sec == 6) ssec = 3;
    int d = s;
    if (sec < 2) { const int wc = s >> 5, fq = (s >> 3) & 3, n = (s >> 2) & 1, i = s & 3; d = 64 * n + 16 * wc + 4 * fq + i; }
    return ssec * 512 + h * 128 + d;
}
struct SrcWin { const float* w; DEVI const float* operator()(int k, int n) const { return w + (size_t)k * INC + win_src_col(n); } };
struct SrcPlain { const float* w; int N; DEVI const float* operator()(int k, int n) const { return w + (size_t)k * N + n; } };
struct SrcGU { const float* wg; long dwu; DEVI const float* operator()(int k, int r) const {
        const int ff = 64 * (r >> 7) + 16 * ((r >> 5) & 3) + 4 * ((r >> 3) & 3) + (r & 3); const long sel = ((r >> 2) & 1) ? dwu : 0l; return wg + ((long)k * EFF + ff + sel); } };

DEVI void phase_prep(Frame& F) {
    const Params& P = *F.p;
    for (int mi = F.blk; mi < 192; mi += F.G) {
        LAS float* sc = (LAS float*)F.lds;
        LAS float* red = sc + 9 * 1024;
        { float cv_[18];
#pragma unroll
          for (int q = 0; q < 18; ++q) { const int i = F.tid + NTHREADS * q, v = i >> 10, k = i & 1023; cv_[q] = v < 8 ? P.in[I_C][v * DM + k] : P.in[I_CCTX][k]; }
#pragma unroll
          for (int q = 0; q < 18; ++q) sc[F.tid + NTHREADS * q] = cv_[q] / (1.f + __expf(-cv_[q])); }
        __syncthreads();
        const int c = F.tid & 31, ks = F.tid >> 5, n = mi * 32 + c;
        float a[9];
#pragma unroll
        for (int v = 0; v < 9; ++v) a[v] = 0.f;
        const float* w = P.in[I_WMOD] + (size_t)(ks * 64) * 6144 + n;
        float wv_[64];
#pragma unroll
        for (int k = 0; k < 64; ++k) wv_[k] = w[(size_t)k * 6144];
#pragma unroll
        for (int k = 0; k < 64; ++k) {
#pragma unroll
            for (int v = 0; v < 9; ++v) a[v] += sc[v * 1024 + ks * 64 + k] * wv_[k]; }
#pragma unroll
        for (int v = 0; v < 9; ++v) red[(ks * 9 + v) * 32 + c] = a[v];
        __syncthreads();
        for (int i = F.tid; i < 9 * 32; i += NTHREADS) { const int v = i >> 5, cc = i & 31; float sum = P.in[I_BMOD][mi * 32 + cc];
#pragma unroll
            for (int q = 0; q < 16; ++q) sum += red[(q * 9 + v) * 32 + cc];
            ((float*)(F.ws + WS_MODP))[(size_t)v * 6144 + mi * 32 + cc] = sum; }
        __syncthreads();
    }
    for (int i = F.blk * NTHREADS + F.tid; i < 128 * 1024; i += F.G * NTHREADS) { const int r = i >> 10, k = i & 1023; bf16_t v;
        if (r < 64) v = f2bf(P.in[I_WR][k * NE + r]);
        else { const float w = P.in[I_WR][k * NE + r - 64]; v = f2bf(w - bf2f(f2bf(w))); }
        ((bf16_t*)(F.ws + WS_WRT))[i] = v; }
    LAS float* scr = (LAS float*)(F.lds + 57344 + F.wave * 8704);
    const bool split = F.G >= 192 + 32;
    if (split && F.blk < 192) return;
    const int gw = (split ? F.blk - 192 : F.blk) * NWAVES + F.wave, NGW = (split ? F.G - 192 : F.G) * NWAVES;
    constexpr int I_IN = (DM / 64) * (PN / 32), I_OUT = (DM / 64) * (DM / 32);
    for (int it = gw; it < I_IN + I_OUT; it += NGW) {
        if (it < I_IN) { const int kb = it / (PN / 32), nb = it % (PN / 32); transpose_item(SrcWin{P.in[I_WIN]}, (bf16_t*)(F.ws + WS_WINT), DM, kb * 64, nb * 32, scr, F.lane); }
        else { const int r = it - I_IN, kb = r / (DM / 32), nb = r % (DM / 32); transpose_item(SrcPlain{P.in[I_WOUT], DM}, (bf16_t*)(F.ws + WS_WOUTT), DM, kb * 64, nb * 32, scr, F.lane); }
    }
}
DEVI float mod_value(Frame& F, int v, int n) { return ((const float*)(F.ws + WS_MODP))[(size_t)v * 6144 + n]; }

DEVI void phase_norm1(Frame& F) {
    const Params& P = *F.p;
    LAS float* WG = (LAS float*)F.lds;
    LAS float* MODS = (LAS float*)(F.lds + 65536);
    for (int i0 = 0; i0 < 16 * 1024; i0 += 16 * NTHREADS) { float tv[16];
#pragma unroll
        for (int q = 0; q < 16; ++q) { const int i = i0 + F.tid + q * NTHREADS; tv[q] = P.in[I_WIN][(size_t)(i >> 4) * INC + 4096 + (i & 15)]; }
#pragma unroll
        for (int q = 0; q < 16; ++q) { const int i = i0 + F.tid + q * NTHREADS; WG[(i & 15) * 1024 + (i >> 4)] = tv[q]; } }
    for (int i0 = 0; i0 < 9 * 2048; i0 += 18 * NTHREADS) { float tv[18];
#pragma unroll
        for (int q = 0; q < 18; ++q) { const int i = i0 + F.tid + q * NTHREADS; tv[q] = mod_value(F, i / 2048, i % 2048); }
#pragma unroll
        for (int q = 0; q < 18; ++q) { const int i = i0 + F.tid + q * NTHREADS; MODS[i] = (i % 2048) < 1024 ? tv[q] : 1.f + tv[q]; } }
    __syncthreads();
    const float* g0 = P.in[I_NORMG];
    f32x4 gv[4];
#pragma unroll
    for (int j = 0; j < 4; ++j) gv[j] = *(const f32x4*)(g0 + 256 * j + 4 * F.lane);
    float gb = 0.f; if (F.lane < 16) gb = P.in[I_GATEB][F.lane];
    f32x4 wreg[8][4];
#pragma unroll
    for (int gj = 0; gj < 8; ++gj)
#pragma unroll
        for (int j = 0; j < 4; ++j) wreg[gj][j] = *(const LAS f32x4*)(WG + gj * 1024 + 256 * j + 4 * F.lane);
    bf16_t* HL = (bf16_t*)(F.ws + WS_B); float* GT = (float*)(F.ws + WS_GATES);
    const int gw = F.blk * NWAVES + F.wave, NGW = F.G * NWAVES;
    f32x4 xn[4];
    if (gw < TT) { const float* xr = gw < T ? P.in[I_X] + (size_t)gw * DM : P.in[I_CTX] + (size_t)(gw - T) * DM;
#pragma unroll
        for (int j = 0; j < 4; ++j) xn[j] = *(const f32x4*)(xr + 256 * j + 4 * F.lane); }
    for (int row = gw; row < TT; row += NGW) {
        const int v = row < T ? (row >> 13) : 8;
        f32x4 x[4]; float ss = 0.f;
#pragma unroll
        for (int j = 0; j < 4; ++j) { x[j] = xn[j]; ss += x[j].x * x[j].x + x[j].y * x[j].y + x[j].z * x[j].z + x[j].w * x[j].w; }
        { const int nr = row + NGW; if (nr < TT) { const float* xr = nr < T ? P.in[I_X] + (size_t)nr * DM : P.in[I_CTX] + (size_t)(nr - T) * DM;
#pragma unroll
            for (int j = 0; j < 4; ++j) xn[j] = *(const f32x4*)(xr + 256 * j + 4 * F.lane); } }
        const float rstd = rsqrtf(wave_sum(ss) * (1.f / DM) + EPS);
        const LAS float* ms = MODS + v * 2048;
#pragma unroll
        for (int j = 0; j < 4; ++j) { const f32x4 sh = *(const LAS f32x4*)(ms + 256 * j + 4 * F.lane), sc = *(const LAS f32x4*)(ms + 1024 + 256 * j + 4 * F.lane);
            x[j] = (x[j] * rstd * gv[j]) * sc + sh;
            u32x2 o; o.x = cvt_pk_bf16(x[j].x, x[j].y); o.y = cvt_pk_bf16(x[j].z, x[j].w);
            *(u32x2*)(HL + (size_t)row * DM + 256 * j + 4 * F.lane) = o; }
        float ga[16];
#pragma unroll
        for (int gj = 0; gj < 16; ++gj) { f32x2 a2 = (f32x2){0.f, 0.f};
#pragma unroll
            for (int j = 0; j < 4; ++j) { f32x4 w; if (gj < 8) w = wreg[gj][j]; else w = *(const LAS f32x4*)(WG + gj * 1024 + 256 * j + 4 * F.lane);
                a2 = __builtin_elementwise_fma(x[j].lo, w.lo, a2); a2 = __builtin_elementwise_fma(x[j].hi, w.hi, a2); }
            ga[gj] = a2.x + a2.y; }
        float myg;
        {   const bool b0 = F.lane & 1, b1 = F.lane & 2, b2 = F.lane & 4, b3 = F.lane & 8;
            float g8[8], g4[4], g2[2];
#pragma unroll
            for (int j = 0; j < 8; ++j) g8[j] = (b0 ? ga[2 * j + 1] : ga[2 * j]) + dpp_x1(b0 ? ga[2 * j] : ga[2 * j + 1]);
#pragma unroll
            for (int j = 0; j < 4; ++j) g4[j] = (b1 ? g8[2 * j + 1] : g8[2 * j]) + dpp_x2(b1 ? g8[2 * j] : g8[2 * j + 1]);
#pragma unroll
            for (int j = 0; j < 2; ++j) g2[j] = (b2 ? g4[2 * j + 1] : g4[2 * j]) + dpp_x4(b2 ? g4[2 * j] : g4[2 * j + 1]);
            myg = (b3 ? g2[1] : g2[0]) + dpp_x8(b3 ? g2[0] : g2[1]);
            myg += __shfl_xor(myg, 16); myg += __shfl_xor(myg, 32); }
        if (F.lane < 16) GT[(size_t)row * 16 + F.lane] = myg + gb;
    }
}

struct SchedProj {
    int G, c;
    DEVI bool next(int i, pg8::Unit& u) const {
        const long L = (long)i * G + c;
        if (L < 4096) return pg8::static_unit(256, 16, L, u);
        const int j = (int)(L - 4096); if (j >= 64) return false;
        const int ct = j & 7; u.pm = 256 + (j >> 3); u.pn = (ct < 4 ? 2 + ct : 4 + ct); u.aux = 0; return true;
    }
    DEVI int arow(const pg8::Unit& u, int r) const { return u.pm * 256 + r; }
    static constexpr bool IDX_DMA = false; };
struct EpiProj {
    bf16_t* O;
    static constexpr bool PRE = false;
    DEVI void operator()(const f32x4 (&acc)[2][2][4][2], const pg8::Unit& u, int wr, int wc, int fr, int fq) const {
        const int row0 = u.pm * 256 + wr * 64 + fr, col0 = u.pn * 256 + wc * 32 + 8 * fq;
        const bool rope = (u.pn < 4) && (u.pm < 256);
        const float qs = (u.pn < 2) ? 0.08838834764831845f : 1.f;
        float f2[4];
#pragma unroll
        for (int i = 0; i < 4; ++i) f2[i] = exp2f(-(float)(16 * (wc & 1) + 4 * fq + i) * (13.287712379549449f / 32.f)) * 0.15915494309189535f;
#pragma unroll
        for (int ai = 0; ai < 2; ++ai)
#pragma unroll
            for (int m = 0; m < 4; ++m) {
                const int row = row0 + ai * 128 + m * 16; const int pos = row & (SEQ - 1);
                const float pp = (float)((wc < 2) ? (pos >> 6) : (pos & 63));
                float cs[4], sn[4];
                if (rope) {
#pragma unroll
                    for (int i = 0; i < 4; ++i) { const float rev = __builtin_amdgcn_fractf(pp * f2[i]); cs[i] = __builtin_amdgcn_cosf(rev); sn[i] = __builtin_amdgcn_sinf(rev); }
                }
                bf16_t* rowp = O + (size_t)row * PN + col0;
#pragma unroll
                for (int bj = 0; bj < 2; ++bj) { f32x4 v0 = acc[ai][bj][m][0], v1 = acc[ai][bj][m][1];
                    if (rope) {
#pragma unroll
                        for (int i = 0; i < 4; ++i) { const float t1 = v0[i], t2 = v1[i]; v0[i] = t1 * cs[i] - t2 * sn[i]; v1[i] = t2 * cs[i] + t1 * sn[i]; } }
                    v0 = v0 * qs; v1 = v1 * qs;
                    u32x4 w; w.x = cvt_pk_bf16(v0[0], v0[1]); w.y = cvt_pk_bf16(v0[2], v0[3]); w.z = cvt_pk_bf16(v1[0], v1[1]); w.w = cvt_pk_bf16(v1[2], v1[3]);
                    *(u32x4*)(rowp + bj * 128) = w; }
            }
    }
};
DEVI void phase_gemm_proj(Frame& F) {
    pg8::Gemm g{(const bf16_t*)(F.ws + WS_B), (const bf16_t*)(F.ws + WS_WINT), DM, DM};
    SchedProj S{F.G, F.blk}; EpiProj E{(bf16_t*)(F.ws + WS_PROJ)};
    pg8::gemm_phase(F.lds, g, S, E);
}

DEVI void phase_conv(Frame& F) {
    const Params& P = *F.p;
    const bf16_t* PR = (const bf16_t*)(F.ws + WS_PROJ); bf16_t* MQ = (bf16_t*)(F.ws + WS_B);
    const int cg = F.tid & 127, run = F.tid >> 7, c0 = cg * 8;
    float w0[8], w1[8], w2[8], bb[8];
#pragma unroll
    for (int i = 0; i < 8; ++i) { w0[i] = P.in[I_CONVW][c0 + i]; w1[i] = P.in[I_CONVW][1024 + c0 + i]; w2[i] = P.in[I_CONVW][2048 + c0 + i]; bb[i] = P.in[I_CONVB][c0 + i]; }
    const float osc = cg >= 64 ? 0.08838834764831845f : 1.f;
    for (int it = F.blk; it < TT / 64; it += F.G) {
        const int r0 = it * 64 + run * 16;
        const bool isctx = r0 >= T;
        if (isctx && cg < 64) continue;
        const int slen = isctx ? CTXL : SEQ, pos0 = isctx ? ((r0 - T) & (CTXL - 1)) : (r0 & (SEQ - 1));
        u32x4 prev = (u32x4){0u, 0u, 0u, 0u}, cur, nxt;
        if (pos0 > 0) prev = *(const u32x4*)(PR + (size_t)(r0 - 1) * PN + 1536 + c0);
        cur = *(const u32x4*)(PR + (size_t)r0 * PN + 1536 + c0);
        for (int t = 0; t < 16; ++t) {
            const int r = r0 + t;
            nxt = (u32x4){0u, 0u, 0u, 0u};
            if (pos0 + t + 1 < slen) nxt = *(const u32x4*)(PR + (size_t)(r + 1) * PN + 1536 + c0);
            float o[8];
#pragma unroll
            for (int q = 0; q < 4; ++q) {
                const float a0 = lo_bf(prev[q]), a1 = hi_bf(prev[q]), b0 = lo_bf(cur[q]), b1 = hi_bf(cur[q]), d0 = lo_bf(nxt[q]), d1 = hi_bf(nxt[q]);
                o[2 * q] = siluf_(w0[2 * q] * a0 + w1[2 * q] * b0 + w2[2 * q] * d0 + bb[2 * q]) * osc;
                o[2 * q + 1] = siluf_(w0[2 * q + 1] * a1 + w1[2 * q + 1] * b1 + w2[2 * q + 1] * d1 + bb[2 * q + 1]) * osc;
            }
            u32x4 w; w.x = cvt_pk_bf16(o[0], o[1]); w.y = cvt_pk_bf16(o[2], o[3]); w.z = cvt_pk_bf16(o[4], o[5]); w.w = cvt_pk_bf16(o[6], o[7]);
            *(u32x4*)(MQ + (size_t)r * DM + c0) = w;
            prev = cur; cur = nxt;
        }
    }
}

constexpr int LDT = 136;
constexpr int TILE_B = 128 * LDT * 2;
DEVI bf16x8 frag_rows(const LAS bf16_t* base, int row, int k) { return *(const LAS bf16x8*)(base + row * LDT + k); }
DEVI bf16x8 frag_cols(const LAS bf16_t* base, int k, int col) { bf16x8 v;
#pragma unroll
    for (int j = 0; j < 8; ++j) v[j] = (short)base[(k + j) * LDT + col];
    return v; }
DEVI void stage_tile(LAS bf16_t* dst, const bf16_t* src, size_t ld, int tid) {
#pragma unroll
    for (int i = 0; i < 4; ++i) { const int p = tid + NTHREADS * i, r = p >> 4, c = (p & 15) * 8; *(LAS u32x4*)(dst + r * LDT + c) = *(const u32x4*)(src + (size_t)r * ld + c); }
}
DEVI void stage_tile_scaled2(LAS bf16_t* d0, LAS bf16_t* d1, const LAS float* s0, const LAS float* s1, const bf16_t* src, size_t ld, int tid) {
#pragma unroll
    for (int i = 0; i < 4; ++i) { const int p = tid + NTHREADS * i, r = p >> 4, c = (p & 15) * 8; const u32x4 v = *(const u32x4*)(src + (size_t)r * ld + c);
        const float a = s0[r], b = s1[r]; u32x4 o0, o1;
#pragma unroll
        for (int q = 0; q < 4; ++q) { const float lo = lo_bf(v[q]), hi = hi_bf(v[q]); o0[q] = cvt_pk_bf16(lo * a, hi * a); o1[q] = cvt_pk_bf16(lo * b, hi * b); }
        *(LAS u32x4*)(d0 + r * LDT + c) = o0; *(LAS u32x4*)(d1 + r * LDT + c) = o1; }
}
typedef short v4i16_t __attribute__((ext_vector_type(4)));
DEVI bf16x8 frag_tr(const LAS bf16_t* base, int k, int c16, int fr) {
    const LAS bf16_t* p = base + (k + (fr >> 2)) * LDT + c16 + 4 * (fr & 3);
    const v4i16_t lo = __builtin_amdgcn_ds_read_tr16_b64_v4i16((LAS v4i16_t*)p), hi = __builtin_amdgcn_ds_read_tr16_b64_v4i16((LAS v4i16_t*)(p + 4 * LDT));
    return (bf16x8){lo[0], lo[1], lo[2], lo[3], hi[0], hi[1], hi[2], hi[3]};
}
template <bool MAXOP> DEVI float wave_incl_scan(float v, int lane) {
#pragma unroll
    for (int o = 1; o < 64; o <<= 1) { const float u = __shfl_up(v, o); if (lane >= o) v = MAXOP ? fmaxf(v, u) : v + u; }
    return v;
}
DEVI void mlstm_gates2(LAS float* vec, const float* GT, int row0, int h, int tid, int lane, int wave, float m_f, float m_b, bool need_mu) {
    const bool act = tid < 256, bw = tid >= 128; const int tau = bw ? 255 - tid : tid;
    float gi = 0.f, bsum = 0.f, a = 0.f, pm = 0.f;
    if (act) { const float* g = GT + (size_t)(row0 + tau) * 16; const float lf = logsigmoidf_(g[(bw ? 12 : 4) + h]); gi = g[(bw ? 8 : 0) + h];
        bsum = wave_incl_scan<false>(lf, lane); if (lane == 63) vec[3400 + wave] = bsum; }
    __syncthreads();
    if (act) { if (wave & 1) bsum += vec[3400 + wave - 1]; a = gi - bsum; vec[(bw ? 896 : 768) + tau] = bsum; vec[(bw ? 640 : 512) + tau] = a;
        pm = wave_incl_scan<true>(a, lane); if (lane == 63) vec[3404 + wave] = pm; }
    __syncthreads();
    if (act) { if (wave & 1) pm = fmaxf(pm, vec[3404 + wave - 1]);
        if (need_mu) vec[(bw ? 1408 : 1280) + tau] = fmaxf(bw ? m_b : m_f, pm);
        if (tid == 127) { vec[3410] = bsum; vec[3411] = pm; } if (tid == 255) { vec[3412] = bsum; vec[3413] = pm; } }
    __syncthreads();
}
DEVI void mlstm_gates3(LAS float* vec, float fg, float ig, int tid, int lane, int wave, float m_f, float m_b) {
    const bool act = tid < 256, bw = tid >= 128; const int tau = bw ? 255 - tid : tid;
    float bsum = 0.f, a = 0.f, pm = 0.f;
    if (act) { bsum = wave_incl_scan<false>(logsigmoidf_(fg), lane); if (lane == 63) vec[3400 + wave] = bsum; }
    __syncthreads();
    if (act) { if (wave & 1) bsum += vec[3400 + wave - 1]; a = ig - bsum; vec[(bw ? 896 : 768) + tau] = bsum; vec[(bw ? 640 : 512) + tau] = a;
        pm = wave_incl_scan<true>(a, lane); if (lane == 63) vec[3404 + wave] = pm; }
    __syncthreads();
    if (act) { if (wave & 1) pm = fmaxf(pm, vec[3404 + wave - 1]); vec[(bw ? 1408 : 1280) + tau] = fmaxf(bw ? m_b : m_f, pm);
        if (tid == 127) { vec[3410] = bsum; vec[3411] = pm; } if (tid == 255) { vec[3412] = bsum; vec[3413] = pm; } }
    __syncthreads();
}
DEVI void mlstm_chunk_gates(LAS float* vec, const float* GT, int row0, int h, int tid) {
    if (tid < 128) { const float* g = GT + (size_t)(row0 + tid) * 16;
        vec[tid] = logsigmoidf_(g[4 + h]); vec[128 + tid] = logsigmoidf_(g[12 + h]); vec[256 + tid] = g[h]; vec[384 + tid] = g[8 + h]; }
    __syncthreads();
    if (tid < 128) { float s = 0.f; for (int j = 0; j <= tid; ++j) s += vec[j]; vec[768 + tid] = s; vec[512 + tid] = vec[256 + tid] - s; }
    else if (tid < 256) { const int t = tid - 128; float s = 0.f; for (int j = 127; j >= t; --j) s += vec[128 + j]; vec[896 + t] = s; vec[640 + t] = vec[384 + t] - s; }
    __syncthreads();
}
DEVI size_t us_index(int ty, int b, int h, int dir, int slot) { return ((((size_t)(ty * 8 + b) * 4 + h) * 2 + dir) * NSLOT + slot) * 16384; }
DEVI size_t sm_index(int b, int h, int dir, int slot) { return (((size_t)b * 4 + h) * 2 + dir) * NSLOT + slot; }

struct ConvW { f32x4 a[2], b[2], c[2], d[2]; };
DEVI void conv_load_w(ConvW& W, const float* cw, const float* cb, int tid) {
    const int cc = (tid & 15) * 8;
#pragma unroll
    for (int q = 0; q < 2; ++q) { W.a[q] = *(const f32x4*)(cw + cc + 4 * q); W.b[q] = *(const f32x4*)(cw + 1024 + cc + 4 * q); W.c[q] = *(const f32x4*)(cw + 2048 + cc + 4 * q); W.d[q] = *(const f32x4*)(cb + cc + 4 * q); }
}
DEVI void conv_tile_regs(u32x4 (&out)[4], const LAS bf16_t* Tl, const LAS bf16_t* halo, const ConvW& W, float oscale, int tid) {
    const int cc = (tid & 15) * 8;
    float w0[8], w1[8], w2[8], bb[8];
#pragma unroll
    for (int q = 0; q < 2; ++q) {
#pragma unroll
        for (int j = 0; j < 4; ++j) { w0[4 * q + j] = W.a[q][j]; w1[4 * q + j] = W.b[q][j]; w2[4 * q + j] = W.c[q][j]; bb[4 * q + j] = W.d[q][j]; } }
#pragma unroll
    for (int i = 0; i < 4; ++i) { const int r = (tid + NTHREADS * i) >> 4;
        const u32x4 cur = *(const LAS u32x4*)(Tl + r * LDT + cc);
        const LAS bf16_t* pp = r > 0 ? Tl + (r - 1) * LDT + cc : halo + cc; const LAS bf16_t* pn = r < 127 ? Tl + (r + 1) * LDT + cc : halo + 128 + cc;
        const u32x4 prev = *(const LAS u32x4*)pp, nxt = *(const LAS u32x4*)pn;
        unsigned ow[4];
#pragma unroll
        for (int q = 0; q < 4; ++q) {
            const f32x2 p2 = (f32x2){lo_bf(prev[q]), hi_bf(prev[q])}, c2 = (f32x2){lo_bf(cur[q]), hi_bf(cur[q])}, n2 = (f32x2){lo_bf(nxt[q]), hi_bf(nxt[q])};
            const f32x2 z = __builtin_elementwise_fma((f32x2){w0[2 * q], w0[2 * q + 1]}, p2, __builtin_elementwise_fma((f32x2){w1[2 * q], w1[2 * q + 1]}, c2,
                            __builtin_elementwise_fma((f32x2){w2[2 * q], w2[2 * q + 1]}, n2, (f32x2){bb[2 * q], bb[2 * q + 1]})));
            const f32x2 o2 = silu2_(z) * (f32x2){oscale, oscale};
            ow[q] = cvt_pk_bf16(o2.x, o2.y); }
        out[i].x = ow[0]; out[i].y = ow[1]; out[i].z = ow[2]; out[i].w = ow[3]; }
}

DEVI void phase_chunk_u(Frame& F) {
    const Params& P = *F.p;
    LAS bf16_t* Vs = (LAS bf16_t*)F.lds; LAS bf16_t* Kf = (LAS bf16_t*)(F.lds + TILE_B); LAS bf16_t* Kb = (LAS bf16_t*)(F.lds + 2 * TILE_B);
    LAS float* vec = (LAS float*)(F.lds + 3 * TILE_B);
    const bf16_t* PR = (const bf16_t*)(F.ws + WS_PROJ); const float* GT = (const float*)(F.ws + WS_GATES);
    bf16_t* US = (bf16_t*)(F.ws + WS_US);
    const int wr0 = F.wave >> 1, wc0 = F.wave & 1, fr0 = F.lane & 15, fq0 = F.lane >> 4;
    constexpr int NIT4 = 2 * 8 * 4 * NSLOT;
    u32x4 kreg[4], vreg[4], kcur[4], vcur[4], phalo = (u32x4){0u, 0u, 0u, 0u}; float pfg = 0.f, pig = 0.f;
    LAS bf16_t* HL = (LAS bf16_t*)(vec + 2432);
#define P4_ISSUE(IT) do { const int slot_ = (IT) % NSLOT, h_ = ((IT) / NSLOT) & 3, b_ = ((IT) / (NSLOT * 4)) & 7, ty_ = (IT) / (NSLOT * 32); \
        const int row0_ = slot_ < NCC ? T + b_ * CTXL + slot_ * CH : b_ * SEQ + (slot_ - NCC) * CH; \
        const bf16_t* ks_ = PR + (size_t)row0_ * PN + (ty_ == 0 ? 512 : 2048) + h_ * 128; const size_t kl_ = PN; \
        if (ty_ == 1 && F.tid < 32) { const int wh_ = F.tid >> 4; const int sl_ = slot_ < NCC ? slot_ : slot_ - NCC, ns_ = slot_ < NCC ? NCC : NCH; \
            const bool ok_ = wh_ ? (sl_ + 1 < ns_) : (sl_ > 0); phalo = (u32x4){0u, 0u, 0u, 0u}; \
            if (ok_) phalo = *(const u32x4*)(ks_ + (long)(wh_ ? 128 : -1) * (long)PN + (F.tid & 15) * 8); } \
        const bf16_t* vs_ = PR + (size_t)row0_ * PN + (ty_ == 0 ? 1024 : 2560) + h_ * 128; \
        _Pragma("unroll") for (int i = 0; i < 4; ++i) { const int p = F.tid + NTHREADS * i, r = p >> 4, c = (p & 15) * 8; kreg[i] = *(const u32x4*)(ks_ + (size_t)r * kl_ + c); vreg[i] = *(const u32x4*)(vs_ + (size_t)r * PN + c); } \
        if (ty_ == 1 && F.tid < 256) { const int bw_ = F.tid >> 7, tau_ = bw_ ? 255 - F.tid : F.tid; const float* g_ = GT + (size_t)(row0_ + tau_) * 16; pfg = g_[(bw_ ? 12 : 4) + h_]; pig = g_[(bw_ ? 8 : 0) + h_]; } } while (0)
    if (F.blk < NIT4) P4_ISSUE(F.blk);
    for (int it = F.blk; it < NIT4; it += F.G) {
        const int slot = it % NSLOT, h = (it / NSLOT) & 3, b = (it / (NSLOT * 4)) & 7, ty = it / (NSLOT * 32);
        int fr = fr0, fq = fq0, wr = wr0, wc = wc0;
        asm volatile("" : "+v"(fr), "+v"(fq), "+s"(wr), "+s"(wc));
        __syncthreads();
#pragma unroll
        for (int i = 0; i < 4; ++i) { kcur[i] = kreg[i]; vcur[i] = vreg[i]; }
        const float cfg = pfg, cig = pig; const u32x4 chalo = phalo;
        ConvW cwk; if (ty == 1) conv_load_w(cwk, P.in[I_CONVW] + 512 + h * 128, P.in[I_CONVB] + 512 + h * 128, F.tid);
        asm volatile("" ::: "memory");
        if (it + F.G < NIT4) P4_ISSUE(it + F.G);
        if (ty == 1) {
#pragma unroll
            for (int i = 0; i < 4; ++i) { const int p = F.tid + NTHREADS * i, r = p >> 4, c = (p & 15) * 8; *(LAS u32x4*)(Kf + r * LDT + c) = kcur[i]; }
            if (F.tid < 32) *(LAS u32x4*)(HL + (F.tid >> 4) * 128 + (F.tid & 15) * 8) = chalo;
            __syncthreads();
            conv_tile_regs(kcur, Kf, HL, cwk, 0.08838834764831845f, F.tid);
        }
        if (ty == 0) {
            const float lf = -expf(P.in[I_RDEC][h]) * 1.4426950408889634f, lb = -expf(P.in[I_RDEC][4 + h]) * 1.4426950408889634f;
            if (F.tid < 128) { vec[1024 + F.tid] = exp2f((float)(127 - F.tid) * lf); vec[1152 + F.tid] = exp2f((float)F.tid * lb); }
        } else {
            mlstm_gates3(vec, cfg, cig, F.tid, F.lane, F.wave, 0.f, 0.f);
            const float mf = vec[3411], mb = vec[3413];
            if (F.tid < 128) { vec[1024 + F.tid] = __expf(vec[512 + F.tid] - mf); vec[1152 + F.tid] = __expf(vec[640 + F.tid] - mb); }
            if (F.tid == 0) { float* chs = (float*)(F.ws + WS_CHS);
                chs[sm_index(b, h, 0, slot) * 2 + 0] = vec[3410]; chs[sm_index(b, h, 0, slot) * 2 + 1] = mf;
                chs[sm_index(b, h, 1, slot) * 2 + 0] = vec[3412]; chs[sm_index(b, h, 1, slot) * 2 + 1] = mb; }
        }
        __syncthreads();
#pragma unroll
        for (int i = 0; i < 4; ++i) { const int p = F.tid + NTHREADS * i, r = p >> 4, c = (p & 15) * 8;
            *(LAS u32x4*)(Vs + r * LDT + c) = vcur[i];
            const float wa = vec[1024 + r], wb = vec[1152 + r]; u32x4 o0, o1;
#pragma unroll
            for (int q = 0; q < 4; ++q) { const float lo = lo_bf(kcur[i][q]), hi = hi_bf(kcur[i][q]); o0[q] = cvt_pk_bf16(lo * wa, hi * wa); o1[q] = cvt_pk_bf16(lo * wb, hi * wb); }
            *(LAS u32x4*)(Kf + r * LDT + c) = o0; *(LAS u32x4*)(Kb + r * LDT + c) = o1; }
        __syncthreads();
        f32x4 af[2][4], ab[2][4];
#pragma unroll
        for (int m = 0; m < 2; ++m)
#pragma unroll
            for (int n = 0; n < 4; ++n) { af[m][n] = (f32x4){0.f, 0.f, 0.f, 0.f}; ab[m][n] = (f32x4){0.f, 0.f, 0.f, 0.f}; }
#pragma unroll 1
        for (int ks = 0; ks < 4; ++ks) {
            bf16x8 kf2[2], kb2[2];
#pragma unroll
            for (int m = 0; m < 2; ++m) { kf2[m] = frag_tr(Kf, ks * 32 + 8 * fq, 32 * wr + 16 * m, fr); kb2[m] = frag_tr(Kb, ks * 32 + 8 * fq, 32 * wr + 16 * m, fr); }
#pragma unroll
            for (int n = 0; n < 4; ++n) { const bf16x8 bv = frag_tr(Vs, ks * 32 + 8 * fq, 64 * wc + 16 * n, fr);
#pragma unroll
                for (int m = 0; m < 2; ++m) { af[m][n] = __builtin_amdgcn_mfma_f32_16x16x32_bf16(kf2[m], bv, af[m][n], 0, 0, 0); ab[m][n] = __builtin_amdgcn_mfma_f32_16x16x32_bf16(kb2[m], bv, ab[m][n], 0, 0, 0); } }
        }
        if (ty == 1 && F.tid < 256) {
            const int dir = F.tid >> 7, d = F.tid & 127; const LAS bf16_t* kk = dir ? Kb : Kf; float s = 0.f;
#pragma unroll 8
            for (int t = 0; t < 128; ++t) s += bf2f(kk[t * LDT + d]);
            ((float*)(F.ws + WS_UN))[sm_index(b, h, dir, slot) * 128 + d] = s;
        }
        __syncthreads();
#pragma unroll
        for (int m = 0; m < 2; ++m)
#pragma unroll
            for (int n = 0; n < 4; ++n) { const int e = 64 * wc + 16 * n + fr, d0 = 32 * wr + 16 * m + 4 * fq;
                u32x2 o; o.x = cvt_pk_bf16(af[m][n][0], af[m][n][1]); o.y = cvt_pk_bf16(af[m][n][2], af[m][n][3]); *(LAS u32x2*)(Kf + e * LDT + d0) = o;
                o.x = cvt_pk_bf16(ab[m][n][0], ab[m][n][1]); o.y = cvt_pk_bf16(ab[m][n][2], ab[m][n][3]); *(LAS u32x2*)(Kb + e * LDT + d0) = o; }
        __syncthreads();
        bf16_t* uf = US + us_index(ty, b, h, 0, slot); bf16_t* ub = US + us_index(ty, b, h, 1, slot);
#pragma unroll
        for (int i = 0; i < 4; ++i) { const int p = F.tid + NTHREADS * i, r = p >> 4, c = (p & 15) * 8;
            *(u32x4*)(uf + r * 128 + c) = *(const LAS u32x4*)(Kf + r * LDT + c); *(u32x4*)(ub + r * 128 + c) = *(const LAS u32x4*)(Kb + r * LDT + c); }
    }
#undef P4_ISSUE
}

DEVI int scan_slot(int dir, int s) { return dir == 0 ? s : (s < NCC ? (NCC - 1 - s) : (NSLOT - 1 - (s - NCC))); }
DEVI void phase_scan_states(Frame& F) {
    const Params& P = *F.p;
    bf16_t* US = (bf16_t*)(F.ws + WS_US);
    for (int it = F.blk; it < 256; it += F.G) {
        const int half = it & 1, chain = it >> 1, dir = chain & 1, h = (chain >> 1) & 3, b = (chain >> 3) & 7, ty = chain >> 6;
        bf16_t* base = US + us_index(ty, b, h, dir, 0) + half * 8192 + F.tid * 16;
        float st[16];
#pragma unroll
        for (int i = 0; i < 16; ++i) st[i] = 0.f;
        float m = 0.f, nst = 0.f;
        const float gdec = ty == 0 ? expf(-expf(P.in[I_RDEC][dir * 4 + h]) * 128.f) : 0.f;
        const float* chs = (const float*)(F.ws + WS_CHS) + sm_index(b, h, dir, 0) * 2;
        float* smv = (float*)(F.ws + WS_SM) + sm_index(b, h, dir, 0);
        float* un = (float*)(F.ws + WS_UN) + sm_index(b, h, dir, 0) * 128;
        const bool do_n = (ty == 1) && half == 0 && F.tid < 128;
        u32x4 q0[6], q1[6];
#pragma unroll
        for (int j = 0; j < 6; ++j) { const bf16_t* p = base + (size_t)scan_slot(dir, j) * 16384; q0[j] = *(const u32x4*)p; q1[j] = *(const u32x4*)(p + 8); }
        LAS float* CHL = (LAS float*)F.lds;
        LAS float* UNL = CHL + 2 * NSLOT;
        __syncthreads();
        if (ty == 1) {
            for (int i = F.tid; i < 2 * NSLOT; i += NTHREADS) CHL[i] = chs[i];
            if (half == 0) { float uv_[17];
#pragma unroll
                for (int q = 0; q < 17; ++q) { const int i = F.tid + NTHREADS * q; uv_[q] = i < NSLOT * 128 ? un[i] : 0.f; }
#pragma unroll
                for (int q = 0; q < 17; ++q) { const int i = F.tid + NTHREADS * q; if (i < NSLOT * 128) UNL[i] = uv_[q]; } }
        }
        __syncthreads();
        for (int s3 = 0; s3 < NSLOT; s3 += 6) {
#pragma unroll
            for (int j = 0; j < 6; ++j) {
                const int s = s3 + j; const int slot = scan_slot(dir, s);
                bf16_t* p = base + (size_t)slot * 16384;
                const u32x4 u0 = q0[j], u1 = q1[j];
                if (s + 6 < NSLOT) { const bf16_t* pn = base + (size_t)scan_slot(dir, s + 6) * 16384; q0[j] = *(const u32x4*)pn; q1[j] = *(const u32x4*)(pn + 8); }
                float dec = gdec, du = 1.f;
                if (ty == 1) { const float btot = CHL[slot * 2], amax = CHL[slot * 2 + 1]; const float mloc = btot + amax, mn = fmaxf(btot + m, mloc);
                    dec = __expf(btot + m - mn); du = __expf(mloc - mn);
                    if (half == 0 && F.tid == 0 && slot >= NCC) smv[slot] = m;
                    m = mn; }
                if (slot >= NCC) { u32x4 o0, o1;
#pragma unroll
                    for (int q = 0; q < 4; ++q) { o0[q] = cvt_pk_bf16(st[2 * q], st[2 * q + 1]); o1[q] = cvt_pk_bf16(st[8 + 2 * q], st[8 + 2 * q + 1]); }
                    *(u32x4*)p = o0; *(u32x4*)(p + 8) = o1; }
#pragma unroll
                for (int q = 0; q < 4; ++q) { st[2 * q] = dec * st[2 * q] + du * lo_bf(u0[q]); st[2 * q + 1] = dec * st[2 * q + 1] + du * hi_bf(u0[q]);
                    st[8 + 2 * q] = dec * st[8 + 2 * q] + du * lo_bf(u1[q]); st[8 + 2 * q + 1] = dec * st[8 + 2 * q + 1] + du * hi_bf(u1[q]); }
                if (do_n) { const float uv = UNL[slot * 128 + F.tid]; if (slot >= NCC) un[slot * 128 + F.tid] = nst; nst = dec * nst + du * uv; }
            }
        }
    }
}

DEVI void phase_chunk_out(Frame& F) {
    const Params& P = *F.p;
    LAS bf16_t* Qs = (LAS bf16_t*)F.lds; LAS bf16_t* R1 = (LAS bf16_t*)(F.lds + TILE_B); LAS bf16_t* Vs = (LAS bf16_t*)(F.lds + 2 * TILE_B); LAS bf16_t* R3 = (LAS bf16_t*)(F.lds + 3 * TILE_B);
    LAS float* Ot = (LAS float*)F.lds; constexpr int LDO = 132;
    LAS float* vec = (LAS float*)(F.lds + 4 * TILE_B);
    bf16_t* PR = (bf16_t*)(F.ws + WS_PROJ); const float* GT = (const float*)(F.ws + WS_GATES);
    const bf16_t* US = (const bf16_t*)(F.ws + WS_US);
    const int wr0 = F.wave >> 1, wc0 = F.wave & 1, fr0 = F.lane & 15, fq0 = F.lane >> 4, w0 = F.wave;
    u32x4 qreg[4], kreg[4], vreg[4], phalo = (u32x4){0u, 0u, 0u, 0u}; float pfg = 0.f, pig = 0.f, pnv = 0.f, pmf = 0.f, pmb = 0.f;
    LAS bf16_t* HL = (LAS bf16_t*)(vec + 2432);
#define P6_ISSUE(JJ) do { const int rt_ = F.blk + ((JJ) >> 4) * F.G, kk_ = (JJ) & 15; const int c_ = 2 * (rt_ & 31) + (kk_ & 1), h_ = (kk_ >> 1) & 3, b_ = rt_ >> 5, ty_ = kk_ >> 3; const int row0_ = b_ * SEQ + c_ * CH, slot_ = NCC + c_; \
        const bf16_t* qs_ = PR + (size_t)row0_ * PN + (ty_ == 0 ? 0 : 1536) + h_ * 128; const size_t ql_ = PN; \
        if (ty_ == 1 && tidv < 64) { const int tl_ = tidv >> 5, wh_ = (tidv >> 4) & 1; const bool ok_ = wh_ ? (c_ + 1 < NCH) : (c_ > 0); phalo = (u32x4){0u, 0u, 0u, 0u}; \
            if (ok_) phalo = *(const u32x4*)(qs_ + tl_ * 512 + (long)(wh_ ? 128 : -1) * (long)PN + (tidv & 15) * 8); } \
        const bf16_t* vs_ = PR + (size_t)row0_ * PN + (ty_ == 0 ? 1024 : 2560) + h_ * 128; \
        _Pragma("unroll") for (int i = 0; i < 4; ++i) { const int p = tidv + NTHREADS * i, r = p >> 4, cc = (p & 15) * 8; \
            qreg[i] = *(const u32x4*)(qs_ + (size_t)r * ql_ + cc); kreg[i] = *(const u32x4*)(qs_ + 512 + (size_t)r * ql_ + cc); vreg[i] = *(const u32x4*)(vs_ + (size_t)r * PN + cc); } \
        if (ty_ == 1) { pmf = ((const float*)(F.ws + WS_SM))[sm_index(b_, h_, 0, slot_)]; pmb = ((const float*)(F.ws + WS_SM))[sm_index(b_, h_, 1, slot_)]; \
            if (tidv < 256) { const int bw_ = tidv >> 7, tau_ = bw_ ? 255 - tidv : tidv; const float* g_ = GT + (size_t)(row0_ + tau_) * 16; \
                pfg = g_[(bw_ ? 12 : 4) + h_]; pig = g_[(bw_ ? 8 : 0) + h_]; pnv = ((const float*)(F.ws + WS_UN))[sm_index(b_, h_, bw_, slot_) * 128 + (tidv & 127)]; } } } while (0)
    int tidv = F.tid;
    const int njj = F.blk < T / 256 ? 16 * ((T / 256 - 1 - F.blk) / F.G + 1) : 0;
    if (njj > 0) P6_ISSUE(0);
    for (int jj = 0; jj < njj; ++jj) {
        const int rt = F.blk + (jj >> 4) * F.G, kk = jj & 15;
        const int c = 2 * (rt & 31) + (kk & 1), h = (kk >> 1) & 3, b = rt >> 5, ty = kk >> 3;
        const int row0 = b * SEQ + c * CH, slot = NCC + c;
        int fr = fr0, fq = fq0, wr = wr0, wc = wc0, wv = w0;
        tidv = F.tid;
        asm volatile("" : "+v"(fr), "+v"(fq), "+v"(tidv), "+s"(wr), "+s"(wc), "+s"(wv));
        __syncthreads();
#pragma unroll
        for (int i = 0; i < 4; ++i) { const int p = tidv + NTHREADS * i, r = p >> 4, cc = (p & 15) * 8;
            *(LAS u32x4*)(Qs + r * LDT + cc) = qreg[i]; *(LAS u32x4*)(R1 + r * LDT + cc) = kreg[i]; *(LAS u32x4*)(Vs + r * LDT + cc) = vreg[i]; }
        const float m_f = pmf, m_b = pmb;
        if (ty == 1) {
            if (tidv < 64) *(LAS u32x4*)(HL + (tidv >> 4) * 128 + (tidv & 15) * 8) = phalo;
            __syncthreads();
            u32x4 cq[4], ck[4];
            ConvW cwq, cwk; conv_load_w(cwq, P.in[I_CONVW] + h * 128, P.in[I_CONVB] + h * 128, tidv); conv_load_w(cwk, P.in[I_CONVW] + 512 + h * 128, P.in[I_CONVB] + 512 + h * 128, tidv);
            conv_tile_regs(cq, Qs, HL, cwq, 1.f, tidv);
            conv_tile_regs(ck, R1, HL + 256, cwk, 0.08838834764831845f, tidv);
            __syncthreads();
#pragma unroll
            for (int i = 0; i < 4; ++i) { const int p = tidv + NTHREADS * i, r = p >> 4, cc = (p & 15) * 8; *(LAS u32x4*)(Qs + r * LDT + cc) = cq[i]; *(LAS u32x4*)(R1 + r * LDT + cc) = ck[i]; }
        }
        const bf16_t* sfp = US + us_index(ty, b, h, 0, slot); const bf16_t* sbp = US + us_index(ty, b, h, 1, slot);
        u32x4 s0[4], s1[4];
#pragma unroll
        for (int i = 0; i < 4; ++i) { const int p = tidv + NTHREADS * i, r = p >> 4, cc = (p & 15) * 8; s0[i] = *(const u32x4*)(sfp + r * 128 + cc); s1[i] = *(const u32x4*)(sbp + r * 128 + cc); }
        float lgf = 0.f, lgb = 0.f;
        if (ty == 0) {
            lgf = -expf(P.in[I_RDEC][h]) * 1.4426950408889634f; lgb = -expf(P.in[I_RDEC][4 + h]) * 1.4426950408889634f;
            if (tidv < 128) { vec[1024 + tidv] = __builtin_amdgcn_exp2f((float)(tidv + 1) * lgf); vec[1152 + tidv] = __builtin_amdgcn_exp2f((float)(128 - tidv) * lgb); }
            __syncthreads();
        } else {
            if (tidv < 256) vec[1792 + tidv] = pnv;
            mlstm_gates3(vec, pfg, pig, tidv, F.lane, F.wave, m_f, m_b);
            {
                const int t = tidv >> 2, qq = tidv & 3; float sf = 0.f, sb = 0.f;
#pragma unroll 4
                for (int d = qq * 32; d < qq * 32 + 32; d += 2) { const unsigned qv = *(const LAS unsigned*)(Qs + t * LDT + d); const float q0 = lo_bf(qv), q1 = hi_bf(qv);
                    sf += q0 * vec[1792 + d] + q1 * vec[1792 + d + 1]; sb += q0 * vec[1920 + d] + q1 * vec[1920 + d + 1]; }
                sf = quad_sum(sf); sb = quad_sum(sb);
                if (qq == 0) { vec[2048 + t] = sf; vec[2176 + t] = sb; }
            }
        }
        f32x4 g[8];
#pragma unroll
        for (int m = 0; m < 8; ++m) g[m] = (f32x4){0.f, 0.f, 0.f, 0.f};
#pragma unroll 1
        for (int ks = 0; ks < 4; ++ks) {
            const bf16x8 bq = frag_rows(Qs, 16 * wv + fr, ks * 32 + 8 * fq);
#pragma unroll
            for (int m = 0; m < 8; ++m) { const bf16x8 ak = frag_rows(R1, 16 * m + fr, ks * 32 + 8 * fq); g[m] = __builtin_amdgcn_mfma_f32_16x16x32_bf16(ak, bq, g[m], 0, 0, 0); }
        }
        __syncthreads();
        {
            const int t = 16 * wv + fr;
            if (ty == 0) {
                const float tf0 = (float)(t - 4 * fq);
#pragma unroll
                for (int m = 0; m < 8; ++m) { float pv[4];
                    if (m < wv) {
#pragma unroll
                        for (int r = 0; r < 4; ++r) pv[r] = 0.f;
                        { const f32x4 w4 = exp2_4_(((f32x4){0.f, -1.f, -2.f, -3.f} + (tf0 - 16.f * m)) * lgf) * g[m]; pv[0] = w4.x; pv[1] = w4.y; pv[2] = w4.z; pv[3] = w4.w; }
                    } else if (m > wv) {
                        { const f32x4 w4 = exp2_4_(((f32x4){0.f, 1.f, 2.f, 3.f} - (tf0 - 16.f * m)) * lgb) * g[m]; pv[0] = w4.x; pv[1] = w4.y; pv[2] = w4.z; pv[3] = w4.w; }
                    } else {
#pragma unroll
                        for (int r = 0; r < 4; ++r) { const int dl = t - (16 * m + 4 * fq + r);
                            const float w = dl > 0 ? __builtin_amdgcn_exp2f((float)dl * lgf) : (dl < 0 ? __builtin_amdgcn_exp2f((float)(-dl) * lgb) : 2.f); pv[r] = g[m][r] * w; }
                    }
                    u32x2 o; o.x = cvt_pk_bf16(pv[0], pv[1]); o.y = cvt_pk_bf16(pv[2], pv[3]); *(LAS u32x2*)(R1 + t * LDT + 16 * m + 4 * fq) = o; }
            } else {
                const float muf = vec[1280 + t], mub = vec[1408 + t]; float rsf = 0.f, rsb = 0.f; f32x2 rs2f = (f32x2){0.f, 0.f}, rs2b = (f32x2){0.f, 0.f};
                f32x4 sb4[8];
#pragma unroll
                for (int m = 0; m < 8; ++m) {
                    if (m < wv) {
                        const f32x4 av = *(const LAS f32x4*)(vec + 512 + 16 * m + 4 * fq);
#pragma unroll
                        for (int r = 0; r < 1; ++r) { g[m] = g[m] * exp4_(av - muf); rs2f = rs2f + g[m].lo + g[m].hi; }
                        sb4[m] = (f32x4){0.f, 0.f, 0.f, 0.f};
                    } else if (m > wv) {
                        const f32x4 bv = *(const LAS f32x4*)(vec + 640 + 16 * m + 4 * fq);
#pragma unroll
                        for (int r = 0; r < 1; ++r) { sb4[m] = g[m] * exp4_(bv - mub); rs2b = rs2b + sb4[m].lo + sb4[m].hi; }
                        g[m] = (f32x4){0.f, 0.f, 0.f, 0.f};
                    } else {
                        const f32x4 av = *(const LAS f32x4*)(vec + 512 + 16 * m + 4 * fq), bv = *(const LAS f32x4*)(vec + 640 + 16 * m + 4 * fq);
#pragma unroll
                        for (int r = 0; r < 4; ++r) { const int tp = 16 * m + 4 * fq + r; const float gv = g[m][r];
                            const float sf = tp <= t ? gv * __expf(av[r] - muf) : 0.f, sb = tp >= t ? gv * __expf(bv[r] - mub) : 0.f;
                            g[m][r] = sf; sb4[m][r] = sb; rsf += sf; rsb += sb; }
                    } }
                rsf += rs2f.x + rs2f.y; rsb += rs2b.x + rs2b.y;
                rsf += __shfl_xor(rsf, 16); rsf += __shfl_xor(rsf, 32); rsb += __shfl_xor(rsb, 16); rsb += __shfl_xor(rsb, 32);
                const float interf = __expf(m_f - muf), interb = __expf(m_b - mub);
                const float denf = rsf + interf * vec[2048 + t], denb = rsb + interb * vec[2176 + t];
                const float rDf = __builtin_amdgcn_rcpf(fmaxf(fabsf(denf), __expf(-(vec[768 + t] + muf)))), rDb = __builtin_amdgcn_rcpf(fmaxf(fabsf(denb), __expf(-(vec[896 + t] + mub))));
                if (fq == 0) { vec[1024 + t] = interf * rDf; vec[1152 + t] = interb * rDb; }
#pragma unroll
                for (int m = 0; m < 8; ++m) { const f32x4 pv = g[m] * rDf + sb4[m] * rDb;
                    u32x2 o; o.x = cvt_pk_bf16(pv[0], pv[1]); o.y = cvt_pk_bf16(pv[2], pv[3]); *(LAS u32x2*)(R1 + t * LDT + 16 * m + 4 * fq) = o; }
            }
        }
        f32x4 o1[2][4];
        {
            f32x4 o2[2][4], o3[2][4];
#pragma unroll
            for (int m = 0; m < 2; ++m)
#pragma unroll
                for (int n = 0; n < 4; ++n) { o2[m][n] = (f32x4){0.f, 0.f, 0.f, 0.f}; o3[m][n] = (f32x4){0.f, 0.f, 0.f, 0.f}; }
#define P6_QS(ACC) do { _Pragma("unroll 1") for (int ks = 0; ks < 4; ++ks) { bf16x8 aq[2]; \
                _Pragma("unroll") for (int m = 0; m < 2; ++m) aq[m] = frag_rows(Qs, 32 * wr + 16 * m + fr, ks * 32 + 8 * fq); \
                _Pragma("unroll") for (int n = 0; n < 4; ++n) { const bf16x8 bs = frag_rows(R3, 64 * wc + 16 * n + fr, ks * 32 + 8 * fq); \
                    _Pragma("unroll") for (int m = 0; m < 2; ++m) ACC[m][n] = __builtin_amdgcn_mfma_f32_16x16x32_bf16(aq[m], bs, ACC[m][n], 0, 0, 0); } } } while (0)
#pragma unroll
            for (int i = 0; i < 4; ++i) { const int p = tidv + NTHREADS * i, r = p >> 4, cc = (p & 15) * 8; *(LAS u32x4*)(R3 + r * LDT + cc) = s0[i]; }
            __syncthreads();
            P6_QS(o2);
            __syncthreads();
#pragma unroll
            for (int i = 0; i < 4; ++i) { const int p = tidv + NTHREADS * i, r = p >> 4, cc = (p & 15) * 8; *(LAS u32x4*)(R3 + r * LDT + cc) = s1[i]; }
            __syncthreads();
            P6_QS(o3);
#pragma unroll
            for (int m = 0; m < 2; ++m)
#pragma unroll
                for (int r = 0; r < 4; ++r) { const int t = 32 * wr + 16 * m + 4 * fq + r; const float cf = vec[1024 + t], cb = vec[1152 + t];
#pragma unroll
                    for (int n = 0; n < 4; ++n) o1[m][n][r] = cf * o2[m][n][r] + cb * o3[m][n][r]; }
        }
        const float* gain = (ty == 0 ? P.in[I_RNG] : P.in[I_MNG]) + h * 128;
        bf16_t* obase = PR + (size_t)row0 * PN + 3072 + ty * 512 + h * 128;
        u32x4 gt[4];
#pragma unroll
        for (int i = 0; i < 4; ++i) { const int p = tidv + NTHREADS * i, r = p >> 4, cc = (p & 15) * 8; gt[i] = *(const u32x4*)(obase + (size_t)r * PN + cc); }
        const f32x4 gn0 = *(const f32x4*)(gain + (tidv & 15) * 8), gn1 = *(const f32x4*)(gain + (tidv & 15) * 8 + 4);
        asm volatile("" ::: "memory");
        if (jj + 1 < njj) P6_ISSUE(jj + 1);
#pragma unroll 1
        for (int ks = 0; ks < 4; ++ks) {
            bf16x8 ap[2];
#pragma unroll
            for (int m = 0; m < 2; ++m) ap[m] = frag_rows(R1, 32 * wr + 16 * m + fr, ks * 32 + 8 * fq);
#pragma unroll
            for (int n = 0; n < 4; ++n) { const bf16x8 bv = frag_tr(Vs, ks * 32 + 8 * fq, 64 * wc + 16 * n, fr);
#pragma unroll
                for (int m = 0; m < 2; ++m) o1[m][n] = __builtin_amdgcn_mfma_f32_16x16x32_bf16(ap[m], bv, o1[m][n], 0, 0, 0); }
        }
        __syncthreads();
#pragma unroll
        for (int m = 0; m < 2; ++m)
#pragma unroll
            for (int n = 0; n < 4; ++n)
#pragma unroll
                for (int r = 0; r < 4; ++r) Ot[(32 * wr + 16 * m + 4 * fq + r) * LDO + 64 * wc + 16 * n + fr] = o1[m][n][r];
        __syncthreads();
#pragma unroll
        for (int i = 0; i < 4; ++i) { const int p = tidv + NTHREADS * i, r = p >> 4, cc = (p & 15) * 8;
            const f32x4 a0 = *(const LAS f32x4*)(Ot + r * LDO + cc), a1 = *(const LAS f32x4*)(Ot + r * LDO + cc + 4);
            float sm = (a0.x + a0.y) + (a0.z + a0.w) + (a1.x + a1.y) + (a1.z + a1.w);
            float sq = (a0.x * a0.x + a0.y * a0.y) + (a0.z * a0.z + a0.w * a0.w) + (a1.x * a1.x + a1.y * a1.y) + (a1.z * a1.z + a1.w * a1.w);
            sm = row16_sum(sm); sq = row16_sum(sq);
            const float mean = sm * (1.f / 128.f), rstd = __builtin_amdgcn_rsqf(fmaxf(sq * (1.f / 128.f) - mean * mean, 0.f) + EPS);
            const f32x4 g0 = gn0, g1 = gn1;
            const f32x4 d0 = (a0 - mean) * (g0 * rstd), d1 = (a1 - mean) * (g1 * rstd);
            const f32x2 dd[4] = {d0.lo, d0.hi, d1.lo, d1.hi};
            u32x4 o;
#pragma unroll
            for (int q = 0; q < 4; ++q) { const f32x2 t2 = (f32x2){lo_bf(gt[i][q]), hi_bf(gt[i][q])};
                const f32x2 c2 = ty == 0 ? silu2_(t2) : sigmoid2_(t2); const f32x2 y2 = dd[q] * c2;
                o[q] = cvt_pk_bf16(y2.x, y2.y); }
            *(u32x4*)(obase + (size_t)r * PN + cc) = o; }
    }
#undef P6_ISSUE
#undef P6_QS
}

struct SchedY { int G, c;
    DEVI bool next(int i, pg8::Unit& u) const { return pg8::static_unit(256, 4, (long)i * G + c, u); }
    DEVI int arow(const pg8::Unit& u, int r) const { return u.pm * 256 + r; }
    static constexpr bool IDX_DMA = false; };
struct EpiBf16 { bf16_t* O; int ldc;
    static constexpr bool PRE = false;
    DEVI void operator()(const f32x4 (&acc)[2][2][4][2], const pg8::Unit& u, int wr, int wc, int fr, int fq) const {
        const int row0 = u.pm * 256 + wr * 64 + fr, col0 = u.pn * 256 + wc * 32 + 8 * fq;
#pragma unroll
        for (int ai = 0; ai < 2; ++ai)
#pragma unroll
            for (int m = 0; m < 4; ++m) { bf16_t* rowp = O + (size_t)(row0 + ai * 128 + m * 16) * ldc + col0;
#pragma unroll
                for (int bj = 0; bj < 2; ++bj) { const f32x4 v0 = acc[ai][bj][m][0], v1 = acc[ai][bj][m][1];
                    u32x4 w; w.x = cvt_pk_bf16(v0[0], v0[1]); w.y = cvt_pk_bf16(v0[2], v0[3]); w.z = cvt_pk_bf16(v1[0], v1[1]); w.w = cvt_pk_bf16(v1[2], v1[3]);
                    *(u32x4*)(rowp + bj * 128) = w; } }
    } };
struct CpItem { const float* p; size_t stride; unsigned char* dst; int K; float scale; };
DEVI CpItem cp_item(Frame& F, int it, int lane) {
    const Params& P = *F.p;
    constexpr int IGU = 16 * 16, IDN = 4 * 32;
    const int e = it / (IGU + IDN), r = it % (IGU + IDN);
    CpItem c;
    if (r < IGU) { const int kb = r >> 4, nb = r & 15, rr = nb * 32 + (lane & 31);
        const float* wg = e < 64 ? P.in[I_WG] + (size_t)e * DM * EFF : P.in[I_SG]; const float* wu = e < 64 ? P.in[I_WU] + (size_t)e * DM * EFF : P.in[I_SU];
        c.p = SrcGU{wg, (long)(wu - wg)}(kb * 64 + (lane >> 5), rr); c.stride = 2 * EFF;
        c.dst = (unsigned char*)(F.ws + WS_WGU) + (size_t)e * 512 * DM + (size_t)(nb * 32) * DM + kb * 64; c.K = DM; c.scale = W_SCALE_GU; }
    else { const int q = r - IGU, kb = q >> 5, nb = q & 31;
        const float* wd = e < 64 ? P.in[I_WDN] + (size_t)e * EFF * DM : P.in[I_SD];
        c.p = wd + (size_t)(kb * 64 + (lane >> 5)) * DM + nb * 32 + (lane & 31); c.stride = 2 * DM;
        c.dst = (unsigned char*)(F.ws + WS_WD) + (size_t)e * DM * EFF + (size_t)(nb * 32) * EFF + kb * 64; c.K = EFF; c.scale = W_SCALE_DN; }
    return c;
}
DEVI void expert_weight_copies(Frame& F) {
    __syncthreads();
    LAS float* scr = (LAS float*)(F.lds + F.wave * 8704);
    const int lane = F.lane;
    const int gw = F.blk * NWAVES + F.wave, NGW = F.G * NWAVES;
    constexpr int NIT = 65 * (16 * 16 + 4 * 32);
#define CP_LOAD(T_, C_) do { _Pragma("unroll") for (int i = 0; i < 32; ++i) T_[i] = (C_).p[(size_t)i * (C_).stride]; asm volatile("" ::: "memory"); } while (0)
#define CP_PROC(T_, C_) do { _Pragma("unroll") for (int i = 0; i < 32; ++i) scr[(2 * i + (lane >> 5)) * 33 + (lane & 31)] = T_[i]; \
        LDS_WAIT(); asm volatile("" ::: "memory"); \
        const int n_ = lane >> 1, hf_ = lane & 1; const LAS float* sp_ = scr + (32 * hf_) * 33 + n_; const float sc_ = (C_).scale; u32x4 o0_, o1_; \
        _Pragma("unroll") for (int q = 0; q < 4; ++q) { o0_[q] = pack_fp8x4(sp_[(4 * q) * 33] * sc_, sp_[(4 * q + 1) * 33] * sc_, sp_[(4 * q + 2) * 33] * sc_, sp_[(4 * q + 3) * 33] * sc_); \
            o1_[q] = pack_fp8x4(sp_[(16 + 4 * q) * 33] * sc_, sp_[(17 + 4 * q) * 33] * sc_, sp_[(18 + 4 * q) * 33] * sc_, sp_[(19 + 4 * q) * 33] * sc_); } \
        unsigned char* d_ = (C_).dst + (size_t)n_ * (C_).K + 32 * hf_; *(u32x4*)d_ = o0_; *(u32x4*)(d_ + 16) = o1_; \
        LDS_WAIT(); asm volatile("" ::: "memory"); } while (0)
    for (int it = gw; it < NIT; it += 2 * NGW) {
        float ta[32], tb[32]; const bool two = it + NGW < NIT;
        const CpItem ca = cp_item(F, it, lane), cb = cp_item(F, two ? it + NGW : it, lane);
        CP_LOAD(ta, ca); if (two) CP_LOAD(tb, cb);
        CP_PROC(ta, ca);
        if (two) CP_PROC(tb, cb);
    }
#undef CP_LOAD
#undef CP_PROC
}
struct SchedRowTiles { int G, c;
    DEVI bool next(int i, pg8::Unit& u) const { const int rt = c + (i >> 2) * G; if (rt >= T / 256) return false; u.pm = rt; u.pn = i & 3; u.aux = 0; return true; }
    DEVI int arow(const pg8::Unit& u, int r) const { return u.pm * 256 + r; }
    static constexpr bool IDX_DMA = false; };
DEVI void wg_global_handoff(Frame& F) {
    asm volatile("s_waitcnt vmcnt(0)" ::: "memory");
    __syncthreads();
    if (F.tid == 0) { __builtin_amdgcn_fence(__ATOMIC_ACQUIRE, "agent"); asm volatile("s_waitcnt vmcnt(0)" ::: "memory"); }
    __syncthreads();
}
DEVI void phase_gemm_y(Frame& F) {
    pg8::Gemm g{(const bf16_t*)(F.ws + WS_PROJ) + 3072, (const bf16_t*)(F.ws + WS_WOUTT), PN, DM};
    SchedRowTiles S{F.G, F.blk}; EpiBf16 E{(bf16_t*)(F.ws + WS_PROJ), PN};
    pg8::gemm_phase(F.lds, g, S, E);
}

struct SchedOne { int pm; DEVI bool next(int i, pg8::Unit& u) const { if (i) return false; u.pm = pm; u.pn = 0; u.aux = 0; return true; }
    DEVI int arow(const pg8::Unit& u, int r) const { return u.pm * 256 + r; }
    static constexpr bool IDX_DMA = false; };
constexpr int LGP = 258;
struct EpiRouter { LAS float* L;
    static constexpr bool PRE = false;
    DEVI void operator()(const f32x4 (&acc)[2][2][4][2], const pg8::Unit&, int wr, int wc, int fr, int fq) const {
#pragma unroll
        for (int pass = 0; pass < 2; ++pass) {
            if ((wc >> 1) == pass) {
#pragma unroll
                for (int ai = 0; ai < 2; ++ai)
#pragma unroll
                    for (int m = 0; m < 4; ++m) { const int row = ai * 128 + wr * 64 + m * 16 + fr, ex = (wc & 1) * 32 + 8 * fq;
                        const f32x4 v0 = acc[ai][0][m][0], v1 = acc[ai][0][m][1];
#pragma unroll
                        for (int i = 0; i < 4; ++i) { if (pass == 0) { L[(ex + i) * LGP + row] = v0[i]; L[(ex + 4 + i) * LGP + row] = v1[i]; }
                                                      else { L[(ex + i) * LGP + row] += v0[i]; L[(ex + 4 + i) * LGP + row] += v1[i]; } } }
            }
            __syncthreads();
        }
    } };
DEVI void phase_norm2(Frame& F) {
    const Params& P = *F.p;
    LAS float* LG = (LAS float*)F.lds;
    LAS float* MODS = (LAS float*)(F.lds + 131072);
    LAS int* hist = (LAS int*)(F.lds + 131072 + 12288);
    const float* ng = P.in[I_NORMG];
    const bf16_t* Y = (const bf16_t*)(F.ws + WS_PROJ); bf16_t* H2 = (bf16_t*)(F.ws + WS_PROJ) + 3072;
    int* EIDX = (int*)(F.ws + WS_EIDX); float* WTS = (float*)(F.ws + WS_WTS);
#pragma unroll 1
    for (int rb = F.blk; rb < T / 256; rb += F.G) {
        const int b = rb >> 5;
        __syncthreads();
        { float mv[6];
#pragma unroll
          for (int q = 0; q < 6; ++q) { const int i = F.tid + NTHREADS * q; mv[q] = mod_value(F, b, (2 + (i >> 10)) * 1024 + (i & 1023)); }
#pragma unroll
          for (int q = 0; q < 6; ++q) { const int i = F.tid + NTHREADS * q; MODS[i] = (i >> 10) == 2 ? 1.f + mv[q] : mv[q]; } }
        __syncthreads();
        {
            int lane = F.lane; asm volatile("" : "+v"(lane));
            f32x4 g1v[4], g2v[4];
#pragma unroll
            for (int j = 0; j < 4; ++j) { g1v[j] = *(const f32x4*)(ng + 1024 + 256 * j + 4 * lane); g2v[j] = *(const f32x4*)(ng + 2048 + 256 * j + 4 * lane); }
            u32x2 yn[4]; f32x4 xn[4];
            { const int row = rb * 256 + F.wave;
#pragma unroll
              for (int j = 0; j < 4; ++j) { yn[j] = *(const u32x2*)(Y + (size_t)row * PN + 256 * j + 4 * lane); xn[j] = *(const f32x4*)(P.in[I_X] + (size_t)row * DM + 256 * j + 4 * lane); } }
            for (int i = 0; i < 32; ++i) {
                const int row = rb * 256 + F.wave + 8 * i;
                f32x4 y[4], x[4]; float ss = 0.f;
#pragma unroll
                for (int j = 0; j < 4; ++j) { const u32x2 yy = yn[j]; y[j] = (f32x4){lo_bf(yy.x), hi_bf(yy.x), lo_bf(yy.y), hi_bf(yy.y)};
                    x[j] = xn[j]; ss += y[j].x * y[j].x + y[j].y * y[j].y + y[j].z * y[j].z + y[j].w * y[j].w; }
                if (i + 1 < 32) { const int nr = row + 8;
#pragma unroll
                    for (int j = 0; j < 4; ++j) { yn[j] = *(const u32x2*)(Y + (size_t)nr * PN + 256 * j + 4 * lane); xn[j] = *(const f32x4*)(P.in[I_X] + (size_t)nr * DM + 256 * j + 4 * lane); } }
                const float rsy = rsqrtf(wave_sum(ss) * (1.f / DM) + EPS); float s2 = 0.f;
#pragma unroll
                for (int j = 0; j < 4; ++j) { const f32x4 gg = *(const LAS f32x4*)(MODS + 256 * j + 4 * lane); x[j] = x[j] + gg * (y[j] * rsy * g1v[j]);
                    { u32x2 xo; xo.x = cvt_pk_bf16(x[j].x, x[j].y); xo.y = cvt_pk_bf16(x[j].z, x[j].w); *(u32x2*)((bf16_t*)(P.out + (size_t)row * DM) + 256 * j + 4 * lane) = xo; } s2 += x[j].x * x[j].x + x[j].y * x[j].y + x[j].z * x[j].z + x[j].w * x[j].w; }
                const float rsx = rsqrtf(wave_sum(s2) * (1.f / DM) + EPS);
#pragma unroll
                for (int j = 0; j < 4; ++j) { const f32x4 sh = *(const LAS f32x4*)(MODS + 1024 + 256 * j + 4 * lane), sc = *(const LAS f32x4*)(MODS + 2048 + 256 * j + 4 * lane);
                    const f32x4 hv = (x[j] * rsx * g2v[j]) * sc + sh;
                    u32x2 o; o.x = cvt_pk_bf16(hv.x, hv.y); o.y = cvt_pk_bf16(hv.z, hv.w);
                    *(u32x2*)(H2 + (size_t)row * PN + 256 * j + 4 * lane) = o;
                    *(unsigned*)((unsigned char*)(F.ws + WS_PROJ) + (size_t)row * PN * 2 + 256 * j + 4 * lane) = pack_fp8x4(hv.x * H2_SCALE, hv.y * H2_SCALE, hv.z * H2_SCALE, hv.w * H2_SCALE); }
            }
        }
    }
    asm volatile("s_waitcnt vmcnt(0)" ::: "memory");
    __syncthreads();
    if (F.tid == 0) { __builtin_amdgcn_fence(__ATOMIC_ACQUIRE, "agent"); asm volatile("s_waitcnt vmcnt(0)" ::: "memory"); }
    __syncthreads();
#pragma unroll 1
    for (int rb = F.blk; rb < T / 256; rb += F.G) {
        __syncthreads();
        if (F.tid < 64) hist[F.tid] = 0;
        {
            pg8::Gemm g{(const bf16_t*)(F.ws + WS_PROJ) + 3072, (const bf16_t*)(F.ws + WS_WRT), PN, DM};
            SchedOne S{rb}; EpiRouter E{LG};
            pg8::gemm_phase<EpiRouter, SchedOne, true, true>(F.lds, g, S, E);
        }
        __syncthreads();
        if (F.tid < 256) {
            const int lr = F.tid, row = rb * 256 + lr;
            float sc[64], sel[64];
#pragma unroll
            for (int e = 0; e < 64; ++e) { const float s = sigmoidf_(LG[e * LGP + lr]); sc[e] = s; sel[e] = s + P.in[I_RB][e]; }
            float gs[8];
#pragma unroll
            for (int g2 = 0; g2 < 8; ++g2) { float m1 = -3.0e38f, m2 = -3.0e38f;
#pragma unroll
                for (int j = 0; j < 8; ++j) { const float v = sel[8 * g2 + j]; m2 = fmaxf(m2, fminf(m1, v)); m1 = fmaxf(m1, v); }
                gs[g2] = m1 + m2; }
#pragma unroll
            for (int g2 = 0; g2 < 8; ++g2) { int rank = 0;
#pragma unroll
                for (int g3 = 0; g3 < 8; ++g3) if (g3 != g2) rank += (gs[g3] > gs[g2] || (gs[g3] == gs[g2] && g3 < g2)) ? 1 : 0;
                if (rank >= 4) {
#pragma unroll
                    for (int j = 0; j < 8; ++j) sel[8 * g2 + j] = -3.0e38f; } }
            int idx[8]; float wv[8]; float wsum = 0.f;
#pragma unroll
            for (int k = 0; k < 8; ++k) { float best = -3.4e38f, bs = 0.f; int bi = 0;
#pragma unroll
                for (int e = 0; e < 64; ++e) { const bool c = sel[e] > best; best = c ? sel[e] : best; bi = c ? e : bi; bs = c ? sc[e] : bs; }
                idx[k] = bi; wv[k] = bs; wsum += bs;
#pragma unroll
                for (int e = 0; e < 64; ++e) sel[e] = (bi == e) ? -3.4e38f : sel[e]; }
            const float wn = 2.5f * __builtin_amdgcn_rcpf(wsum);
            *(u32x4*)(EIDX + (size_t)row * 8) = (u32x4){(unsigned)idx[0], (unsigned)idx[1], (unsigned)idx[2], (unsigned)idx[3]};
            *(u32x4*)(EIDX + (size_t)row * 8 + 4) = (u32x4){(unsigned)idx[4], (unsigned)idx[5], (unsigned)idx[6], (unsigned)idx[7]};
            *(f32x4*)(WTS + (size_t)row * 8) = (f32x4){wv[0] * wn, wv[1] * wn, wv[2] * wn, wv[3] * wn};
            *(f32x4*)(WTS + (size_t)row * 8 + 4) = (f32x4){wv[4] * wn, wv[5] * wn, wv[6] * wn, wv[7] * wn};
#pragma unroll
            for (int k = 0; k < 8; ++k) atomicAdd((int*)hist + idx[k], 1);
        }
        __syncthreads();
        if (F.tid < 64) ((int*)(F.ws + WS_BCNT))[rb * 64 + F.tid] = hist[F.tid];
    }
}

DEVI void phase_lists(Frame& F) {
    LAS int* base = (LAS int*)F.lds;
    LAS int* pst = base + 64;
    LAS int* tot = pst + 65;
    LAS int* lcnt = tot + 64;
    const int* BC = (const int*)(F.ws + WS_BCNT);
    const int* EIDX = (const int*)(F.ws + WS_EIDX); const float* WTS = (const float*)(F.ws + WS_WTS); int* POS = (int*)(F.ws + WS_POS);
    for (int rb = F.blk; rb < 256; rb += F.G) {
        const int hh = rb >> 7;
        __syncthreads();
        {   LAS int* psum = lcnt + 64;
            const int e = F.tid & 63, part = F.tid >> 6; int bs = 0, ts = 0;
#pragma unroll
            for (int i = 0; i < 16; ++i) { const int q = hh * 128 + part * 16 + i; const int v = BC[q * 64 + e]; ts += v; bs += q < rb ? v : 0; }
            psum[(part * 64 + e) * 2] = bs; psum[(part * 64 + e) * 2 + 1] = ts;
            __syncthreads();
            if (F.tid < 64) { int bsum = 0, tsum = 0;
#pragma unroll
                for (int p = 0; p < 8; ++p) { bsum += psum[(p * 64 + F.tid) * 2]; tsum += psum[(p * 64 + F.tid) * 2 + 1]; }
                base[F.tid] = bsum; tot[F.tid] = tsum; lcnt[F.tid] = 0; }
        }
        __syncthreads();
        if (F.tid == 0) { int s = 0; for (int e = 0; e < 64; ++e) { pst[e] = s; s += (tot[e] + 255) & ~255; } pst[64] = s; }
        __syncthreads();
        int* TOK = (int*)(F.ws + WS_TOKL) + (size_t)hh * ROWS_H; float* WL = (float*)(F.ws + WS_WL) + (size_t)hh * ROWS_H;
        { int ee[4]; float ww[4];
#pragma unroll
          for (int q = 0; q < 4; ++q) { const int i = F.tid + NTHREADS * q; const size_t o = (size_t)(rb * 256 + (i >> 3)) * 8 + (i & 7); ee[q] = EIDX[o]; ww[q] = WTS[o]; }
#pragma unroll
          for (int q = 0; q < 4; ++q) { const int i = F.tid + NTHREADS * q; const int t = rb * 256 + (i >> 3), k = i & 7; const int e = ee[q];
            const int loc = atomicAdd((int*)lcnt + e, 1); const int dest = pst[e] + base[e] + loc;
            TOK[dest] = t; WL[dest] = ww[q]; POS[(size_t)t * 8 + k] = dest + hh * ROWS_H; } }
        if (F.tid < 256) { const int t = rb * 256 + F.tid; TOK[CAP_R + t - hh * HALF_T] = t; WL[CAP_R + t - hh * HALF_T] = 1.f; }
        const int e = rb & 127;
        if (e < 64) {
            for (int r = pst[e] + tot[e] + F.tid; r < pst[e + 1]; r += NTHREADS) { TOK[r] = -1; WL[r] = 0.f; }
            int* TE = (int*)(F.ws + WS_TEXP) + hh * CAP_TILES;
            for (int q = (pst[e] >> 8) + F.tid; q < (pst[e + 1] >> 8); q += NTHREADS) TE[q] = e;
            if (e == 0 && F.tid == 0) ((int*)(F.ws + WS_NT))[hh] = pst[64] >> 8;
        }
    }
}

struct SchedMoE {
    int G, c, nt0, nt1, npn, hsel; const int* texp; const int* tok; bool gather;
    DEVI bool next(int i, pg8::Unit& u) const {
        const int cc = (G == 256) ? ((c & 7) * 32 + (c >> 3)) : c;
        const int sh = npn == 8 ? 3 : (npn == 4 ? 2 : 1);
        const int L = i * G + cc; const int rtl = L >> sh; int pnl = L & (npn - 1);
        const int r0 = nt0 + SH_TILES, r1 = nt1 + SH_TILES;
        int hh, rl;
        if (hsel < 0) { if (rtl >= r0 + r1) return false; hh = rtl >= r0 ? 1 : 0; rl = rtl - hh * r0; }
        else {
            hh = hsel; const int nrt = hh ? r1 : r0, fr = nrt / G;
            if (i < npn * fr) { rl = (i >> sh) * G + cc; pnl = i & (npn - 1); }
            else { const int L2 = (i - npn * fr) * G + cc; rl = fr * G + (L2 >> sh); pnl = L2 & (npn - 1); if (rl >= nrt) return false; }
        }
        const int nth = hh ? nt1 : nt0;
        int e, lt; if (rl < nth) { lt = rl; e = texp[hh * CAP_TILES + rl]; } else { lt = CAP_TILES + (rl - nth); e = 64; }
        u.pm = hh * HTILES + lt; u.pn = e * npn + pnl; u.aux = pnl; return true;
    }
    DEVI int arow(const pg8::Unit& u, int r) const {
        if (!gather) return u.pm * 256 + r;
        const int t = tok[u.pm * 256 + r]; return t < 0 ? 0 : t;
    }
};
constexpr int UT_OFF = pg8::STAGE_BYTES, UT_MAX = 64;
constexpr int WLB_OFF = UT_OFF + 1024;
constexpr int IDX_OFF = UT_OFF + 3072;
template <bool GATHER>
struct SchedTab { const LAS int* tab; const int* tok;
    static constexpr bool IDX_DMA = GATHER;
    DEVI bool next(int i, pg8::Unit& u) const {
        if (i >= UT_MAX) return false;
        const int pm = tab[4 * i]; if (pm < 0) return false;
        u.pm = pm; u.pn = tab[4 * i + 1]; u.aux = tab[4 * i + 2]; return true;
    }
    DEVI int arow(const pg8::Unit& u, int r) const {
        if (!GATHER) return u.pm * 256 + r;
        return tok[u.pm * 256 + r];
    }
    DEVI void idx_dma(LAS unsigned char* l, const pg8::Unit& u, int ui, int wid, int lane) const {
        if (wid >= 4) __builtin_amdgcn_global_load_lds((const unsigned*)(tok + u.pm * 256 + (wid - 4) * 64 + lane), (LAS unsigned*)(l + IDX_OFF + (ui & 1) * 1024 + (wid - 4) * 256), 4, 0, 0);
    }
    DEVI int idx_lds(LAS unsigned char* l, int ui, int r) const { return ((const LAS int*)(l + IDX_OFF + (ui & 1) * 1024))[r]; }
};
template <bool GATHER>
DEVI SchedTab<GATHER> build_unit_table(Frame& F, const SchedMoE& S) {
    LAS int* tab = (LAS int*)(F.lds + UT_OFF);
    __syncthreads();
    int ti = F.tid; asm volatile("" : "+v"(ti));
    if (ti < UT_MAX) { pg8::Unit u; u.pm = 0; u.pn = 0; u.aux = 0; const bool ok = S.next(ti, u);
        tab[4 * ti] = ok ? u.pm : -1; tab[4 * ti + 1] = ok ? u.pn : 0; tab[4 * ti + 2] = ok ? u.aux : 0; }
    __syncthreads();
    return SchedTab<GATHER>{tab, S.tok};
}
struct EpiGU { unsigned char* O; const float* wl; float inv; LAS unsigned char* lds;
    static constexpr bool PRE = true;
    DEVI void prefetch(LAS unsigned char* l, const pg8::Unit& u, int wid, int lane) const {
        if (wid < 4) __builtin_amdgcn_global_load_lds((const unsigned*)(wl + u.pm * 256 + wid * 64 + lane), (LAS unsigned*)(l + WLB_OFF + (u.seq & 1) * 1024 + wid * 256), 4, 0, 0);
    }
    DEVI void operator()(const f32x4 (&acc)[2][2][4][2], const pg8::Unit& u, int wr, int wc, int fr, int fq) const {
        asm volatile("" : "+v"(fr), "+v"(fq));
        const int row0 = u.pm * 256 + wr * 64 + fr, col0 = u.aux * 64 + wc * 16 + 4 * fq;
        const LAS float* wb = (const LAS float*)(lds + WLB_OFF + (u.seq & 1) * 1024) + wr * 64 + fr;
        float wv[2][4];
#pragma unroll
        for (int ai = 0; ai < 2; ++ai)
#pragma unroll
            for (int m = 0; m < 4; ++m) wv[ai][m] = wb[ai * 128 + m * 16];
#pragma unroll
        for (int ai = 0; ai < 2; ++ai)
#pragma unroll
            for (int m = 0; m < 4; ++m) { const f32x4 g0 = acc[ai][0][m][0], u0 = acc[ai][0][m][1]; const float w = wv[ai][m];
                float o[4];
#pragma unroll
                for (int i = 0; i < 4; ++i) o[i] = siluf_(g0[i]) * u0[i] * (w * ACT_SCALE);
                *(unsigned*)(O + (size_t)(row0 + ai * 128 + m * 16) * EFF + col0) = pack_fp8x4(o[0], o[1], o[2], o[3]); }
    } };
DEVI void phase_moe_gu(Frame& F) {
    const int nt0 = ((const int*)(F.ws + WS_NT))[0], nt1 = ((const int*)(F.ws + WS_NT))[1];
    static_assert(H2_SCALE * W_SCALE_GU == 16384.f, "the gate|up GEMM's operand scaling is undone by the MFMA block scale: 2^-14");
    pg8::Gemm g{(const bf16_t*)(F.ws + WS_PROJ), (const bf16_t*)(F.ws + WS_WGU), PN, DM / 2, 0x71717171};
    SchedMoE S0{F.G, F.blk, nt0, nt1, 4, -1, (const int*)(F.ws + WS_TEXP), (const int*)(F.ws + WS_TOKL), true};
    const SchedTab<true> S = build_unit_table<true>(F, S0);
    EpiGU E{(unsigned char*)(F.ws + WS_ACT), (const float*)(F.ws + WS_WL), 1.f, F.lds};
    pg8::gemm_phase<EpiGU, SchedTab<true>, false, true, true>(F.lds, g, S, E);
}
struct EpiDown { unsigned char* O; int hh; float sc;
    static constexpr bool PRE = false;
    static constexpr int NST = 8;
    DEVI void operator()(const f32x4 (&acc)[2][2][4][2], const pg8::Unit& u, int wr, int wc, int fr, int fq) const {
        asm volatile("" : "+v"(fr), "+v"(fq));
        const int row0 = (u.pm - hh * HTILES) * 256 + wr * 64 + fr, col0 = u.aux * 128 + wc * 32 + 8 * fq;
#pragma unroll
        for (int ai = 0; ai < 2; ++ai)
#pragma unroll
            for (int m = 0; m < 4; ++m) { const int row = row0 + ai * 128 + m * 16;
                const f32x4 a0 = acc[ai][0][m][0], a1 = acc[ai][0][m][1];
                u32x2 o; o.x = pack_fp8x4(a0[0], a0[1], a0[2], a0[3]); o.y = pack_fp8x4(a1[0], a1[1], a1[2], a1[3]);
                *(u32x2*)(O + (size_t)row * DM + col0) = o; }
    } };
DEVI void phase_moe_down(Frame& F, int hh) {
    const int nt0 = ((const int*)(F.ws + WS_NT))[0], nt1 = ((const int*)(F.ws + WS_NT))[1];
    static_assert(ROW_SCALE / (ACT_SCALE * W_SCALE_DN) == 1.f / 1024.f, "the down GEMM's output scaling rides on the MFMA block scale: 2^-10");
    SchedMoE S0{F.G, F.blk, nt0, nt1, 8, hh, (const int*)(F.ws + WS_TEXP), nullptr, false};
    const SchedTab<false> S = build_unit_table<false>(F, S0);
    pg8::DnArgs g{(const unsigned char*)(F.ws + WS_ACT), (const unsigned char*)(F.ws + WS_WD), (unsigned char*)(F.ws + (hh ? WS_ROWS1 : WS_ROWS0)), hh, 0x75757575};
    pg8::gemm_phase_dnreg(F.lds, g, S);
}
DEVI void phase_combine(Frame& F, int hh) {
    const Params& P = *F.p;
    LAS float* G2 = (LAS float*)F.lds;
    const unsigned char* ROWS = (const unsigned char*)(F.ws + (hh ? WS_ROWS1 : WS_ROWS0)); const int* POS = (const int*)(F.ws + WS_POS);
    const int cA = 16 * F.lane;
    f32x4 g3v[4];
#pragma unroll
    for (int j = 0; j < 4; ++j) g3v[j] = *(const f32x4*)(P.in[I_NORMG] + 3072 + cA + 4 * j);
    for (int rb = F.blk; rb < HALF_T / 128; rb += F.G) {
        const int t0 = hh * HALF_T + rb * 128, b = t0 >> 13;
        __syncthreads();
        for (int i = F.tid; i < 1024; i += NTHREADS) G2[i] = mod_value(F, b, 5 * 1024 + i);
        __syncthreads();
        int prv[16];
#pragma unroll
        for (int i = 0; i < 16; ++i) { prv[i] = 0; if (F.lane < 8) prv[i] = POS[(size_t)(t0 + F.wave + 8 * i) * 8 + F.lane] - hh * ROWS_H; }
        u32x4 rvs[2][9], xas[2], xbs[2];
#define CB_LOAD(S_, I_) do { const int t_ = t0 + F.wave + 8 * (I_); const int pr_ = prv[I_]; const bf16_t* x1p_ = (const bf16_t*)(P.out + (size_t)t_ * DM); \
            xas[S_] = *(const u32x4*)(x1p_ + cA); xbs[S_] = *(const u32x4*)(x1p_ + cA + 8); \
            _Pragma("unroll") for (int k = 0; k < 9; ++k) { const int r_ = k < 8 ? __shfl(pr_, k) : CAP_R + (t_ - hh * HALF_T); rvs[S_][k] = *(const u32x4*)(ROWS + (size_t)r_ * DM + 16 * F.lane); } } while (0)
        CB_LOAD(0, 0);
#pragma unroll
        for (int i = 0; i < 16; ++i) {
            const int t = t0 + F.wave + 8 * i;
            if (i + 1 < 16) CB_LOAD((i + 1) & 1, i + 1);
            asm volatile("" ::: "memory");
            const u32x4 xa = xas[i & 1], xb = xbs[i & 1];
            u32x4 rv[9];
#pragma unroll
            for (int k = 0; k < 9; ++k) rv[k] = rvs[i & 1][k];
            float a[16];
#pragma unroll
            for (int q = 0; q < 16; ++q) a[q] = 0.f;
#pragma unroll
            for (int k = 0; k < 9; ++k)
#pragma unroll
                for (int q = 0; q < 4; ++q) { const f32x2 lo = __builtin_amdgcn_cvt_pk_f32_fp8((int)rv[k][q], false), hi = __builtin_amdgcn_cvt_pk_f32_fp8((int)rv[k][q], true);
                    a[4 * q] += lo[0]; a[4 * q + 1] += lo[1]; a[4 * q + 2] += hi[0]; a[4 * q + 3] += hi[1]; }
            float ss = 0.f;
#pragma unroll
            for (int q = 0; q < 16; ++q) { a[q] *= (1.f / ROW_SCALE); ss += a[q] * a[q]; }
            const float rs = rsqrtf(wave_sum(ss) * (1.f / DM) + EPS);
#pragma unroll
            for (int j = 0; j < 4; ++j) { const int col = cA + 4 * j; const f32x4 gg = *(const LAS f32x4*)(G2 + col);
                const u32x4 xs = (j >> 1) ? xb : xa; const unsigned w0 = (j & 1) ? xs.z : xs.x, w1 = (j & 1) ? xs.w : xs.y;
                const f32x4 x1 = (f32x4){lo_bf(w0), hi_bf(w0), lo_bf(w1), hi_bf(w1)};
                const f32x4 av = (f32x4){a[4 * j], a[4 * j + 1], a[4 * j + 2], a[4 * j + 3]};
                *(f32x4*)(P.out + (size_t)t * DM + col) = x1 + gg * (av * rs * g3v[j]); }
        }
#undef CB_LOAD
    }
}

DEVI void phase_mixer_tail(Frame& F) {
    const bool first = (F.blk >> 3) & 1;
    if (first) { expert_weight_copies(F); __syncthreads(); }
    phase_chunk_out(F);
    wg_global_handoff(F);
    phase_gemm_y(F);
    wg_global_handoff(F);
    phase_norm2(F);
    if (!first) { __syncthreads(); expert_weight_copies(F); }
}

DEVI void phase_down1_combine0(Frame& F) {
    if ((F.blk >> 3) & 1) { phase_combine(F, 0); __syncthreads(); phase_moe_down(F, 1); }
    else { phase_moe_down(F, 1); __syncthreads(); phase_combine(F, 0); }
}

constexpr int N_PHASES = 11;
__global__ void __launch_bounds__(NTHREADS, 2) mk_fwd(Params prm) {
    extern __shared__ __attribute__((aligned(16))) unsigned char lds_raw[];
    Frame F; F.lds = (LAS unsigned char*)lds_raw; F.tid = threadIdx.x; F.lane = F.tid & 63; F.wave = __builtin_amdgcn_readfirstlane(F.tid >> 6);
    F.G = gridDim.x; F.blk = blockIdx.x; F.p = &prm; F.ws = prm.ws;
    volatile LAS unsigned* misc = (volatile LAS unsigned*)(F.lds + LDS_MISC);
    if (F.tid < 16) misc[F.tid] = 0u;
    __syncthreads();
    const int lo = prm.ph_lo, hi = prm.ph_hi;
    XcdBarrier bar; bar.bar = (unsigned*)(F.ws + WS_CTL); bar.x = 0; bar.st = misc;
    if (hi - lo > 1) bar = xcd_barrier_post((unsigned*)(F.ws + WS_CTL), misc);
#ifndef PH_MASK
#define PH_MASK 0xFFFF
#endif
#define RUN(k, call) do { if (((PH_MASK >> (k)) & 1) && lo <= (k) && (k) < hi) { call; if ((k) + 1 < hi) xcd_barrier(bar); } } while (0)
    RUN(0, phase_prep(F));
    RUN(1, phase_norm1(F));
    RUN(2, phase_gemm_proj(F));
    RUN(3, phase_chunk_u(F));
    RUN(4, phase_scan_states(F));
    RUN(5, phase_mixer_tail(F));
    RUN(6, phase_lists(F));
    RUN(7, phase_moe_gu(F));
    RUN(8, phase_moe_down(F, 0));
    RUN(9, phase_down1_combine0(F));
    RUN(10, phase_combine(F, 1));
#undef RUN
}

extern "C" void kernel_launch(void* const* d_in, const int* in_sizes, int n_in, void* d_out, int out_size, void* d_ws, size_t ws_size, hipStream_t stream) {
    static int grid = 0;
    if (grid == 0) {
        if (n_in != 23 || in_sizes[0] != T * DM || out_size != T * DM || ws_size < WS_END) {
            fprintf(stderr, "kernel_launch: unexpected shapes (n_in %d, in0 %d, out %d, ws %zu < %zu)\n", n_in, n_in > 0 ? in_sizes[0] : -1, out_size, ws_size, (size_t)WS_END); grid = -1; return; }
        int dev = 0, cus = 0, per_cu = 0;
        if (hipGetDevice(&dev) != hipSuccess || hipDeviceGetAttribute(&cus, hipDeviceAttributeMultiprocessorCount, dev) != hipSuccess) { grid = -1; return; }
        if (hipFuncSetAttribute((const void*)mk_fwd, hipFuncAttributeMaxDynamicSharedMemorySize, LDS_BYTES) != hipSuccess) { fprintf(stderr, "kernel_launch: hipFuncSetAttribute failed\n"); grid = -1; return; }
        if (hipOccupancyMaxActiveBlocksPerMultiprocessor(&per_cu, (const void*)mk_fwd, NTHREADS, LDS_BYTES) != hipSuccess || per_cu < 1) { fprintf(stderr, "kernel_launch: occupancy query says %d\n", per_cu); }
        (void)hipGetLastError();
        grid = cus;
    }
    if (grid < 0) return;
    (void)hipMemsetAsync((char*)d_ws + WS_CTL, 0, CTL_BYTES, stream);
    Params p{};
    for (int i = 0; i < 23; ++i) p.in[i] = (const float*)d_in[i];
    p.out = (float*)d_out; p.ws = (unsigned char*)d_ws;
#if MK_ONE_LAUNCH
    p.ph_lo = 0; p.ph_hi = N_PHASES;
    hipLaunchKernelGGL(mk_fwd, dim3(grid), dim3(NTHREADS), LDS_BYTES, stream, p);
#else
    for (int k = 0; k < N_PHASES; ++k) { p.ph_lo = k; p.ph_hi = k + 1; hipLaunchKernelGGL(mk_fwd, dim3(grid), dim3(NTHREADS), LDS_BYTES, stream, p); }
#endif
}
```
